# Optimizing an MI355X kernel written in HIP

```python
import jax, jax.numpy as jnp
from jax import lax
import numpy as np

D_MODEL = 1024
BATCH = 8
SEQ = 4096
DEPTH = 2

GRID_W = 64
CTX_LEN = 256
EPS = 1e-6
NEG_INF = -1e30
HEAD_DIM = 64
N_Q_HEADS = 8
N_KV_HEADS = 2
Q_PER_KV = N_Q_HEADS // N_KV_HEADS
ATTN_WIDTH = N_Q_HEADS * HEAD_DIM
KV_WIDTH = N_KV_HEADS * HEAD_DIM
WINDOW = 128
BLOCK = 128
ROPE_BASE = 10000.0
CONV_B_WIDTH = D_MODEL // 2
CONV_B_GROUPS = 8
CONV_B_K = 3
CONV_B_LEFT = 1
EVEN_SPLITS = (ATTN_WIDTH, ATTN_WIDTH + KV_WIDTH, ATTN_WIDTH + 2 * KV_WIDTH,
               ATTN_WIDTH + 2 * KV_WIDTH + CONV_B_WIDTH, ATTN_WIDTH + 2 * KV_WIDTH + 2 * CONV_B_WIDTH)
EVEN_IN = ATTN_WIDTH + 2 * KV_WIDTH + 3 * CONV_B_WIDTH
EVEN_OUT = ATTN_WIDTH + CONV_B_WIDTH
LRU_WIDTH = D_MODEL
LRU_HEADS = 8
LRU_BLOCK = LRU_WIDTH // LRU_HEADS
LRU_C = 8.0
LRU_CONV_K = 4
LRU_CONV_LEFT = 2
N_EXPERTS = 16
CAPACITY_FACTOR = 2
EXPERT_FF = 1408
N_EVEN = (DEPTH + 1) // 2
N_ODD = DEPTH // 2

kernel_name = "hybrid_swa_shortconv_rglru_ecmoe_dit"


def rmsnorm(x, g):
    xf = x.astype(jnp.float32)
    y = xf * lax.rsqrt(jnp.mean(xf * xf, axis=-1, keepdims=True) + EPS)
    return (y * g.astype(jnp.float32)).astype(x.dtype)


def modulate(h, shift, scale):
    return h * (1.0 + scale) + shift


def axial_rope(x, rows, cols):
    dh = x.shape[-1]
    half = dh // 2
    nf = half // 2
    inv = ROPE_BASE ** (-jnp.arange(nf, dtype=jnp.float32) / nf)
    out = []
    for part, pos in ((x[..., :half], rows), (x[..., half:], cols)):
        ang = pos.astype(jnp.float32)[:, None] * inv[None, :]
        cos = jnp.cos(ang)[None, :, None, :]
        sin = jnp.sin(ang)[None, :, None, :]
        p1 = part[..., :nf].astype(jnp.float32)
        p2 = part[..., nf:].astype(jnp.float32)
        out += [p1 * cos - p2 * sin, p2 * cos + p1 * sin]
    return jnp.concatenate(out, axis=-1).astype(x.dtype)


def dwconv(u, w, bias, left):
    k_w = w.shape[0]
    n = u.shape[1]
    up = jnp.pad(u, ((0, 0), (left, k_w - 1 - left), (0, 0)))
    return sum(w[k] * up[:, k:k + n] for k in range(k_w)) + bias


def sink_logits(sink, shape):
    return jnp.broadcast_to(sink.astype(jnp.float32).reshape(1, N_KV_HEADS, Q_PER_KV, *([1] * (len(shape) - 3))), shape)


def windowed_gqa_with_context(q, k, v, kc, vc, sink):
    b, n, hk, g, dh = q.shape
    nb = n // BLOCK
    scale = dh ** -0.5
    qb = q.reshape(b, nb, BLOCK, hk, g, dh)
    pad = ((0, 0), (BLOCK, BLOCK), (0, 0), (0, 0))
    kp = jnp.pad(k, pad).reshape(b, nb + 2, BLOCK, hk, dh)
    vp = jnp.pad(v, pad).reshape(b, nb + 2, BLOCK, hk, dh)
    kb = jnp.concatenate([kp[:, :-2], kp[:, 1:-1], kp[:, 2:]], axis=2)
    vb = jnp.concatenate([vp[:, :-2], vp[:, 1:-1], vp[:, 2:]], axis=2)
    s_loc = jnp.einsum('bnqkgd,bnjkd->bkgnqj', qb, kb).astype(jnp.float32) * scale
    qpos = jnp.arange(nb)[:, None] * BLOCK + jnp.arange(BLOCK)[None, :]
    kpos = jnp.arange(nb)[:, None] * BLOCK - BLOCK + jnp.arange(3 * BLOCK)[None, :]
    diff = kpos[:, None, :] - qpos[:, :, None]
    valid = (jnp.abs(diff) <= WINDOW) & (kpos[:, None, :] >= 0) & (kpos[:, None, :] < n)
    s_loc = jnp.where(valid, s_loc, NEG_INF)
    s_ctx = jnp.einsum('bnqkgd,bjkd->bkgnqj', qb, kc).astype(jnp.float32) * scale
    s_snk = sink_logits(sink, s_loc.shape[:-1] + (1,))
    p = jax.nn.softmax(jnp.concatenate([s_loc, s_ctx, s_snk], axis=-1), axis=-1)
    n_loc = 3 * BLOCK
    n_ctx = kc.shape[1]
    p_loc = p[..., :n_loc].astype(v.dtype)
    p_ctx = p[..., n_loc:n_loc + n_ctx].astype(v.dtype)
    o = (jnp.einsum('bkgnqj,bnjkd->bnqkgd', p_loc, vb)
         + jnp.einsum('bkgnqj,bjkd->bnqkgd', p_ctx, vc))
    return o.reshape(b, n, hk * g * dh)


def context_attention(qc, kc, vc, sink):
    b, L, hk, g, dh = qc.shape
    s = jnp.einsum('bqkgd,bjkd->bkgqj', qc, kc).astype(jnp.float32) * dh ** -0.5
    s_snk = sink_logits(sink, s.shape[:-1] + (1,))
    p = jax.nn.softmax(jnp.concatenate([s, s_snk], axis=-1), axis=-1)
    o = jnp.einsum('bkgqj,bjkd->bqkgd', p[..., :L].astype(vc.dtype), vc)
    return o.reshape(b, L, hk * g * dh)


def gated_short_conv(gb, gc, u, w, bias):
    return gb * dwconv(gc * u, w, bias, CONV_B_LEFT)


def even_mixer(hl, hc, rows, cols, w_in, w_out, sink, conv_w, conv_b, need_ctx_out):
    def project(h):
        b, n = h.shape[:2]
        q, k, v, gb, gc, u = jnp.split(h @ w_in, EVEN_SPLITS, axis=-1)
        return (q.reshape(b, n, N_Q_HEADS, HEAD_DIM), k.reshape(b, n, N_KV_HEADS, HEAD_DIM),
                v.reshape(b, n, N_KV_HEADS, HEAD_DIM), gb, gc, u)
    b, n = hl.shape[:2]
    ql, kl, vl, bl, cl, ul = project(hl)
    qc, kc, vc, bc, cc, uc = project(hc)
    ql = axial_rope(ql, rows, cols).reshape(b, n, N_KV_HEADS, Q_PER_KV, HEAD_DIM)
    kl = axial_rope(kl, rows, cols)
    att_l = windowed_gqa_with_context(ql, kl, vl, kc, vc, sink)
    conv_l = gated_short_conv(bl, cl, ul, conv_w, conv_b)
    yl = jnp.concatenate([att_l, conv_l], axis=-1) @ w_out
    if not need_ctx_out:
        return yl, None
    L = hc.shape[1]
    att_c = context_attention(qc.reshape(b, L, N_KV_HEADS, Q_PER_KV, HEAD_DIM), kc, vc, sink)
    conv_c = gated_short_conv(bc, cc, uc, conv_w, conv_b)
    yc = jnp.concatenate([att_c, conv_c], axis=-1) @ w_out
    return yl, yc


def rglru_coeffs(u, wa, ba, wx, bx, lam):
    b, n, w = u.shape
    ub = u.reshape(b, n, LRU_HEADS, LRU_BLOCK)
    r = jax.nn.sigmoid(jnp.einsum('bnhi,hij->bnhj', ub, wa.astype(jnp.float32)).reshape(b, n, w) + ba.astype(jnp.float32))
    i = jax.nn.sigmoid(jnp.einsum('bnhi,hij->bnhj', ub, wx.astype(jnp.float32)).reshape(b, n, w) + bx.astype(jnp.float32))
    log_a = -LRU_C * r * jax.nn.softplus(-lam.astype(jnp.float32))
    a = jnp.exp(log_a)
    mult = jnp.sqrt(-jnp.expm1(2.0 * log_a))
    return a, mult * (i * u)


def linear_scan(a, b, reverse):
    def combine(e1, e2):
        a1, b1 = e1
        a2, b2 = e2
        return a1 * a2, a2 * b1 + b2
    return lax.associative_scan(combine, (a, b), reverse=reverse, axis=1)[1]


def odd_mixer(hl, hc, w_in, w_out, conv_w, conv_b, wa, ba, wx, bx, lam, need_ctx_out):
    gl, ul = jnp.split(hl @ w_in, 2, axis=-1)
    gc, uc = jnp.split(hc @ w_in, 2, axis=-1)
    ul = dwconv(ul, conv_w, conv_b, LRU_CONV_LEFT).astype(jnp.float32)
    uc = dwconv(uc, conv_w, conv_b, LRU_CONV_LEFT).astype(jnp.float32)
    hs_l, hs_c = [], []
    for d, reverse in ((0, False), (1, True)):
        a_c, b_c = rglru_coeffs(uc, wa[d], ba[d], wx[d], bx[d], lam[d])
        h_c = linear_scan(a_c, b_c, reverse)
        end = 0 if reverse else -1
        h0 = h_c[:, 0] if reverse else h_c[:, -1]
        a_l, b_l = rglru_coeffs(ul, wa[d], ba[d], wx[d], bx[d], lam[d])
        b_l = b_l.at[:, -1 if reverse else 0].add(a_l[:, -1 if reverse else 0] * h0)
        hs_l.append(linear_scan(a_l, b_l, reverse))
        hs_c.append(h_c)
    yl = (jax.nn.gelu(gl) * (hs_l[0] + hs_l[1]).astype(gl.dtype)) @ w_out
    if not need_ctx_out:
        return yl, None
    yc = (jax.nn.gelu(gc) * (hs_c[0] + hs_c[1]).astype(gc.dtype)) @ w_out
    return yl, yc


def expert_choice_ffn(h, router_w, w_gate, w_up, w_down):
    b, n, d = h.shape
    cap = max(1, CAPACITY_FACTOR * n // N_EXPERTS)
    aff = jax.nn.softmax((h @ router_w).astype(jnp.float32), axis=-1)
    g, idx = lax.top_k(jnp.swapaxes(aff, 1, 2), cap)
    flat = (jnp.arange(b)[:, None, None] * n + idx).reshape(-1)
    hf = h.reshape(b * n, d)
    xe = hf[flat].reshape(b, N_EXPERTS, cap, d)
    a = jnp.einsum('becd,edf->becf', xe, w_gate)
    u = jnp.einsum('becd,edf->becf', xe, w_up)
    y = jnp.einsum('becf,efd->becd', jax.nn.silu(a) * u, w_down)
    y = y * g[..., None].astype(y.dtype)
    out = jnp.zeros((b * n, d), y.dtype).at[flat].add(y.reshape(-1, d))
    return out.reshape(b, n, d)


def setup_inputs(seed: int = 0) -> dict:
    key = jax.random.key(seed)
    ks = jax.random.split(key, 32)
    f32 = jnp.float32
    D = D_MODEL

    def nrm(k, shape, s):
        return jax.random.normal(k, shape, f32) * s

    u = jax.random.uniform(ks[22], (N_ODD, 2, LRU_WIDTH), f32, 0.9, 0.999)
    s = u ** (1.0 / LRU_C)
    lam = jnp.log(s) - jnp.log1p(-s)
    return {
        "x": nrm(ks[0], (BATCH, SEQ, D), 1.0),
        "c": nrm(ks[1], (BATCH, D), 1.0),
        "ctx": nrm(ks[2], (BATCH, CTX_LEN, D), 1.0),
        "c_ctx": nrm(ks[3], (D,), 1.0),
        "ada_w": nrm(ks[4], (DEPTH, D, 6 * D), 0.02),
        "ada_b": nrm(ks[5], (DEPTH, 6 * D), 0.01),
        "norm_mix_g": 1.0 + nrm(ks[6], (DEPTH, D), 0.02),
        "norm_ffn_g": 1.0 + nrm(ks[7], (DEPTH, D), 0.02),
        "ev_w_in": nrm(ks[8], (N_EVEN, D, EVEN_IN), D ** -0.5),
        "ev_w_out": nrm(ks[9], (N_EVEN, EVEN_OUT, D), EVEN_OUT ** -0.5),
        "ev_sink": nrm(ks[10], (N_EVEN, N_Q_HEADS), 0.5),
        "ev_conv_w": nrm(ks[11], (N_EVEN, CONV_B_K, CONV_B_WIDTH), CONV_B_K ** -0.5),
        "ev_conv_b": nrm(ks[12], (N_EVEN, CONV_B_WIDTH), 0.01),
        "od_w_in": nrm(ks[13], (N_ODD, D, 2 * LRU_WIDTH), D ** -0.5),
        "od_w_out": nrm(ks[14], (N_ODD, LRU_WIDTH, D), LRU_WIDTH ** -0.5),
        "od_conv_w": nrm(ks[15], (N_ODD, LRU_CONV_K, LRU_WIDTH), LRU_CONV_K ** -0.5),
        "od_conv_b": nrm(ks[16], (N_ODD, LRU_WIDTH), 0.01),
        "od_wa": nrm(ks[17], (N_ODD, 2, LRU_HEADS, LRU_BLOCK, LRU_BLOCK), LRU_BLOCK ** -0.5),
        "od_ba": nrm(ks[18], (N_ODD, 2, LRU_WIDTH), 0.01),
        "od_wx": nrm(ks[19], (N_ODD, 2, LRU_HEADS, LRU_BLOCK, LRU_BLOCK), LRU_BLOCK ** -0.5),
        "od_bx": nrm(ks[20], (N_ODD, 2, LRU_WIDTH), 0.01),
        "od_lambda": lam,
        "router_w": nrm(ks[23], (DEPTH, D, N_EXPERTS), D ** -0.5),
        "w_gate": nrm(ks[24], (DEPTH, N_EXPERTS, D, EXPERT_FF), D ** -0.5),
        "w_up": nrm(ks[25], (DEPTH, N_EXPERTS, D, EXPERT_FF), D ** -0.5),
        "w_down": nrm(ks[26], (DEPTH, N_EXPERTS, EXPERT_FF, D), EXPERT_FF ** -0.5),
        "final_g": 1.0 + nrm(ks[27], (D,), 0.02),
    }


def reference(x, c, ctx, c_ctx, ada_w, ada_b, norm_mix_g, norm_ffn_g, ev_w_in, ev_w_out, ev_sink,
              ev_conv_w, ev_conv_b, od_w_in, od_w_out, od_conv_w, od_conv_b, od_wa, od_ba, od_wx, od_bx,
              od_lambda, router_w, w_gate, w_up, w_down, final_g):
    n = x.shape[1]
    n_rows = n // GRID_W
    rows = jnp.broadcast_to(jnp.arange(n_rows)[:, None], (n_rows, GRID_W)).reshape(-1)
    cols = jnp.broadcast_to(jnp.arange(GRID_W)[None, :], (n_rows, GRID_W)).reshape(-1)
    s_lat = jax.nn.silu(c)
    s_ctx = jax.nn.silu(c_ctx)[None, :]
    xl, xc = x, ctx
    for l in range(DEPTH):
        last = l == DEPTH - 1
        m_l = [m[:, None, :] for m in jnp.split(s_lat @ ada_w[l] + ada_b[l], 6, axis=-1)]
        m_c = [m[:, None, :] for m in jnp.split(s_ctx @ ada_w[l] + ada_b[l], 6, axis=-1)]
        hl = modulate(rmsnorm(xl, norm_mix_g[l]), m_l[0], m_l[1])
        hc = modulate(rmsnorm(xc, norm_mix_g[l]), m_c[0], m_c[1])
        j = l // 2
        if l % 2 == 0:
            yl, yc = even_mixer(hl, hc, rows, cols, ev_w_in[j], ev_w_out[j], ev_sink[j],
                                ev_conv_w[j], ev_conv_b[j], not last)
        else:
            yl, yc = odd_mixer(hl, hc, od_w_in[j], od_w_out[j], od_conv_w[j], od_conv_b[j],
                               od_wa[j], od_ba[j], od_wx[j], od_bx[j], od_lambda[j], not last)
        xl = xl + m_l[2] * yl
        if not last:
            xc = xc + m_c[2] * yc
        hl = modulate(rmsnorm(xl, norm_ffn_g[l]), m_l[3], m_l[4])
        xl = xl + m_l[5] * expert_choice_ffn(hl, router_w[l], w_gate[l], w_up[l], w_down[l])
        if not last:
            hc = modulate(rmsnorm(xc, norm_ffn_g[l]), m_c[3], m_c[4])
            xc = xc + m_c[5] * expert_choice_ffn(hc, router_w[l], w_gate[l], w_up[l], w_down[l])
    return rmsnorm(xl, final_g)
```

```cpp
#include <hip/hip_runtime.h>
#include <cstdio>
#include <cstdint>

namespace {
typedef unsigned short bf16;
constexpr int D = 1024, NB = 8, SEQ = 4096, CTXL = 256;
constexpr int NL = NB * SEQ, NC = NB * CTXL, NT = NL + NC;
constexpr int NE = 16, FF = 1408, CAPL = 512, CAPC = 32;
constexpr int ME = NB * CAPL + NB * CAPC;
constexpr int EVIN = 2304;
constexpr float EPS = 1e-6f;

enum { I_X = 0, I_C, I_CTX, I_CCTX, I_ADAW, I_ADAB, I_NMIX, I_NFFN, I_EVWIN, I_EVWOUT, I_EVSINK, I_EVCW, I_EVCB,
       I_ODWIN, I_ODWOUT, I_ODCW, I_ODCB, I_ODWA, I_ODBA, I_ODWX, I_ODBX, I_ODLAM, I_RW, I_WG, I_WU, I_WD, I_FG, N_IN };

constexpr size_t MiB = 1u << 20;
constexpr size_t OFF_MODV = 0;
constexpr size_t OFF_ROPE = 512 * 1024;
constexpr size_t OFF_AFFL = 1 * MiB;
constexpr size_t OFF_AFFC = 3 * MiB;
constexpr size_t OFF_ROWL = 4 * MiB;
constexpr size_t OFF_GATEV = 5 * MiB;
constexpr size_t OFF_SLOT = 6 * MiB;
constexpr size_t OFF_XRES = 32 * MiB;
constexpr size_t OFF_H = 168 * MiB;
constexpr size_t OFF_MIX = 236 * MiB;
constexpr size_t OFF_Y = OFF_H;
constexpr size_t OFF_PROJ = 304 * MiB;
constexpr size_t OFF_HID = OFF_PROJ;
constexpr size_t OFF_H1 = OFF_PROJ;
constexpr size_t OFF_UC = OFF_PROJ;
constexpr size_t OFF_Z = 372 * MiB;

struct P { const float* in[N_IN]; float* out; char* ws; };

__device__ __forceinline__ float bf2f(unsigned v) { return __uint_as_float(v << 16); }
__device__ __forceinline__ unsigned f2bf(float f) { unsigned u = __float_as_uint(f); return (u + 0x7fffu + ((u >> 16) & 1u)) >> 16; }
__device__ __forceinline__ unsigned pk2(float lo, float hi) { return f2bf(lo) | (f2bf(hi) << 16); }
__device__ __forceinline__ float wave_sum(float v) {
#pragma unroll
    for (int o = 1; o < 64; o <<= 1) v += __shfl_xor(v, o);
    return v;
}
__device__ __forceinline__ float wave_max(float v) {
#pragma unroll
    for (int o = 1; o < 64; o <<= 1) v = fmaxf(v, __shfl_xor(v, o));
    return v;
}
__device__ __forceinline__ float sigmoidf_(float x) { return 1.f / (1.f + expf(-x)); }
__device__ __forceinline__ int mod_row(int r) { return r < NL ? (r >> 12) : 8; }
__device__ __forceinline__ const float* in_row(const P& p, int r) { return r < NL ? p.in[I_X] + (size_t)r * D : p.in[I_CTX] + (size_t)(r - NL) * D; }

__device__ void ph_mod(const P& p, float* sm) {
    float* modv = (float*)(p.ws + OFF_MODV);
    for (int i = threadIdx.x; i < 9 * 1024; i += blockDim.x) {
        int r = i >> 10, k = i & 1023; float v = (r < 8) ? p.in[I_C][r * 1024 + k] : p.in[I_CCTX][k];
        sm[i] = v / (1.f + expf(-v));
    }
    __syncthreads();
    for (int item = blockIdx.x; item < 24; item += gridDim.x) {
        const int l = item / 12, j = (item % 12) * 512 + threadIdx.x;
        const float* w = p.in[I_ADAW] + (size_t)l * 1024 * 6144 + j;
        float acc[9];
#pragma unroll
        for (int r = 0; r < 9; ++r) acc[r] = 0.f;
#pragma unroll 4
        for (int k = 0; k < 1024; ++k) {
            const float wv = w[(size_t)k * 6144];
#pragma unroll
            for (int r = 0; r < 9; ++r) acc[r] += sm[r * 1024 + k] * wv;
        }
        const float bb = p.in[I_ADAB][l * 6144 + j];
#pragma unroll
        for (int r = 0; r < 9; ++r) modv[(l * 9 + r) * 6144 + j] = acc[r] + bb;
    }
    if (blockIdx.x == gridDim.x - 1) {
        float* tab = (float*)(p.ws + OFF_ROPE);
        for (int i = threadIdx.x; i < 1024; i += blockDim.x) {
            const int pos = i >> 4, f = i & 15;
            const float inv = powf(10000.f, -(float)f / 16.f);
            const float ang = (float)pos * inv;
            tab[i * 2] = cosf(ang); tab[i * 2 + 1] = sinf(ang);
        }
    }
}

template <bool ROUTER>
__device__ void ph_norm(const P& p, int l, bool first, const float* gvec, int shift_idx, int nrows, bf16* hout) {
    const float* modv = (const float*)(p.ws + OFF_MODV);
    const float* xres = (const float*)(p.ws + OFF_XRES);
    const int lane = threadIdx.x & 63, wave = threadIdx.x >> 6;
    for (int r = blockIdx.x * 8 + wave; r < nrows; r += gridDim.x * 8) {
        const float4* xr = (const float4*)(first ? in_row(p, r) : xres + (size_t)r * D);
        float4 v[4]; float ss = 0.f;
#pragma unroll
        for (int j = 0; j < 4; ++j) { v[j] = xr[lane + 64 * j]; ss += v[j].x * v[j].x + v[j].y * v[j].y + v[j].z * v[j].z + v[j].w * v[j].w; }
        ss = wave_sum(ss);
        const float rstd = 1.f / sqrtf(ss * (1.f / D) + EPS);
        const float* mv = modv + (size_t)(l * 9 + mod_row(r)) * 6144;
        const float4* sh4 = (const float4*)(mv + shift_idx * 1024);
        const float4* sc4 = (const float4*)(mv + (shift_idx + 1) * 1024);
        const float4* g4 = (const float4*)gvec;
        const float* rw = p.in[I_RW] + (size_t)l * 1024 * 16;
        float part[16];
#pragma unroll
        for (int e = 0; e < 16; ++e) part[e] = 0.f;
#pragma unroll 1
        for (int j = 0; j < 4; ++j) {
            const float4 xv = xr[lane + 64 * j];
            const float4 g = g4[lane + 64 * j], sh = sh4[lane + 64 * j], sc = sc4[lane + 64 * j];
            float hh[4];
            hh[0] = xv.x * rstd * g.x * (1.f + sc.x) + sh.x;
            hh[1] = xv.y * rstd * g.y * (1.f + sc.y) + sh.y;
            hh[2] = xv.z * rstd * g.z * (1.f + sc.z) + sh.z;
            hh[3] = xv.w * rstd * g.w * (1.f + sc.w) + sh.w;
            uint2 o; o.x = pk2(hh[0], hh[1]); o.y = pk2(hh[2], hh[3]);
            *(uint2*)(hout + (size_t)r * D + (lane + 64 * j) * 4) = o;
            if (ROUTER) {
#pragma unroll
                for (int i = 0; i < 4; ++i) {
                    const float4* w4 = (const float4*)(rw + (size_t)((lane + 64 * j) * 4 + i) * 16);
#pragma unroll
                    for (int q = 0; q < 4; ++q) { const float4 w = w4[q]; part[q * 4 + 0] += hh[i] * w.x; part[q * 4 + 1] += hh[i] * w.y; part[q * 4 + 2] += hh[i] * w.z; part[q * 4 + 3] += hh[i] * w.w; }
                }
            }
        }
        if (ROUTER) {
            float mx = -1e30f;
#pragma unroll
            for (int e = 0; e < 16; ++e) { part[e] = wave_sum(part[e]); mx = fmaxf(mx, part[e]); }
            float den = 0.f, mine = 0.f;
#pragma unroll
            for (int e = 0; e < 16; ++e) { const float ex = expf(part[e] - mx); den += ex; if (lane == e) mine = ex; }
            if (lane < 16) {
                const float a = mine / den;
                if (r < NL) { const int b = r >> 12, t = r & 4095; ((float*)(p.ws + OFF_AFFL))[(size_t)(b * 16 + lane) * SEQ + t] = a; }
                else { const int rc = r - NL, b = rc >> 8, t = rc & 255; ((float*)(p.ws + OFF_AFFC))[(size_t)(b * 16 + lane) * CTXL + t] = a; }
            }
        }
    }
}

template <bool DUAL, class ARow, class Epi>
__device__ __forceinline__ void ngemm_tile(int m0, int n0, int K, const ARow& arow, const float* B0, const float* B1, int ldb, const Epi& epi, float* sm) {
    float* As = sm; float* Bs0 = sm + 16 * 132; float* Bs1 = Bs0 + 16 * 64;
    const int tid = threadIdx.x, ty = tid >> 4, tx = tid & 15;
    float acc0[4][4], acc1[4][4];
#pragma unroll
    for (int i = 0; i < 4; ++i)
#pragma unroll
        for (int j = 0; j < 4; ++j) { acc0[i][j] = 0.f; acc1[i][j] = 0.f; }
    const int ar = tid >> 2, akq = (tid & 3) * 4;
    const bf16* aptr = arow(m0 + ar) + akq;
    const bool second = DUAL && tid >= 256;
    const bool doB = DUAL || tid < 256;
    const int br = (tid & 255) >> 4, bc = (tid & 15) * 4;
    const float* bptr = (second ? B1 : B0) + (size_t)br * ldb + n0 + bc;
    float* bdst = (second ? Bs1 : Bs0) + br * 64 + bc;
    for (int k0 = 0; k0 < K; k0 += 16) {
        const uint2 av = *(const uint2*)(aptr + k0);
        float4 bv = make_float4(0.f, 0.f, 0.f, 0.f);
        if (doB) bv = *(const float4*)(bptr + (size_t)k0 * ldb);
        __syncthreads();
        As[(akq + 0) * 132 + ar] = bf2f(av.x & 0xffffu); As[(akq + 1) * 132 + ar] = bf2f(av.x >> 16);
        As[(akq + 2) * 132 + ar] = bf2f(av.y & 0xffffu); As[(akq + 3) * 132 + ar] = bf2f(av.y >> 16);
        if (doB) *(float4*)bdst = bv;
        __syncthreads();
#pragma unroll
        for (int kk = 0; kk < 16; ++kk) {
            const float4 a = *(const float4*)&As[kk * 132 + ty * 4];
            const float4 b = *(const float4*)&Bs0[kk * 64 + tx * 4];
            const float aa[4] = {a.x, a.y, a.z, a.w}, bb[4] = {b.x, b.y, b.z, b.w};
#pragma unroll
            for (int i = 0; i < 4; ++i)
#pragma unroll
                for (int j = 0; j < 4; ++j) acc0[i][j] += aa[i] * bb[j];
            if (DUAL) {
                const float4 b1 = *(const float4*)&Bs1[kk * 64 + tx * 4];
                const float cc[4] = {b1.x, b1.y, b1.z, b1.w};
#pragma unroll
                for (int i = 0; i < 4; ++i)
#pragma unroll
                    for (int j = 0; j < 4; ++j) acc1[i][j] += aa[i] * cc[j];
            }
        }
    }
#pragma unroll
    for (int i = 0; i < 4; ++i) epi(m0 + ty * 4 + i, n0 + tx * 4, acc0[i], acc1[i]);
}

struct ARowPlain { const bf16* base; int ld; __device__ const bf16* operator()(int m) const { return base + (size_t)m * ld; } };
struct ARowGather { const bf16* base; const int* idx; int ld; __device__ const bf16* operator()(int m) const { return base + (size_t)idx[m] * ld; } };

__device__ __forceinline__ void store_bf16x4(bf16* dst, const float* v) { uint2 o; o.x = pk2(v[0], v[1]); o.y = pk2(v[2], v[3]); *(uint2*)dst = o; }

__device__ void ph_inproj_even(const P& p, float* sm) {
    const bf16* H = (const bf16*)(p.ws + OFF_H); bf16* PROJ = (bf16*)(p.ws + OFF_PROJ);
    const int nn = EVIN / 64, nitems = (NT / 128) * nn;
    ARowPlain ar{H, D};
    auto epi = [&](int m, int n, const float* a0, const float*) { store_bf16x4(PROJ + (size_t)m * EVIN + n, a0); };
    for (int it = blockIdx.x; it < nitems; it += gridDim.x) ngemm_tile<false>((it / nn) * 128, (it % nn) * 64, D, ar, p.in[I_EVWIN], nullptr, EVIN, epi, sm);
}
__device__ void ph_rope(const P& p) {
    bf16* PROJ = (bf16*)(p.ws + OFF_PROJ); const float* tab = (const float*)(p.ws + OFF_ROPE);
    const size_t total = (size_t)NL * 320;
    for (size_t i = (size_t)blockIdx.x * blockDim.x + threadIdx.x; i < total; i += (size_t)gridDim.x * blockDim.x) {
        const int r = (int)(i / 320), rem = (int)(i % 320), hh = rem >> 5, pi = rem & 31;
        const int part = pi >> 4, f = pi & 15, t = r & 4095;
        const int pos = part == 0 ? (t >> 6) : (t & 63);
        const float c = tab[(pos * 16 + f) * 2], s = tab[(pos * 16 + f) * 2 + 1];
        bf16* base = PROJ + (size_t)r * EVIN + (hh < 8 ? hh * 64 : 512 + (hh - 8) * 64) + part * 32 + f;
        const float x1 = bf2f(base[0]), x2 = bf2f(base[16]);
        base[0] = (bf16)f2bf(x1 * c - x2 * s); base[16] = (bf16)f2bf(x2 * c + x1 * s);
    }
}
__device__ void ph_attn(const P& p, float* sm) {
    const bf16* PROJ = (const bf16*)(p.ws + OFF_PROJ); bf16* MIX = (bf16*)(p.ws + OFF_MIX);
    const int lane = threadIdx.x & 63, wave = threadIdx.x >> 6;
    float* qs = sm + wave * 640; float* sc = qs + 64;
    const int nitems = NT * 8;
    for (int it = blockIdx.x * 8 + wave; it < nitems; it += gridDim.x * 8) {
        const int r = it >> 3, h = it & 7, hk = h >> 2;
        int b, t, nloc, tlo;
        if (r < NL) { b = r >> 12; t = r & 4095; tlo = max(0, t - 128); const int thi = min(SEQ - 1, t + 128); nloc = thi - tlo + 1; }
        else { const int rc = r - NL; b = rc >> 8; t = rc & 255; tlo = 0; nloc = 0; }
        const int nk = nloc + CTXL;
        qs[lane] = bf2f(PROJ[(size_t)r * EVIN + h * 64 + lane]) * 0.125f;
        __builtin_amdgcn_wave_barrier();
        float mx = p.in[I_EVSINK][h];
        for (int kk = lane; kk < nk; kk += 64) {
            const int krow = kk < nloc ? (b * SEQ + tlo + kk) : (NL + b * CTXL + (kk - nloc));
            const uint4* kp = (const uint4*)(PROJ + (size_t)krow * EVIN + 512 + hk * 64);
            float s = 0.f;
#pragma unroll
            for (int c = 0; c < 8; ++c) {
                const uint4 kv = kp[c];
                const unsigned w[4] = {kv.x, kv.y, kv.z, kv.w};
#pragma unroll
                for (int q = 0; q < 4; ++q) s += qs[c * 8 + q * 2] * bf2f(w[q] & 0xffffu) + qs[c * 8 + q * 2 + 1] * bf2f(w[q] >> 16);
            }
            sc[kk] = s; mx = fmaxf(mx, s);
        }
        mx = wave_max(mx);
        float den = 0.f;
        for (int kk = lane; kk < nk; kk += 64) { const float e = expf(sc[kk] - mx); sc[kk] = e; den += e; }
        den = wave_sum(den) + expf(p.in[I_EVSINK][h] - mx);
        __builtin_amdgcn_wave_barrier();
        float o = 0.f;
        for (int kk = 0; kk < nk; ++kk) {
            const int krow = kk < nloc ? (b * SEQ + tlo + kk) : (NL + b * CTXL + (kk - nloc));
            o += sc[kk] * bf2f(PROJ[(size_t)krow * EVIN + 640 + hk * 64 + lane]);
        }
        MIX[(size_t)r * D + h * 64 + lane] = (bf16)f2bf(o / den);
        __builtin_amdgcn_wave_barrier();
    }
}
__device__ void ph_conv3(const P& p) {
    const bf16* PROJ = (const bf16*)(p.ws + OFF_PROJ); bf16* MIX = (bf16*)(p.ws + OFF_MIX);
    const float* cw = p.in[I_EVCW]; const float* cb = p.in[I_EVCB];
    const size_t total = (size_t)NT * 512;
    for (size_t i = (size_t)blockIdx.x * blockDim.x + threadIdx.x; i < total; i += (size_t)gridDim.x * blockDim.x) {
        const int r = (int)(i >> 9), j = (int)(i & 511);
        int t, len; if (r < NL) { t = r & 4095; len = SEQ; } else { t = (r - NL) & 255; len = CTXL; }
        float acc = cb[j];
#pragma unroll
        for (int k = 0; k < 3; ++k) {
            const int tt = t - 1 + k;
            if (tt >= 0 && tt < len) { const bf16* row = PROJ + (size_t)(r - 1 + k) * EVIN; acc += cw[k * 512 + j] * bf2f(row[1280 + j]) * bf2f(row[1792 + j]); }
        }
        MIX[(size_t)r * D + 512 + j] = (bf16)f2bf(bf2f(PROJ[(size_t)r * EVIN + 768 + j]) * acc);
    }
}
__device__ void ph_outproj(const P& p, int l, bool first, const float* wout, float* sm) {
    const bf16* MIX = (const bf16*)(p.ws + OFF_MIX); float* xres = (float*)(p.ws + OFF_XRES);
    const float* modv = (const float*)(p.ws + OFF_MODV);
    const int nn = D / 64, nitems = (NT / 128) * nn;
    ARowPlain ar{MIX, D};
    auto epi = [&](int m, int n, const float* a0, const float*) {
        const float* rs = first ? in_row(p, m) : xres + (size_t)m * D;
        const float4 x = *(const float4*)(rs + n);
        const float4 g = *(const float4*)(modv + (size_t)(l * 9 + mod_row(m)) * 6144 + 2 * 1024 + n);
        float4 o; o.x = x.x + g.x * a0[0]; o.y = x.y + g.y * a0[1]; o.z = x.z + g.z * a0[2]; o.w = x.w + g.w * a0[3];
        *(float4*)(xres + (size_t)m * D + n) = o;
    };
    for (int it = blockIdx.x; it < nitems; it += gridDim.x) ngemm_tile<false>((it / nn) * 128, (it % nn) * 64, D, ar, wout, nullptr, D, epi, sm);
}
__device__ void ph_topk(const P& p, bool with_ctx, float* sm) {
    int* rowl = (int*)(p.ws + OFF_ROWL); float* gatev = (float*)(p.ws + OFF_GATEV); int* slot = (int*)(p.ws + OFF_SLOT);
    const int nitems = with_ctx ? 256 : 128;
    for (int it = blockIdx.x; it < nitems; it += gridDim.x) {
        const bool isc = it >= 128; const int be = it & 127, b = be >> 4, e = be & 15;
        const int n = isc ? CTXL : SEQ, cap = isc ? CAPC : CAPL;
        const float* aff = isc ? (const float*)(p.ws + OFF_AFFC) + (size_t)be * CTXL : (const float*)(p.ws + OFF_AFFL) + (size_t)be * SEQ;
        __syncthreads();
        for (int i = threadIdx.x; i < n; i += blockDim.x) sm[i] = aff[i];
        __syncthreads();
        const int base = isc ? (NB * CAPL + b * CAPC) : b * CAPL;
        const int rowbase = isc ? (NL + b * CTXL) : b * SEQ;
        for (int i = threadIdx.x; i < n; i += blockDim.x) {
            const float v = sm[i]; int rank = 0;
            for (int j = 0; j < n; ++j) { const float w = sm[j]; rank += (w > v || (w == v && j < i)) ? 1 : 0; }
            if (rank < cap) { rowl[e * ME + base + rank] = rowbase + i; gatev[e * ME + base + rank] = v; slot[(size_t)e * NT + rowbase + i] = base + rank; }
            else slot[(size_t)e * NT + rowbase + i] = -1;
        }
    }
}
__device__ __forceinline__ float siluf_(float x) { return x / (1.f + expf(-x)); }
__device__ void ph_moe_up(const P& p, int l, int Me, float* sm) {
    const bf16* H = (const bf16*)(p.ws + OFF_H); bf16* HID = (bf16*)(p.ws + OFF_HID); const int* rowl = (const int*)(p.ws + OFF_ROWL);
    const int nn = FF / 64, mm = Me / 128, nitems = NE * mm * nn;
    for (int it = blockIdx.x; it < nitems; it += gridDim.x) {
        const int e = it / (mm * nn), rem = it % (mm * nn), m0 = (rem / nn) * 128, n0 = (rem % nn) * 64;
        ARowGather ar{H, rowl + e * ME, D};
        bf16* hid = HID + (size_t)e * ME * FF;
        auto epi = [&](int m, int n, const float* a0, const float* a1) {
            float v[4];
#pragma unroll
            for (int j = 0; j < 4; ++j) v[j] = siluf_(a0[j]) * a1[j];
            store_bf16x4(hid + (size_t)m * FF + n, v);
        };
        const size_t wo = (size_t)(l * NE + e) * D * FF;
        ngemm_tile<true>(m0, n0, D, ar, p.in[I_WG] + wo, p.in[I_WU] + wo, FF, epi, sm);
    }
}
__device__ void ph_moe_down(const P& p, int l, int Me, float* sm) {
    const bf16* HID = (const bf16*)(p.ws + OFF_HID); bf16* Y = (bf16*)(p.ws + OFF_Y);
    const int nn = D / 64, mm = Me / 128, nitems = NE * mm * nn;
    for (int it = blockIdx.x; it < nitems; it += gridDim.x) {
        const int e = it / (mm * nn), rem = it % (mm * nn), m0 = (rem / nn) * 128, n0 = (rem % nn) * 64;
        ARowPlain ar{HID + (size_t)e * ME * FF, FF};
        bf16* y = Y + (size_t)e * ME * D;
        auto epi = [&](int m, int n, const float* a0, const float*) { store_bf16x4(y + (size_t)m * D + n, a0); };
        ngemm_tile<false>(m0, n0, FF, ar, p.in[I_WD] + (size_t)(l * NE + e) * FF * D, nullptr, D, epi, sm);
    }
}
__device__ void ph_combine(const P& p, int l, bool last, int nrows) {
    const float* modv = (const float*)(p.ws + OFF_MODV); float* xres = (float*)(p.ws + OFF_XRES);
    const bf16* Y = (const bf16*)(p.ws + OFF_Y); const float* gatev = (const float*)(p.ws + OFF_GATEV); const int* slot = (const int*)(p.ws + OFF_SLOT);
    bf16* H1 = (bf16*)(p.ws + OFF_H1);
    const int lane = threadIdx.x & 63, wave = threadIdx.x >> 6;
    for (int r = blockIdx.x * 8 + wave; r < nrows; r += gridDim.x * 8) {
        float4 acc[4];
#pragma unroll
        for (int j = 0; j < 4; ++j) acc[j] = make_float4(0.f, 0.f, 0.f, 0.f);
        for (int e = 0; e < NE; ++e) {
            const int s = slot[(size_t)e * NT + r];
            if (s >= 0) {
                const float g = gatev[e * ME + s];
                const uint2* yr = (const uint2*)(Y + ((size_t)e * ME + s) * D);
#pragma unroll
                for (int j = 0; j < 4; ++j) { const uint2 w = yr[lane + 64 * j];
                    acc[j].x += g * bf2f(w.x & 0xffffu); acc[j].y += g * bf2f(w.x >> 16); acc[j].z += g * bf2f(w.y & 0xffffu); acc[j].w += g * bf2f(w.y >> 16); }
            }
        }
        const float* mv = modv + (size_t)(l * 9 + mod_row(r)) * 6144;
        float4* xr = (float4*)(xres + (size_t)r * D);
        float4 v[4]; float ss = 0.f;
#pragma unroll
        for (int j = 0; j < 4; ++j) {
            const float4 x = xr[lane + 64 * j]; const float4 g5 = ((const float4*)(mv + 5 * 1024))[lane + 64 * j];
            v[j].x = x.x + g5.x * acc[j].x; v[j].y = x.y + g5.y * acc[j].y; v[j].z = x.z + g5.z * acc[j].z; v[j].w = x.w + g5.w * acc[j].w;
            ss += v[j].x * v[j].x + v[j].y * v[j].y + v[j].z * v[j].z + v[j].w * v[j].w;
        }
        ss = wave_sum(ss);
        const float rstd = 1.f / sqrtf(ss * (1.f / D) + EPS);
        if (last) {
            float4* o = (float4*)(p.out + (size_t)r * D); const float4* g4 = (const float4*)p.in[I_FG];
#pragma unroll
            for (int j = 0; j < 4; ++j) { const float4 g = g4[lane + 64 * j]; float4 w; w.x = v[j].x * rstd * g.x; w.y = v[j].y * rstd * g.y; w.z = v[j].z * rstd * g.z; w.w = v[j].w * rstd * g.w; o[lane + 64 * j] = w; }
        } else {
            const float* mv1 = modv + (size_t)((l + 1) * 9 + mod_row(r)) * 6144;
            const float4* g4 = (const float4*)(p.in[I_NMIX] + (l + 1) * 1024);
#pragma unroll
            for (int j = 0; j < 4; ++j) {
                xr[lane + 64 * j] = v[j];
                const float4 g = g4[lane + 64 * j], sh = ((const float4*)mv1)[lane + 64 * j], sc = ((const float4*)(mv1 + 1024))[lane + 64 * j];
                uint2 o; o.x = pk2(v[j].x * rstd * g.x * (1.f + sc.x) + sh.x, v[j].y * rstd * g.y * (1.f + sc.y) + sh.y);
                o.y = pk2(v[j].z * rstd * g.z * (1.f + sc.z) + sh.z, v[j].w * rstd * g.w * (1.f + sc.w) + sh.w);
                *(uint2*)(H1 + (size_t)r * D + (lane + 64 * j) * 4) = o;
            }
        }
    }
}
__device__ void ph_inproj_odd(const P& p, float* sm) {
    const bf16* H1 = (const bf16*)(p.ws + OFF_H1); bf16* G = (bf16*)(p.ws + OFF_MIX); bf16* U = (bf16*)(p.ws + OFF_H);
    const int nn = 2048 / 64, nitems = (NT / 128) * nn;
    ARowPlain ar{H1, D};
    auto epi = [&](int m, int n, const float* a0, const float*) { if (n < 1024) store_bf16x4(G + (size_t)m * D + n, a0); else store_bf16x4(U + (size_t)m * D + n - 1024, a0); };
    for (int it = blockIdx.x; it < nitems; it += gridDim.x) ngemm_tile<false>((it / nn) * 128, (it % nn) * 64, D, ar, p.in[I_ODWIN], nullptr, 2048, epi, sm);
}
__device__ void ph_conv4(const P& p) {
    const bf16* U = (const bf16*)(p.ws + OFF_H); bf16* UC = (bf16*)(p.ws + OFF_UC);
    const float* cw = p.in[I_ODCW]; const float* cb = p.in[I_ODCB];
    const size_t total = (size_t)NT * D;
    for (size_t i = (size_t)blockIdx.x * blockDim.x + threadIdx.x; i < total; i += (size_t)gridDim.x * blockDim.x) {
        const int r = (int)(i >> 10), ch = (int)(i & 1023);
        int t, len; if (r < NL) { t = r & 4095; len = SEQ; } else { t = (r - NL) & 255; len = CTXL; }
        float acc = cb[ch];
#pragma unroll
        for (int k = 0; k < 4; ++k) { const int tt = t - 2 + k; if (tt >= 0 && tt < len) acc += cw[k * 1024 + ch] * bf2f(U[(size_t)(r - 2 + k) * D + ch]); }
        UC[i] = (bf16)f2bf(acc);
    }
}
__device__ void ph_gates(const P& p, float* sm) {
    const bf16* UC = (const bf16*)(p.ws + OFF_UC); bf16* Z = (bf16*)(p.ws + OFF_Z);
    const int mm = NT / 128, per = mm * 2, nitems = 32 * per;
    for (int it = blockIdx.x; it < nitems; it += gridDim.x) {
        const int g = it / per, rem = it % per, m0 = (rem >> 1) * 128, n0 = (rem & 1) * 64;
        const int d = g >> 4, type = (g >> 3) & 1, h = g & 7;
        ARowPlain ar{UC + h * 128, D};
        const float* W = (type ? p.in[I_ODWX] : p.in[I_ODWA]) + (size_t)(d * 8 + h) * 128 * 128;
        const float* bias = (type ? p.in[I_ODBX] : p.in[I_ODBA]) + d * 1024 + h * 128;
        bf16* z = Z + d * 2048 + type * 1024 + h * 128;
        auto epi = [&](int m, int n, const float* a0, const float*) {
            float v[4];
#pragma unroll
            for (int j = 0; j < 4; ++j) v[j] = a0[j] + bias[n + j];
            store_bf16x4(z + (size_t)m * 4096 + n, v);
        };
        ngemm_tile<false>(m0, n0, 128, ar, W, nullptr, 128, epi, sm);
    }
}
__device__ __forceinline__ float gelu_tanh(float x) { const float u = 0.7978845608028654f * (x + 0.044715f * x * x * x); return 0.5f * x * (1.f + tanhf(u)); }
__device__ void ph_scan(const P& p) {
    const bf16* UC = (const bf16*)(p.ws + OFF_UC); bf16* Z = (bf16*)(p.ws + OFF_Z); bf16* G = (bf16*)(p.ws + OFF_MIX);
    for (int i = blockIdx.x * blockDim.x + threadIdx.x; i < NB * D; i += gridDim.x * blockDim.x) {
        const int b = i >> 10, ch = i & 1023;
        for (int d = 0; d < 2; ++d) {
            const float lam = p.in[I_ODLAM][d * 1024 + ch];
            const float c8 = -8.f * log1pf(expf(-lam));
            float h = 0.f;
            const int total = CTXL + SEQ;
            for (int s0 = 0; s0 < total; s0 += 8) {
                float zr[8], zi[8], uu[8]; size_t rows[8];
#pragma unroll
                for (int q = 0; q < 8; ++q) {
                    const int s = s0 + q; int r;
                    if (s < CTXL) r = NL + b * CTXL + (d == 0 ? s : CTXL - 1 - s);
                    else { const int t = s - CTXL; r = b * SEQ + (d == 0 ? t : SEQ - 1 - t); }
                    rows[q] = (size_t)r;
                    zr[q] = bf2f(Z[(size_t)r * 4096 + d * 2048 + ch]); zi[q] = bf2f(Z[(size_t)r * 4096 + d * 2048 + 1024 + ch]); uu[q] = bf2f(UC[(size_t)r * D + ch]);
                }
#pragma unroll
                for (int q = 0; q < 8; ++q) {
                    const float rr = sigmoidf_(zr[q]), ii = sigmoidf_(zi[q]);
                    const float la = c8 * rr, a = expf(la), mult = sqrtf(-expm1f(2.f * la));
                    h = a * h + mult * ii * uu[q];
                    if (s0 >= CTXL) {
                        if (d == 0) Z[rows[q] * 4096 + ch] = (bf16)f2bf(h);
                        else { const float hf = bf2f(Z[rows[q] * 4096 + ch]); const float g = bf2f(G[rows[q] * D + ch]); G[rows[q] * D + ch] = (bf16)f2bf(gelu_tanh(g) * (hf + h)); }
                    }
                }
            }
        }
    }
}

enum { PH_MOD = 0, PH_NORM0, PH_INPROJ_E, PH_ROPE, PH_ATTN, PH_CONV3, PH_OUTPROJ0, PH_NORMF0, PH_TOPK0, PH_UP0, PH_DOWN0, PH_COMB0,
       PH_INPROJ_O, PH_CONV4, PH_GATES, PH_SCAN, PH_OUTPROJ1, PH_NORMF1, PH_TOPK1, PH_UP1, PH_DOWN1, PH_COMB1, PH_COUNT };

template <int PH> __global__ void __launch_bounds__(512) k_ph(P p) {
    __shared__ __attribute__((aligned(16))) float sm[9216];
    if (PH == PH_MOD) ph_mod(p, sm);
    if (PH == PH_NORM0) ph_norm<false>(p, 0, true, p.in[I_NMIX], 0, NT, (bf16*)(p.ws + OFF_H));
    if (PH == PH_INPROJ_E) ph_inproj_even(p, sm);
    if (PH == PH_ROPE) ph_rope(p);
    if (PH == PH_ATTN) ph_attn(p, sm);
    if (PH == PH_CONV3) ph_conv3(p);
    if (PH == PH_OUTPROJ0) ph_outproj(p, 0, true, p.in[I_EVWOUT], sm);
    if (PH == PH_NORMF0) ph_norm<true>(p, 0, false, p.in[I_NFFN], 3, NT, (bf16*)(p.ws + OFF_H));
    if (PH == PH_TOPK0) ph_topk(p, true, sm);
    if (PH == PH_UP0) ph_moe_up(p, 0, ME, sm);
    if (PH == PH_DOWN0) ph_moe_down(p, 0, ME, sm);
    if (PH == PH_COMB0) ph_combine(p, 0, false, NT);
    if (PH == PH_INPROJ_O) ph_inproj_odd(p, sm);
    if (PH == PH_CONV4) ph_conv4(p);
    if (PH == PH_GATES) ph_gates(p, sm);
    if (PH == PH_SCAN) ph_scan(p);
    if (PH == PH_OUTPROJ1) ph_outproj(p, 1, false, p.in[I_ODWOUT], sm);
    if (PH == PH_NORMF1) ph_norm<true>(p, 1, false, p.in[I_NFFN] + 1024, 3, NL, (bf16*)(p.ws + OFF_H));
    if (PH == PH_TOPK1) ph_topk(p, false, sm);
    if (PH == PH_UP1) ph_moe_up(p, 1, NB * CAPL, sm);
    if (PH == PH_DOWN1) ph_moe_down(p, 1, NB * CAPL, sm);
    if (PH == PH_COMB1) ph_combine(p, 1, true, NL);
}

template <int PH> void launch_all(const P& p, hipStream_t stream) {
    hipLaunchKernelGGL(k_ph<PH>, dim3(1024), dim3(512), 0, stream, p);
    if constexpr (PH + 1 < PH_COUNT) launch_all<PH + 1>(p, stream);
}
}

extern "C" void kernel_launch(void* const* d_in, const int* in_sizes, int n_in, void* d_out, int out_size, void* d_ws, size_t ws_size, hipStream_t stream) {
    if (n_in != N_IN || ws_size < 644 * MiB) { fprintf(stderr, "kernel_launch: unexpected n_in %d or ws_size %zu\n", n_in, ws_size); return; }
    P p{};
    for (int i = 0; i < N_IN; ++i) p.in[i] = (const float*)d_in[i];
    p.out = (float*)d_out; p.ws = (char*)d_ws;
    launch_all<0>(p, stream);
}
```

```cpp
#include <hip/hip_runtime.h>
#include <hip/hip_cooperative_groups.h>
#include <cstdio>
#include <cstdint>

namespace {
typedef unsigned short bf16;
constexpr int D = 1024, NB = 8, SEQ = 4096, CTXL = 256;
constexpr int NL = NB * SEQ, NC = NB * CTXL, NT = NL + NC;
constexpr int NE = 16, FF = 1408, CAPL = 512, CAPC = 32;
constexpr int ME = NB * CAPL + NB * CAPC;
constexpr int EVIN = 2304;
constexpr float EPS = 1e-6f;
constexpr float Y8_SCALE = 16.f;

enum { I_X = 0, I_C, I_CTX, I_CCTX, I_ADAW, I_ADAB, I_NMIX, I_NFFN, I_EVWIN, I_EVWOUT, I_EVSINK, I_EVCW, I_EVCB,
       I_ODWIN, I_ODWOUT, I_ODCW, I_ODCB, I_ODWA, I_ODBA, I_ODWX, I_ODBX, I_ODLAM, I_RW, I_WG, I_WU, I_WD, I_FG, N_IN };

constexpr size_t MiB = 1u << 20;
constexpr size_t OFF_MODV = 0;
constexpr size_t OFF_ROPE = 512 * 1024;
constexpr size_t OFF_AFFL = 1 * MiB;
constexpr size_t OFF_AFFC = 3 * MiB;
constexpr size_t OFF_ROWL = 4 * MiB;
constexpr size_t OFF_GATEV = 5 * MiB;
constexpr size_t OFF_SLOT = 6 * MiB;
constexpr size_t OFF_VTL = 8 * MiB + 512 * 1024;
constexpr size_t OFF_KFL = 624 * MiB;
constexpr size_t OFF_KFC = 632 * MiB;
constexpr size_t OFF_WT_GATES = 30 * MiB;
constexpr size_t OFF_VTC = 31 * MiB;
constexpr size_t OFF_XRES = 32 * MiB;
constexpr size_t OFF_H = 168 * MiB;
constexpr size_t OFF_MIX = 236 * MiB;
constexpr size_t OFF_XE = OFF_MIX;
constexpr size_t OFF_Y = OFF_H;
constexpr size_t OFF_PROJ = 304 * MiB;
constexpr size_t OFF_HID = OFF_PROJ;
constexpr size_t OFF_H1 = OFF_PROJ;
constexpr size_t OFF_UC = OFF_PROJ;
constexpr size_t OFF_HF = 372 * MiB;
constexpr size_t OFF_HB = 168 * MiB;
constexpr size_t OFF_Z = 372 * MiB;

struct P { const float* in[N_IN]; float* out; char* ws; };

__device__ __forceinline__ float bf2f(unsigned v) { return __uint_as_float(v << 16); }
__device__ __forceinline__ unsigned f2bf(float f) { unsigned u = __float_as_uint(f); return (u + 0x7fffu + ((u >> 16) & 1u)) >> 16; }
__device__ __forceinline__ unsigned pk2(float lo, float hi) { unsigned r; asm("v_cvt_pk_bf16_f32 %0, %1, %2" : "=v"(r) : "v"(lo), "v"(hi)); return r; }
__device__ __forceinline__ float wave_sum(float v) {
#pragma unroll
    for (int o = 1; o < 64; o <<= 1) v += __shfl_xor(v, o);
    return v;
}
__device__ __forceinline__ float wave_max(float v) {
#pragma unroll
    for (int o = 1; o < 64; o <<= 1) v = fmaxf(v, __shfl_xor(v, o));
    return v;
}
__device__ __forceinline__ int otid() { int t = threadIdx.x; asm volatile("" : "+v"(t)); return t; }
__device__ __forceinline__ int mod_row(int r) { return r < NL ? (r >> 12) : 8; }
__device__ __forceinline__ const float* in_row(const P& p, int r) { return r < NL ? p.in[I_X] + (size_t)r * D : p.in[I_CTX] + (size_t)(r - NL) * D; }

__device__ __forceinline__ void ph_mod(const P& p, float* sm) {
    const int tix = otid();
    float* modv = (float*)(p.ws + OFF_MODV);
    float* red = sm + 9216;
    if (blockIdx.x < 192) {
        for (int i = tix; i < 9 * 1024; i += blockDim.x) {
            int r = i >> 10, k = i & 1023; float v = (r < 8) ? p.in[I_C][r * 1024 + k] : p.in[I_CCTX][k];
            sm[i] = v / (1.f + expf(-v));
        }
        __syncthreads();
    }
    for (int item = blockIdx.x; item < 192; item += gridDim.x) {
        const int l = item / 96, j0 = (item % 96) * 64, kc = tix >> 6, col = tix & 63;
        const float* w = p.in[I_ADAW] + (size_t)l * 1024 * 6144 + (size_t)(kc * 128) * 6144 + j0 + col;
        const float* sv = sm + kc * 128;
        float acc[9];
#pragma unroll
        for (int r = 0; r < 9; ++r) acc[r] = 0.f;
#pragma unroll 16
        for (int k = 0; k < 128; ++k) {
            const float wv = w[(size_t)k * 6144];
#pragma unroll
            for (int r = 0; r < 9; ++r) acc[r] += sv[r * 1024 + k] * wv;
        }
#pragma unroll
        for (int r = 0; r < 9; ++r) red[(r * 8 + kc) * 64 + col] = acc[r];
        __syncthreads();
        for (int i = tix; i < 576; i += blockDim.x) {
            const int r = i >> 6, c = i & 63; float s = 0.f;
#pragma unroll
            for (int q = 0; q < 8; ++q) s += red[(r * 8 + q) * 64 + c];
            modv[(l * 9 + r) * 6144 + j0 + c] = s + p.in[I_ADAB][l * 6144 + j0 + c];
        }
        __syncthreads();
    }
    if (blockIdx.x == gridDim.x - 1) {
        float* tab = (float*)(p.ws + OFF_ROPE);
        for (int i = tix; i < 1024; i += blockDim.x) {
            const int pos = i >> 4, f = i & 15;
            const float inv = powf(10000.f, -(float)f / 16.f);
            const float ang = (float)pos * inv;
            tab[i * 2] = cosf(ang); tab[i * 2 + 1] = sinf(ang);
        }
    }
}


__device__ __forceinline__ void ph_topk(const P& p, bool with_ctx, float* sm) {
    const int tix = otid();
    int* rowl = (int*)(p.ws + OFF_ROWL); float* gatev = (float*)(p.ws + OFF_GATEV); int* slot = (int*)(p.ws + OFF_SLOT);
    int* hist = (int*)sm; int* misc = hist + 256; int* wtot = hist + 272;
    const int lane = tix & 63, wave = tix >> 6;
    const int nitems = with_ctx ? 256 : 128;
    for (int it = blockIdx.x; it < nitems; it += gridDim.x) {
        const bool isc = it >= 128; const int be = it & 127, b = be >> 4, e = be & 15;
        const int n = isc ? CTXL : SEQ, cap = isc ? CAPC : CAPL;
        const float* aff = isc ? (const float*)(p.ws + OFF_AFFC) + (size_t)be * CTXL : (const float*)(p.ws + OFF_AFFL) + (size_t)be * SEQ;
        const bool have = tix * 8 < n;
        unsigned u[8];
        { float4 a = make_float4(0.f, 0.f, 0.f, 0.f), c = a; if (have) { a = *(const float4*)(aff + tix * 8); c = *(const float4*)(aff + tix * 8 + 4); }
          u[0] = __float_as_uint(a.x); u[1] = __float_as_uint(a.y); u[2] = __float_as_uint(a.z); u[3] = __float_as_uint(a.w);
          u[4] = __float_as_uint(c.x); u[5] = __float_as_uint(c.y); u[6] = __float_as_uint(c.z); u[7] = __float_as_uint(c.w); }
        unsigned prefix = 0u, pmask = 0u; int kk = cap;
#pragma unroll 1
        for (int shift = 24; shift >= 0; shift -= 8) {
            __syncthreads();
            if (tix < 256) hist[tix] = 0;
            __syncthreads();
            if (have) {
#pragma unroll
                for (int j = 0; j < 8; ++j) if ((u[j] & pmask) == prefix) atomicAdd(&hist[(u[j] >> shift) & 255u], 1);
            }
            __syncthreads();
            if (wave == 0) {
                const int h0 = hist[4 * lane], h1 = hist[4 * lane + 1], h2 = hist[4 * lane + 2], h3 = hist[4 * lane + 3];
                int tot = h0 + h1 + h2 + h3, suf = tot;
#pragma unroll
                for (int o = 1; o < 64; o <<= 1) { const int t = __shfl_down(suf, o); if (lane + o < 64) suf += t; }
                const int above = suf - tot;
                const int a3 = above, a2 = above + h3, a1 = a2 + h2, a0 = a1 + h1;
                int dsel = -1, kn = 0;
                if (a3 < kk && kk <= a3 + h3) { dsel = 4 * lane + 3; kn = kk - a3; }
                else if (a2 < kk && kk <= a2 + h2) { dsel = 4 * lane + 2; kn = kk - a2; }
                else if (a1 < kk && kk <= a1 + h1) { dsel = 4 * lane + 1; kn = kk - a1; }
                else if (a0 < kk && kk <= a0 + h0) { dsel = 4 * lane; kn = kk - a0; }
                if (dsel >= 0) { misc[0] = dsel; misc[1] = kn; }
            }
            __syncthreads();
            prefix |= (unsigned)misc[0] << shift; pmask |= 255u << shift; kk = misc[1];
        }
        int cg = 0, ce = 0;
        if (have) {
#pragma unroll
            for (int j = 0; j < 8; ++j) { cg += u[j] > prefix ? 1 : 0; ce += u[j] == prefix ? 1 : 0; }
        }
        int packed = cg | (ce << 16), inc = packed;
#pragma unroll
        for (int o = 1; o < 64; o <<= 1) { const int t = __shfl_up(inc, o); if (lane >= o) inc += t; }
        if (lane == 63) wtot[wave] = inc;
        __syncthreads();
        int before = inc - packed;
#pragma unroll
        for (int w = 0; w < 8; ++w) if (w < wave) before += wtot[w];
        int gb = before & 0xffff, eb = before >> 16;
        const int base = isc ? (NB * CAPL + b * CAPC) : b * CAPL;
        const int rowbase = isc ? (NL + b * CTXL) : b * SEQ;
        if (have) {
#pragma unroll
            for (int j = 0; j < 8; ++j) {
                const bool g = u[j] > prefix, q = u[j] == prefix, sel = g || (q && eb < kk);
                const int row = rowbase + tix * 8 + j;
                if (sel) { const int pos = base + gb + min(eb, kk); rowl[e * ME + pos] = row; gatev[e * ME + pos] = __uint_as_float(u[j]); slot[(size_t)e * NT + row] = pos; }
                else slot[(size_t)e * NT + row] = -1;
                gb += g ? 1 : 0; eb += q ? 1 : 0;
            }
        }
    }
}
__device__ __forceinline__ void ph_combine(const P& p, int l, bool last, int nrows) {
    const int tix = otid();
    const float* modv = (const float*)(p.ws + OFF_MODV); bf16* xres = (bf16*)(p.ws + OFF_XRES);
    const unsigned char* Y = (const unsigned char*)(p.ws + OFF_Y); const float* gatev = (const float*)(p.ws + OFF_GATEV); const int* slot = (const int*)(p.ws + OFF_SLOT);
    bf16* H1 = (bf16*)(p.ws + OFF_H1);
    const int lane = tix & 63, wave = tix >> 6;
    for (int r = blockIdx.x * 8 + wave; r < nrows; r += gridDim.x * 8) {
        float4 acc[4];
#pragma unroll
        for (int j = 0; j < 4; ++j) acc[j] = make_float4(0.f, 0.f, 0.f, 0.f);
        const int s_l = lane < NE ? slot[(size_t)lane * NT + r] : -1;
        const float g_l = s_l >= 0 ? gatev[lane * ME + s_l] : 0.f;
        unsigned mask = (unsigned)(__ballot(s_l >= 0) & 0xFFFFull);
        while (mask) {
            unsigned yv[4][4]; float gq[4];
#pragma unroll
            for (int q = 0; q < 4; ++q) {
                int e = 0, s = 0; float g = 0.f;
                if (mask) { e = __builtin_ctz(mask); mask &= mask - 1; s = __builtin_amdgcn_readlane(s_l, e); g = __uint_as_float(__builtin_amdgcn_readlane(__float_as_uint(g_l), e)); }
                gq[q] = g * (1.f / Y8_SCALE);
                const unsigned* yr = (const unsigned*)(Y + ((size_t)e * ME + s) * D);
#pragma unroll
                for (int j = 0; j < 4; ++j) yv[q][j] = yr[lane + 64 * j];
            }
#pragma unroll
            for (int q = 0; q < 4; ++q)
#pragma unroll
                for (int j = 0; j < 4; ++j) { const unsigned w = yv[q][j]; const float g = gq[q];
                    typedef float v2f_ __attribute__((ext_vector_type(2)));
                    const v2f_ lo = __builtin_amdgcn_cvt_pk_f32_fp8((int)w, false), hi2 = __builtin_amdgcn_cvt_pk_f32_fp8((int)w, true);
                    acc[j].x += g * lo[0]; acc[j].y += g * lo[1]; acc[j].z += g * hi2[0]; acc[j].w += g * hi2[1]; }
        }
        const float* mv = modv + (size_t)(l * 9 + mod_row(r)) * 6144;
        uint2* xr = (uint2*)(xres + (size_t)r * D);
        float4 v[4]; float ss = 0.f;
#pragma unroll
        for (int j = 0; j < 4; ++j) {
            const uint2 xw = xr[lane + 64 * j]; float4 x; x.x = bf2f(xw.x & 0xffffu); x.y = bf2f(xw.x >> 16); x.z = bf2f(xw.y & 0xffffu); x.w = bf2f(xw.y >> 16);
            const float4 g5 = ((const float4*)(mv + 5 * 1024))[lane + 64 * j];
            v[j].x = x.x + g5.x * acc[j].x; v[j].y = x.y + g5.y * acc[j].y; v[j].z = x.z + g5.z * acc[j].z; v[j].w = x.w + g5.w * acc[j].w;
            ss += v[j].x * v[j].x + v[j].y * v[j].y + v[j].z * v[j].z + v[j].w * v[j].w;
        }
        ss = wave_sum(ss);
        const float rstd = 1.f / sqrtf(ss * (1.f / D) + EPS);
        if (last) {
            float4* o = (float4*)(p.out + (size_t)r * D); const float4* g4 = (const float4*)p.in[I_FG];
#pragma unroll
            for (int j = 0; j < 4; ++j) { const float4 g = g4[lane + 64 * j]; float4 w; w.x = v[j].x * rstd * g.x; w.y = v[j].y * rstd * g.y; w.z = v[j].z * rstd * g.z; w.w = v[j].w * rstd * g.w; o[lane + 64 * j] = w; }
        } else {
            const float* mv1 = modv + (size_t)((l + 1) * 9 + mod_row(r)) * 6144;
            const float4* g4 = (const float4*)(p.in[I_NMIX] + (l + 1) * 1024);
#pragma unroll
            for (int j = 0; j < 4; ++j) {
                { uint2 xo; xo.x = pk2(v[j].x, v[j].y); xo.y = pk2(v[j].z, v[j].w); xr[lane + 64 * j] = xo; }
                const float4 g = g4[lane + 64 * j], sh = ((const float4*)mv1)[lane + 64 * j], sc = ((const float4*)(mv1 + 1024))[lane + 64 * j];
                uint2 o; o.x = pk2(v[j].x * rstd * g.x * (1.f + sc.x) + sh.x, v[j].y * rstd * g.y * (1.f + sc.y) + sh.y);
                o.y = pk2(v[j].z * rstd * g.z * (1.f + sc.z) + sh.z, v[j].w * rstd * g.w * (1.f + sc.w) + sh.w);
                *(uint2*)(H1 + (size_t)r * D + (lane + 64 * j) * 4) = o;
            }
        }
    }
}
__device__ __forceinline__ float gelu_tanh(float x) {
    const float u = 0.7978845608028654f * (x + 0.044715f * x * x * x);
    return x * __builtin_amdgcn_rcpf(1.f + __builtin_amdgcn_exp2f(-2.f * 1.4426950408889634f * u)); }

__device__ __forceinline__ void unpack8(const uint4& v, float* f) {
    f[0] = bf2f(v.x & 0xffffu); f[1] = bf2f(v.x >> 16); f[2] = bf2f(v.y & 0xffffu); f[3] = bf2f(v.y >> 16);
    f[4] = bf2f(v.z & 0xffffu); f[5] = bf2f(v.z >> 16); f[6] = bf2f(v.w & 0xffffu); f[7] = bf2f(v.w >> 16);
}
__device__ __forceinline__ uint4 pack8(const float* f) { uint4 o; o.x = pk2(f[0], f[1]); o.y = pk2(f[2], f[3]); o.z = pk2(f[4], f[5]); o.w = pk2(f[6], f[7]); return o; }
__device__ __forceinline__ void ph_prep_attn(const P& p, float* sm) {
    const int tix = otid();
    bf16* PROJ = (bf16*)(p.ws + OFF_PROJ); const float* tab = (const float*)(p.ws + OFF_ROPE);
    bf16* KFL = (bf16*)(p.ws + OFF_KFL); bf16* KFC = (bf16*)(p.ws + OFF_KFC);
    const int total = NL * 40;
    for (int i = blockIdx.x * blockDim.x + tix; i < total; i += gridDim.x * blockDim.x) {
        const int r = i / 40, rem = i % 40, hh = rem >> 2, part = (rem >> 1) & 1, hf = rem & 1, t = r & 4095;
        const int pos = part == 0 ? (t >> 6) : (t & 63);
        bf16* base = PROJ + (size_t)r * EVIN + (hh < 8 ? hh * 64 : 512 + (hh - 8) * 64) + part * 32 + hf * 8;
        const uint4 a = *(const uint4*)base, bq = *(const uint4*)(base + 16);
        float x1[8], x2[8], o1[8], o2[8]; unpack8(a, x1); unpack8(bq, x2);
        const float4* cs = (const float4*)(tab + (size_t)(pos * 16 + hf * 8) * 2);
#pragma unroll
        for (int q = 0; q < 4; ++q) { const float4 w = cs[q];
            o1[2 * q] = x1[2 * q] * w.x - x2[2 * q] * w.y; o2[2 * q] = x2[2 * q] * w.x + x1[2 * q] * w.y;
            o1[2 * q + 1] = x1[2 * q + 1] * w.z - x2[2 * q + 1] * w.w; o2[2 * q + 1] = x2[2 * q + 1] * w.z + x1[2 * q + 1] * w.w; }
        if (hh < 8) { *(uint4*)base = pack8(o1); *(uint4*)(base + 16) = pack8(o2); }
        else {
            const int b = r >> 12, hk = hh - 8;
            bf16* kf = KFL + ((((size_t)(b * 2 + hk) * 128 + (t >> 5)) * 4 + 2 * part) * 64 + hf * 32 + (t & 31)) * 8;
            *(uint4*)kf = pack8(o1); *(uint4*)(kf + 512) = pack8(o2);
        }
    }
    for (int i = blockIdx.x * blockDim.x + tix; i < NC * 16; i += gridDim.x * blockDim.x) {
        const int rc = i >> 4, hk = (i >> 3) & 1, s = (i >> 1) & 3, hf = i & 1, b = rc >> 8, t = rc & 255;
        const uint4 v = *(const uint4*)(PROJ + (size_t)(NL + rc) * EVIN + 512 + hk * 64 + 16 * s + 8 * hf);
        *(uint4*)(KFC + ((((size_t)(b * 2 + hk) * 8 + (t >> 5)) * 4 + s) * 64 + hf * 32 + (t & 31)) * 8) = v;
    }
    bf16* tile = (bf16*)sm;
    for (int it = blockIdx.x; it < 1024 + 64; it += gridDim.x) {
        int b, hk, t0, rowbase; bf16* vf;
        if (it < 1024) { b = it >> 7; hk = (it >> 6) & 1; t0 = (it & 63) * 64; rowbase = b * SEQ; vf = (bf16*)(p.ws + OFF_VTL) + (size_t)(b * 2 + hk) * 128 * 2048; }
        else { const int j = it - 1024; b = j >> 3; hk = (j >> 2) & 1; t0 = (j & 3) * 64; rowbase = NL + b * CTXL; vf = (bf16*)(p.ws + OFF_VTC) + (size_t)(b * 2 + hk) * 8 * 2048; }
        __syncthreads();
        for (int i = tix; i < 4096; i += blockDim.x) { const int tok = i >> 6, d = i & 63; tile[tok * 65 + d] = PROJ[(size_t)(rowbase + t0 + tok) * EVIN + 640 + hk * 64 + d]; }
        __syncthreads();
        {
            const int frag = tix >> 6, ln = tix & 63, T = frag >> 2, dt = (frag >> 1) & 1, s = frag & 1, rr = ln & 31, hi = ln >> 5;
            unsigned w[4];
#pragma unroll
            for (int jj = 0; jj < 4; ++jj) {
                const int j0 = 2 * jj, j1 = 2 * jj + 1;
                const unsigned lo = tile[(32 * T + 16 * s + 8 * (j0 >> 2) + 4 * hi + (j0 & 3)) * 65 + 32 * dt + rr];
                const unsigned hi16 = tile[(32 * T + 16 * s + 8 * (j1 >> 2) + 4 * hi + (j1 & 3)) * 65 + 32 * dt + rr];
                w[jj] = lo | (hi16 << 16);
            }
            uint4 o; o.x = w[0]; o.y = w[1]; o.z = w[2]; o.w = w[3];
            *(uint4*)(vf + ((((size_t)((t0 >> 5) + T) * 2 + dt) * 2 + s) * 64 + ln) * 8) = o;
        }
    }
}
typedef short abf16x8 __attribute__((ext_vector_type(8)));
typedef short abf16x4 __attribute__((ext_vector_type(4)));
typedef float af32x16 __attribute__((ext_vector_type(16)));
__device__ __forceinline__ unsigned cvtpk(float lo, float hi) { unsigned r; asm volatile("v_cvt_pk_bf16_f32 %0, %1, %2" : "=v"(r) : "v"(lo), "v"(hi)); return r; }
struct AttnK { abf16x8 k[8]; };
struct AttnV { abf16x8 v[8]; };
__device__ __forceinline__ void attn_load_k(AttnK& f, const char* ub, const unsigned vo) {
#pragma unroll
    for (int s = 0; s < 4; ++s) { f.k[2 * s] = *(const abf16x8*)(ub + vo + s * 1024); f.k[2 * s + 1] = *(const abf16x8*)(ub + vo + (4 + s) * 1024); }
}
__device__ __forceinline__ void attn_load_v(AttnV& f, const char* ub, const unsigned vo) {
#pragma unroll
    for (int dt = 0; dt < 2; ++dt)
#pragma unroll
        for (int T = 0; T < 2; ++T)
#pragma unroll
            for (int s = 0; s < 2; ++s) f.v[(dt * 2 + T) * 2 + s] = *(const abf16x8*)(ub + vo + ((T * 2 + dt) * 2 + s) * 1024);
}
__device__ __forceinline__ void attn_tile(AttnK& f, AttnV& fv, const bool has_next, const char* nkp, const char* nvp, const unsigned vo, const abf16x8* ql, const bool partial, const int kq0  , const int kmax  ,
                                          const int hi, float& m, float& l, af32x16& o0, af32x16& o1) {
    const float CS = 0.125f * 1.4426950408889634f;
    const int kqh = kq0 + 4 * hi;
    af32x16 s0, s1;
#pragma unroll
    for (int i = 0; i < 16; ++i) { s0[i] = 0.f; s1[i] = 0.f; }
    abf16x8 qf[4];
#pragma unroll
    for (int s = 0; s < 4; ++s) qf[s] = ql[s * 64];
#pragma unroll
    for (int s = 0; s < 4; ++s) {
        s0 = __builtin_amdgcn_mfma_f32_32x32x16_bf16(f.k[2 * s], qf[s], s0, 0, 0, 0);
        s1 = __builtin_amdgcn_mfma_f32_32x32x16_bf16(f.k[2 * s + 1], qf[s], s1, 0, 0, 0);
    }
    if (has_next) attn_load_k(f, nkp, vo);
    float tmax = -1e30f;
    if (partial) {
        asm volatile("" ::: "memory");
#pragma unroll
        for (int i = 0; i < 16; ++i) {
            const int c = (i & 3) + 8 * (i >> 2);
            if (kqh > 128 - c || kqh < -128 - c) s0[i] = -1e30f;
            if (kqh > 96 - c || kqh < -160 - c) s1[i] = -1e30f;
        }
    }
#pragma unroll
    for (int i = 0; i < 16; ++i) asm("v_max3_f32 %0, %0, %1, %2" : "+v"(tmax) : "v"(s0[i]), "v"(s1[i]));
    tmax = fmaxf(tmax, __shfl_xor(tmax, 32));
    const float mn = fmaxf(m, tmax * CS), alpha = __builtin_amdgcn_exp2f(m - mn), nmn = -mn; m = mn;
    float sum = 0.f;
#pragma unroll
    for (int i = 0; i < 16; ++i) { s0[i] = __builtin_amdgcn_exp2f(__builtin_fmaf(s0[i], CS, nmn)); s1[i] = __builtin_amdgcn_exp2f(__builtin_fmaf(s1[i], CS, nmn)); sum += s0[i] + s1[i]; }
    l = l * alpha + sum;
#pragma unroll
    for (int i = 0; i < 16; ++i) { float t0 = o0[i] * alpha, t1 = o1[i] * alpha; asm("" : "+v"(t0), "+v"(t1)); o0[i] = t0; o1[i] = t1; }
    typedef unsigned u32x4_ __attribute__((ext_vector_type(4)));
    abf16x8 pf[2][2];
#pragma unroll
    for (int s = 0; s < 2; ++s) {
        u32x4_ w0, w1;
        w0.x = cvtpk(s0[8 * s + 0], s0[8 * s + 1]); w0.y = cvtpk(s0[8 * s + 2], s0[8 * s + 3]); w0.z = cvtpk(s0[8 * s + 4], s0[8 * s + 5]); w0.w = cvtpk(s0[8 * s + 6], s0[8 * s + 7]);
        w1.x = cvtpk(s1[8 * s + 0], s1[8 * s + 1]); w1.y = cvtpk(s1[8 * s + 2], s1[8 * s + 3]); w1.z = cvtpk(s1[8 * s + 4], s1[8 * s + 5]); w1.w = cvtpk(s1[8 * s + 6], s1[8 * s + 7]);
        pf[0][s] = __builtin_bit_cast(abf16x8, w0); pf[1][s] = __builtin_bit_cast(abf16x8, w1);
    }
#pragma unroll
    for (int T = 0; T < 2; ++T)
#pragma unroll
        for (int s = 0; s < 2; ++s) {
            o0 = __builtin_amdgcn_mfma_f32_32x32x16_bf16(fv.v[(0 * 2 + T) * 2 + s], pf[T][s], o0, 0, 0, 0);
            o1 = __builtin_amdgcn_mfma_f32_32x32x16_bf16(fv.v[(1 * 2 + T) * 2 + s], pf[T][s], o1, 0, 0, 0);
        }
    if (has_next) attn_load_v(fv, nvp, vo);
}
__device__ __forceinline__ void ph_attn_mfma(const P& p, unsigned char* lds) {
    const bf16* PROJ = (const bf16*)(p.ws + OFF_PROJ); bf16* MIX = (bf16*)(p.ws + OFF_MIX);
    const bf16* VTL = (const bf16*)(p.ws + OFF_VTL); const bf16* VTC = (const bf16*)(p.ws + OFF_VTC);
    const bf16* KFL = (const bf16*)(p.ws + OFF_KFL); const bf16* KFC = (const bf16*)(p.ws + OFF_KFC);
    int tid_ = threadIdx.x; asm volatile("" : "+v"(tid_));
    const int lane = tid_ & 63, r = lane & 31, hi = lane >> 5, wave = __builtin_amdgcn_readfirstlane(tid_ >> 6);
    const int gw = blockIdx.x * 8 + wave, NGW = gridDim.x * 8;
    int task = gw; bool isctx = false;
    while (true) {
        if (!isctx && task >= 4096) { isctx = true; task = wave == 0 ? (int)blockIdx.x : (1 << 30); }
        if (isctx && task >= 256) break;
        int b, h, q0, rowq;
        if (!isctx) { h = task & 7; q0 = ((task >> 3) & 63) * 64; b = task >> 9; rowq = b * SEQ + q0; }
        else { h = task & 7; q0 = ((task >> 3) & 3) * 64; b = task >> 5; rowq = NL + b * CTXL + q0; }
        const int hk = h >> 2;
        const bf16* qp = PROJ + (size_t)(rowq + r) * EVIN + h * 64 + 8 * hi;
        {
            abf16x8* qw = (abf16x8*)(lds + wave * 8192) + lane;
#pragma unroll
            for (int s = 0; s < 4; ++s) { qw[s * 64] = *(const abf16x8*)(qp + 16 * s); qw[(4 + s) * 64] = *(const abf16x8*)(qp + (size_t)32 * EVIN + 16 * s); }
        }
        const float m0 = p.in[I_EVSINK][h] * 1.4426950408889634f;
        float ma = m0, mb = m0, la = hi ? 0.f : 1.f, lb = la;
        af32x16 oa0, oa1, ob0, ob1;
#pragma unroll
        for (int i = 0; i < 16; ++i) { oa0[i] = 0.f; oa1[i] = 0.f; ob0[i] = 0.f; ob1[i] = 0.f; }
        int kbeg = 0, nloc = 0;
        if (!isctx) { const int lo = max(0, q0 - 128), hik = min(SEQ - 1, q0 + 63 + 128); kbeg = lo & ~63; nloc = ((hik - kbeg) >> 6) + 1; }
        const int ntile = nloc + 4;
        const char* kloc = (const char*)(KFL + (size_t)(b * 2 + hk) * 128 * 2048);
        const char* vloc = (const char*)(VTL + (size_t)(b * 2 + hk) * 128 * 2048);
        const char* kctx = (const char*)(KFC + (size_t)(b * 2 + hk) * 8 * 2048);
        const char* vctx = (const char*)(VTC + (size_t)(b * 2 + hk) * 8 * 2048);
        const unsigned vo = lane * 16;
        AttnK ka; AttnV fv;
        {   const bool loc0 = nloc > 0; const size_t o0_ = loc0 ? (size_t)(kbeg >> 5) * 4096 : 0;
            attn_load_k(ka, (loc0 ? kloc : kctx) + o0_, vo); attn_load_v(fv, (loc0 ? vloc : vctx) + o0_, vo); }
        for (int ti = 0; ti < ntile; ++ti) {
            const int tn = ti + 1; const bool has_next = tn < ntile, nloc_ = tn < nloc;
            const size_t on_ = (size_t)(nloc_ ? ((kbeg >> 5) + 2 * tn) : 2 * (tn - nloc)) * 4096;
            const char* nkp = (nloc_ ? kloc : kctx) + on_; const char* nvp = (nloc_ ? vloc : vctx) + on_;
            unsigned qo_ = wave * 8192 + lane * 16; asm volatile("" : "+v"(qo_));
            const abf16x8* qa = (const abf16x8*)(lds + qo_); const abf16x8* qb = qa + 256;
            const bool loc_ = ti < nloc; const int k0_ = kbeg + 64 * ti;
            const bool pa_ = loc_ && !(k0_ >= q0 + 31 - 128 && k0_ + 63 <= q0 + 128 && k0_ + 63 < SEQ);
            const bool pb_ = loc_ && !(k0_ >= q0 + 63 - 128 && k0_ + 63 <= q0 + 32 + 128 && k0_ + 63 < SEQ);
            attn_tile(ka, fv, false, nkp, nvp, vo, qa, pa_, k0_ - q0 - r, SEQ - k0_, hi, ma, la, oa0, oa1);
            __builtin_amdgcn_sched_barrier(0);
            attn_tile(ka, fv, has_next, nkp, nvp, vo, qb, pb_, k0_ - q0 - 32 - r, SEQ - k0_, hi, mb, lb, ob0, ob1);
        }
        la += __shfl_xor(la, 32); lb += __shfl_xor(lb, 32);
        const float ia = 1.f / la, ib = 1.f / lb;
        bf16* op = MIX + (size_t)(rowq + r) * D + h * 64 + 4 * hi;
#pragma unroll
        for (int g = 0; g < 4; ++g) {
            uint2 w0, w1;
            w0.x = cvtpk(oa0[4 * g] * ia, oa0[4 * g + 1] * ia); w0.y = cvtpk(oa0[4 * g + 2] * ia, oa0[4 * g + 3] * ia);
            w1.x = cvtpk(oa1[4 * g] * ia, oa1[4 * g + 1] * ia); w1.y = cvtpk(oa1[4 * g + 2] * ia, oa1[4 * g + 3] * ia);
            *(uint2*)(op + 8 * g) = w0; *(uint2*)(op + 32 + 8 * g) = w1;
            w0.x = cvtpk(ob0[4 * g] * ib, ob0[4 * g + 1] * ib); w0.y = cvtpk(ob0[4 * g + 2] * ib, ob0[4 * g + 3] * ib);
            w1.x = cvtpk(ob1[4 * g] * ib, ob1[4 * g + 1] * ib); w1.y = cvtpk(ob1[4 * g + 2] * ib, ob1[4 * g + 3] * ib);
            *(uint2*)(op + (size_t)32 * D + 8 * g) = w0; *(uint2*)(op + (size_t)32 * D + 32 + 8 * g) = w1;
        }
        task += isctx ? (int)gridDim.x : NGW;
    }
}
__device__ __forceinline__ void ph_conv3v(const P& p) {
    const int tix = otid();
    const bf16* __restrict__ PROJ = (const bf16*)(p.ws + OFF_PROJ); bf16* __restrict__ MIX = (bf16*)(p.ws + OFF_MIX);
    const float* cw = p.in[I_EVCW]; const float* cb = p.in[I_EVCB];
    const int total = NT * 64, stride = gridDim.x * blockDim.x, i0 = blockIdx.x * blockDim.x + tix;
    const int j = (i0 & 63) * 8;
    float wv[3][8], bv[8];
    { const float4 b0 = *(const float4*)(cb + j), b1 = *(const float4*)(cb + j + 4); bv[0] = b0.x; bv[1] = b0.y; bv[2] = b0.z; bv[3] = b0.w; bv[4] = b1.x; bv[5] = b1.y; bv[6] = b1.z; bv[7] = b1.w; }
#pragma unroll
    for (int k = 0; k < 3; ++k) { const float4 w0 = *(const float4*)(cw + k * 512 + j), w1 = *(const float4*)(cw + k * 512 + j + 4);
        wv[k][0] = w0.x; wv[k][1] = w0.y; wv[k][2] = w0.z; wv[k][3] = w0.w; wv[k][4] = w1.x; wv[k][5] = w1.y; wv[k][6] = w1.z; wv[k][7] = w1.w; }
    for (int ib = i0; ib < total; ib += 2 * stride) {
        uint4 gcv[2][3], uv[2][3], gbv[2];
#pragma unroll
        for (int q = 0; q < 2; ++q) {
            const int i = ib + q * stride; const int r = min(i, total - 1) >> 6;
            int t, len; if (r < NL) { t = r & 4095; len = SEQ; } else { t = (r - NL) & 255; len = CTXL; }
#pragma unroll
            for (int k = 0; k < 3; ++k) { const int tt = t - 1 + k; const bool ok = tt >= 0 && tt < len; const bf16* row = PROJ + (size_t)(r - 1 + k) * EVIN;
                gcv[q][k] = ok ? *(const uint4*)(row + 1280 + j) : make_uint4(0u, 0u, 0u, 0u); uv[q][k] = ok ? *(const uint4*)(row + 1792 + j) : make_uint4(0u, 0u, 0u, 0u); }
            gbv[q] = *(const uint4*)(PROJ + (size_t)r * EVIN + 768 + j);
        }
#pragma unroll
        for (int q = 0; q < 2; ++q) {
            const int i = ib + q * stride;
            float acc[8];
#pragma unroll
            for (int c = 0; c < 8; ++c) acc[c] = bv[c];
#pragma unroll
            for (int k = 0; k < 3; ++k) { float gc[8], u[8]; unpack8(gcv[q][k], gc); unpack8(uv[q][k], u);
#pragma unroll
                for (int c = 0; c < 8; ++c) acc[c] += wv[k][c] * (gc[c] * u[c]); }
            float gb[8]; unpack8(gbv[q], gb);
#pragma unroll
            for (int c = 0; c < 8; ++c) acc[c] *= gb[c];
            if (i < total) *(uint4*)(MIX + (size_t)(i >> 6) * D + 512 + j) = pack8(acc);
        }
    }
}

namespace pg8 {
#define PG8_LAS __attribute__((address_space(3)))
typedef short bf16x8 __attribute__((ext_vector_type(8)));
typedef float f32x4 __attribute__((ext_vector_type(4)));
typedef unsigned u32x4 __attribute__((ext_vector_type(4)));
constexpr int BM = 256, BK = 64, HALF = 128, HTB = HALF * BK * 2, STAGE_BYTES = 8 * HTB, NXCD = 8, WGM = 8;
__device__ __forceinline__ int lds_byte(int r, int c) { const int st = (r >> 4) * 2 + (c >> 5), rr = r & 15, cc = c & 31, ob = rr * 64 + cc * 2; return st * 1024 + (ob ^ (((ob >> 9) & 1) << 5)); }
__device__ __forceinline__ void stage_rc(int b, int& R, int& C) { const int st = b / 1024, sb = b % 1024, swz = sb ^ (((sb >> 9) & 1) << 5); R = (st >> 1) * 16 + swz / 64; C = (st & 1) * 32 + (swz % 64) / 2; }
__device__ __forceinline__ int perm32(int rho) { const int n = rho >> 4, i = rho & 15; return 8 * (i >> 2) + 4 * n + (i & 3); }
__device__ __forceinline__ unsigned cvt_pk_bf16(float lo, float hi) { unsigned r; asm volatile("v_cvt_pk_bf16_f32 %0, %1, %2" : "=v"(r) : "v"(lo), "v"(hi)); return r; }

struct Unit { int g, pm, pn; };
struct Sched {
    int ng, nM, nN, nwg, G, c;
    const char* Abase; size_t a_gstride, a_tstride;
    const char* Bbase; size_t b_gstride, b_tstride;
    const int* rowidx; int idx_gstride;
    __device__ __forceinline__ bool next(int i, Unit& u) const {
        const long L = (long)i * G + c; if (L >= nwg) return false;
        int wgid = (int)L; { const int q = nwg / NXCD, r = nwg % NXCD, xcd = wgid % NXCD, off = wgid / NXCD; wgid = (xcd < r ? xcd * (q + 1) : r * (q + 1) + (xcd - r) * q) + off; }
        const int tpg = nM * nN; u.g = wgid / tpg; const int w = wgid % tpg;
        const int nig = WGM * nN, gid = w / nig, fm = gid * WGM, gsz = (nM - fm) < WGM ? (nM - fm) : WGM;
        u.pm = fm + ((w % nig) % gsz); u.pn = (w % nig) / gsz; return true;
    }
    __device__ __forceinline__ const char* a_base(const Unit& u) const { return Abase + (size_t)u.g * a_gstride + (size_t)u.pm * a_tstride; }
    __device__ __forceinline__ const char* b_base(const Unit& u) const { return Bbase + (size_t)u.g * b_gstride + (size_t)u.pn * b_tstride; }
};

template <class Epi, bool GATHER, bool F8 = false>
__device__ __forceinline__ void gemm_phase(PG8_LAS unsigned char* lds, const int KB  , const Sched& S, const Epi& E) {
    int tid_ = threadIdx.x; asm volatile("" : "+v"(tid_));
    const int tid = tid_, wid = __builtin_amdgcn_readfirstlane(tid >> 6), lane = tid & 63, wr = wid >> 2, wc = wid & 3, fr = lane & 15, fq = lane >> 4;
    const int nt = KB / (BK * 2);
    int Rr[2], Cc[2]; unsigned voffB[2];
#pragma unroll
    for (int i = 0; i < 2; ++i) { stage_rc(tid * 16 + i * 8192, Rr[i], Cc[i]); const int Rb = Epi::PERM ? ((Rr[i] & ~31) + perm32(Rr[i] & 31)) : Rr[i]; voffB[i] = (unsigned)(Rb * KB + Cc[i] * 2); }
    const size_t kstep = (size_t)(BK * 2);
    const size_t hstep = (size_t)HALF * KB;
    const unsigned ldsw = (unsigned)wid * 1024u;
    const int aoff = lds_byte(wr * 64 + fr, fq * 8), boff = lds_byte(wc * 32 + fr, fq * 8);
#define PG8_SA(b, h) (((b) * 2 + (h)) * HTB)
#define PG8_SB(b, h) ((4 + (b) * 2 + (h)) * HTB)
#define PG8_STAGE2(bufoff, gbase, v0, v1) do { unsigned o0_ = (v0), o1_ = (v1); asm volatile("" : "+v"(o0_), "+v"(o1_));     \
        __builtin_amdgcn_global_load_lds((const unsigned*)((const char*)(gbase) + o0_), (PG8_LAS unsigned*)(lds + (bufoff) + ldsw), 16, 0, 0); \
        __builtin_amdgcn_global_load_lds((const unsigned*)((const char*)(gbase) + o1_), (PG8_LAS unsigned*)(lds + (bufoff) + ldsw + 8192), 16, 0, 0); } while (0)
#define PG8_STAGEB(bufoff, gbase) PG8_STAGE2(bufoff, gbase, voffB[0], voffB[1])
#define PG8_STAGEA1(bufoff, gbase, v10, v11, v00, v01) do { if constexpr (GATHER) PG8_STAGE2(bufoff, gbase, v10, v11); else PG8_STAGE2(bufoff, (gbase) + hstep, v00, v01); } while (0)
#define PG8_LDA(dst, b, h) do { _Pragma("unroll") for (int m = 0; m < 4; ++m) { if constexpr (F8) dst##8[m] = __builtin_shufflevector(*(const PG8_LAS v4i_*)(lds + PG8_SA(b, h) + aoff + m * 2048), *(const PG8_LAS v4i_*)(lds + PG8_SA(b, h) + aoff + m * 2048 + 1024), 0, 1, 2, 3, 4, 5, 6, 7); \
        else { _Pragma("unroll") for (int k = 0; k < 2; ++k) dst[m][k] = *(const PG8_LAS bf16x8*)(lds + PG8_SA(b, h) + aoff + m * 2048 + k * 1024); } } } while (0)
#define PG8_LDB(dst, b, h) do { _Pragma("unroll") for (int n = 0; n < 2; ++n) { if constexpr (F8) dst##8[n] = __builtin_shufflevector(*(const PG8_LAS v4i_*)(lds + PG8_SB(b, h) + boff + n * 2048), *(const PG8_LAS v4i_*)(lds + PG8_SB(b, h) + boff + n * 2048 + 1024), 0, 1, 2, 3, 4, 5, 6, 7); \
        else { _Pragma("unroll") for (int k = 0; k < 2; ++k) dst[n][k] = *(const PG8_LAS bf16x8*)(lds + PG8_SB(b, h) + boff + n * 2048 + k * 1024); } } } while (0)
#define PG8_MMA(ai, bj, At, Bt) do { __builtin_amdgcn_s_setprio(1); _Pragma("unroll") for (int m = 0; m < 4; ++m) _Pragma("unroll") for (int n = 0; n < 2; ++n) { \
        if constexpr (F8) asm volatile("v_mfma_scale_f32_16x16x128_f8f6f4 %0, %1, %2, %0, %3, %3 op_sel_hi:[0,0,0]" : "+v"(acc[ai][bj][m][n]) : "v"(Bt##8[n]), "v"(At##8[m]), "v"(scl8));   \
        else { _Pragma("unroll") for (int k = 0; k < 2; ++k) acc[ai][bj][m][n] = __builtin_amdgcn_mfma_f32_16x16x32_bf16(Bt[n][k], At[m][k], acc[ai][bj][m][n], 0, 0, 0); } } \
        __builtin_amdgcn_s_setprio(0); } while (0)
#define PG8_WAIT_V(n) asm volatile("s_waitcnt vmcnt(" #n ")" ::: "memory")
#define PG8_WAIT_L(n) asm volatile("s_waitcnt lgkmcnt(" #n ")" ::: "memory")
#define PG8_BAR __builtin_amdgcn_s_barrier()
#define PG8_SCHED __builtin_amdgcn_sched_barrier(0)
    Unit cur, nxt; int ui = 0;
    if (!S.next(0, cur)) return;
    f32x4 acc[2][2][4][2];
#pragma unroll
    for (int a = 0; a < 2; ++a)
#pragma unroll
        for (int b = 0; b < 2; ++b)
#pragma unroll
            for (int m = 0; m < 4; ++m)
#pragma unroll
                for (int n = 0; n < 2; ++n) acc[a][b][m][n] = (f32x4){0.f, 0.f, 0.f, 0.f};
    typedef int v8i_ __attribute__((ext_vector_type(8))); typedef int v4i_ __attribute__((ext_vector_type(4)));
    unsigned scl8 = 0x7F7F7F7Fu; asm volatile("" : "+v"(scl8));
    bf16x8 At[4][2], B0[2][2], B1[2][2]; v8i_ At8[4], B08[2], B18[2];
    unsigned c00, c01, c10, c11, n00, n01, n10, n11;
#define PG8_VOFFA(u, v00, v01, v10, v11) do { \
        if constexpr (GATHER) { const int* ix = S.rowidx + (size_t)(u).g * S.idx_gstride + (u).pm * BM; \
            int t2_ = tid; asm volatile("" : "+v"(t2_)); int R0_, C0_, R1_, C1_; stage_rc(t2_ * 16, R0_, C0_); stage_rc(t2_ * 16 + 8192, R1_, C1_);     \
            v00 = (unsigned)(ix[R0_] * KB + C0_ * 2); v01 = (unsigned)(ix[R1_] * KB + C1_ * 2); \
            v10 = (unsigned)(ix[HALF + R0_] * KB + C0_ * 2); v11 = (unsigned)(ix[HALF + R1_] * KB + C1_ * 2); } \
        else { v00 = (unsigned)(Rr[0] * KB + Cc[0] * 2); v01 = (unsigned)(Rr[1] * KB + Cc[1] * 2); \
            v10 = (unsigned)((HALF + Rr[0]) * KB + Cc[0] * 2); v11 = (unsigned)((HALF + Rr[1]) * KB + Cc[1] * 2); } } while (0)
    PG8_VOFFA(cur, c00, c01, c10, c11);
    const char* cA = GATHER ? S.Abase : S.a_base(cur); const char* cB = S.b_base(cur);
    PG8_STAGEB(PG8_SB(0, 0), cB); PG8_STAGEB(PG8_SB(0, 1), cB + hstep); PG8_STAGE2(PG8_SA(0, 0), cA, c00, c01); PG8_STAGEA1(PG8_SA(0, 1), cA, c10, c11, c00, c01);
    if (wr == 1) PG8_BAR;
    PG8_WAIT_V(2); PG8_BAR;
    PG8_STAGEB(PG8_SB(1, 0), cB + kstep); PG8_STAGE2(PG8_SA(1, 0), cA + kstep, c00, c01); PG8_STAGEB(PG8_SB(1, 1), cB + hstep + kstep);
    PG8_WAIT_V(6); PG8_BAR;
    for (;;) {
        const bool has_next = S.next(ui + 1, nxt);
        const char* nA = has_next ? (GATHER ? S.Abase : S.a_base(nxt)) : cA; const char* nB = has_next ? S.b_base(nxt) : cB;
        if (has_next) { PG8_VOFFA(nxt, n00, n01, n10, n11); } else { n00 = c00; n01 = c01; n10 = c10; n11 = c11; }
#pragma unroll 1
        for (int t = 0; t < nt; t += 2) {
            const bool last = (t == nt - 2);
            const char* a1 = cA + (size_t)(t + 1) * kstep;
            const char* a2 = last ? nA : cA + (size_t)(t + 2) * kstep; const char* b2 = last ? nB : cB + (size_t)(t + 2) * kstep;
            const char* a3 = a2 + kstep; const char* b3 = b2 + kstep;
            const unsigned x00 = last ? n00 : c00, x01 = last ? n01 : c01, x10 = last ? n10 : c10, x11 = last ? n11 : c11;
            PG8_LDB(B0, 0, 0); PG8_LDB(B1, 0, 1); PG8_SCHED; PG8_LDA(At, 0, 0); PG8_STAGEA1(PG8_SA(1, 1), a1, c10, c11, c00, c01);
            PG8_WAIT_V(8); PG8_WAIT_L(0); PG8_BAR; PG8_MMA(0, 0, At, B0); PG8_MMA(0, 1, At, B1); PG8_BAR; PG8_SCHED;
            PG8_LDA(At, 0, 1); PG8_STAGEB(PG8_SB(0, 0), b2); PG8_STAGEB(PG8_SB(0, 1), b2 + hstep); PG8_STAGE2(PG8_SA(0, 0), a2, x00, x01);
            PG8_WAIT_V(8); PG8_WAIT_L(0); PG8_BAR; PG8_MMA(1, 0, At, B0); PG8_MMA(1, 1, At, B1); PG8_BAR; PG8_SCHED;
            PG8_LDB(B0, 1, 0); PG8_LDB(B1, 1, 1); PG8_SCHED; PG8_LDA(At, 1, 0); PG8_STAGEA1(PG8_SA(0, 1), a2, x10, x11, x00, x01);
            PG8_WAIT_V(8); PG8_WAIT_L(0); PG8_BAR; PG8_MMA(0, 0, At, B0); PG8_MMA(0, 1, At, B1); PG8_BAR; PG8_SCHED;
            PG8_LDA(At, 1, 1); PG8_STAGEB(PG8_SB(1, 0), b3); PG8_STAGEB(PG8_SB(1, 1), b3 + hstep); PG8_STAGE2(PG8_SA(1, 0), a3, x00, x01);
            PG8_WAIT_V(8); PG8_WAIT_L(0); PG8_BAR; PG8_MMA(1, 0, At, B0); PG8_MMA(1, 1, At, B1); PG8_BAR; PG8_SCHED;
        }
        if (wr == 0) PG8_BAR;
        if constexpr (F8) asm volatile("s_nop 15\n\ts_nop 15" ::: "memory");
        { int efr = fr, efq = fq; asm volatile("" : "+v"(efr), "+v"(efq));
          E(acc, cur, wr, wc, efr, efq); }
        if (!has_next) break;
#pragma unroll
        for (int a = 0; a < 2; ++a)
#pragma unroll
            for (int b = 0; b < 2; ++b)
#pragma unroll
                for (int m = 0; m < 4; ++m)
#pragma unroll
                    for (int n = 0; n < 2; ++n) acc[a][b][m][n] = (f32x4){0.f, 0.f, 0.f, 0.f};
        cur = nxt; cA = nA; cB = nB; c00 = n00; c01 = n01; c10 = n10; c11 = n11; ++ui;
        if (wr == 1) PG8_BAR;
    }
    PG8_WAIT_V(0);
    PG8_BAR;
#undef PG8_SA
#undef PG8_SB
#undef PG8_STAGE2
#undef PG8_STAGEB
#undef PG8_STAGEA1
#undef PG8_LDA
#undef PG8_LDB
#undef PG8_MMA
#undef PG8_WAIT_V
#undef PG8_WAIT_L
#undef PG8_BAR
#undef PG8_SCHED
#undef PG8_VOFFA
}

__device__ __forceinline__ float clamp448(float v) { return fminf(fmaxf(v, -448.f), 448.f); }
__device__ __forceinline__ unsigned pack_fp8x4(float a, float b, float c, float d) {
    int w = __builtin_amdgcn_cvt_pk_fp8_f32(clamp448(a), clamp448(b), 0, false);
    w = __builtin_amdgcn_cvt_pk_fp8_f32(clamp448(c), clamp448(d), w, true);
    return (unsigned)w;
}
struct EpiStoreBf16 {
    static constexpr bool PERM = true;
    bf16* C; int ldc; size_t gstride; float scale;
    __device__ __forceinline__ void operator()(const f32x4 (&acc)[2][2][4][2], const Unit& u, int wr, int wc, int fr, int fq) const {
        bf16* base = C + (size_t)u.g * gstride + (size_t)(u.pm * BM + wr * 64 + fr) * ldc + u.pn * BM + wc * 32 + 8 * fq;
#pragma unroll
        for (int ai = 0; ai < 2; ++ai)
#pragma unroll
            for (int m = 0; m < 4; ++m) { bf16* rowp = base + (size_t)(ai * HALF + m * 16) * ldc;
#pragma unroll
                for (int bj = 0; bj < 2; ++bj) { const f32x4 v0 = acc[ai][bj][m][0] * scale, v1 = acc[ai][bj][m][1] * scale;
                    u32x4 w; w.x = cvt_pk_bf16(v0[0], v0[1]); w.y = cvt_pk_bf16(v0[2], v0[3]); w.z = cvt_pk_bf16(v1[0], v1[1]); w.w = cvt_pk_bf16(v1[2], v1[3]);
                    *(u32x4*)(rowp + bj * HALF) = w; } }
    }
};
struct EpiStoreFp8 {
    static constexpr bool PERM = true;
    unsigned char* C; int ldc; size_t gstride; float scale;
    __device__ __forceinline__ void operator()(const f32x4 (&acc)[2][2][4][2], const Unit& u, int wr, int wc, int fr, int fq) const {
        unsigned char* base = C + (size_t)u.g * gstride + (size_t)(u.pm * BM + wr * 64 + fr) * ldc + u.pn * BM + wc * 32 + 8 * fq;
#pragma unroll
        for (int ai = 0; ai < 2; ++ai)
#pragma unroll
            for (int m = 0; m < 4; ++m) { unsigned char* rowp = base + (size_t)(ai * HALF + m * 16) * ldc;
#pragma unroll
                for (int bj = 0; bj < 2; ++bj) { const f32x4 v0 = acc[ai][bj][m][0] * scale, v1 = acc[ai][bj][m][1] * scale;
                    uint2 w; w.x = pack_fp8x4(v0[0], v0[1], v0[2], v0[3]); w.y = pack_fp8x4(v1[0], v1[1], v1[2], v1[3]);
                    *(uint2*)(rowp + bj * HALF) = w; } }
    }
};
struct EpiSplitBf16 {
    static constexpr bool PERM = true;
    bf16* C0; bf16* C1;
    __device__ __forceinline__ void operator()(const f32x4 (&acc)[2][2][4][2], const Unit& u, int wr, int wc, int fr, int fq) const {
        const int colt = u.pn * BM; bf16* Cb = colt < 1024 ? C0 : C1;
        bf16* base = Cb + (size_t)(u.pm * BM + wr * 64 + fr) * 1024 + (colt & 1023) + wc * 32 + 8 * fq;
#pragma unroll
        for (int ai = 0; ai < 2; ++ai)
#pragma unroll
            for (int m = 0; m < 4; ++m) { bf16* rowp = base + (size_t)(ai * HALF + m * 16) * 1024;
#pragma unroll
                for (int bj = 0; bj < 2; ++bj) { const f32x4 v0 = acc[ai][bj][m][0], v1 = acc[ai][bj][m][1];
                    u32x4 w; w.x = cvt_pk_bf16(v0[0], v0[1]); w.y = cvt_pk_bf16(v0[2], v0[3]); w.z = cvt_pk_bf16(v1[0], v1[1]); w.w = cvt_pk_bf16(v1[2], v1[3]);
                    *(u32x4*)(rowp + bj * HALF) = w; } }
    }
};
constexpr int FFP = 1536;
constexpr float W8_SCALE = 32.f, HID8_SCALE = 8.f;
struct EpiSwiGLU8 {
    static constexpr bool PERM = true;
    unsigned char* HID;
    __device__ __forceinline__ void operator()(const f32x4 (&acc)[2][2][4][2], const Unit& u, int wr, int wc, int fr, int fq) const {
        unsigned char* base = HID + ((size_t)u.g * ME + u.pm * BM + wr * 64 + fr) * FFP + u.pn * HALF + wc * 32 + 8 * fq;
        const float sg = 1.f / W8_SCALE, su = HID8_SCALE / W8_SCALE;
#pragma unroll
        for (int ai = 0; ai < 2; ++ai)
#pragma unroll
            for (int m = 0; m < 4; ++m) {
                float h[8];
#pragma unroll
                for (int n = 0; n < 2; ++n)
#pragma unroll
                    for (int j = 0; j < 4; ++j) { const float a = acc[ai][0][m][n][j] * sg, uu = acc[ai][1][m][n][j] * su; h[n * 4 + j] = a * __builtin_amdgcn_rcpf(1.f + __builtin_amdgcn_exp2f(-1.4426950408889634f * a)) * uu; }
                uint2 w; w.x = pack_fp8x4(h[0], h[1], h[2], h[3]); w.y = pack_fp8x4(h[4], h[5], h[6], h[7]);
                unsigned char* dst = base + (size_t)(ai * HALF + m * 16) * FFP;
                *(uint2*)dst = w;
                if (u.pn == 10) *(uint2*)(dst + 128) = make_uint2(0u, 0u);
            }
    }
};
struct EpiResid {
    static constexpr bool PERM = true;
    const float* x_in; const float* ctx_in; bf16* xres; const float* modv_l; bool first;
    __device__ __forceinline__ void operator()(const f32x4 (&acc)[2][2][4][2], const Unit& u, int wr, int wc, int fr, int fq) const {
        const int row0t = u.pm * BM;
        const float* rb = row0t < NL ? x_in : ctx_in - (size_t)NL * D;
        const int mr = row0t < NL ? (row0t >> 12) : 8;
        const int row0 = row0t + wr * 64 + fr, col0 = u.pn * BM + wc * 32 + 8 * fq;
        const float* gate = modv_l + (size_t)mr * 6144 + 2 * 1024 + col0;
#pragma unroll
        for (int ai = 0; ai < 2; ++ai)
#pragma unroll
            for (int m = 0; m < 4; ++m) { const size_t off = (size_t)(row0 + ai * HALF + m * 16) * D + col0;
#pragma unroll
                for (int bj = 0; bj < 2; ++bj) {
                    const f32x4 g0 = *(const f32x4*)(gate + bj * HALF), g1 = *(const f32x4*)(gate + bj * HALF + 4);
                    f32x4 r0, r1;
                    if (first) { r0 = *(const f32x4*)(rb + off + bj * HALF); r1 = *(const f32x4*)(rb + off + bj * HALF + 4); }
                    else { const u32x4 w = *(const u32x4*)(xres + off + bj * HALF);
                        r0 = (f32x4){__uint_as_float(w.x << 16), __uint_as_float(w.x & 0xffff0000u), __uint_as_float(w.y << 16), __uint_as_float(w.y & 0xffff0000u)};
                        r1 = (f32x4){__uint_as_float(w.z << 16), __uint_as_float(w.z & 0xffff0000u), __uint_as_float(w.w << 16), __uint_as_float(w.w & 0xffff0000u)}; }
                    const f32x4 v0 = r0 + g0 * acc[ai][bj][m][0], v1 = r1 + g1 * acc[ai][bj][m][1];
                    u32x4 o; o.x = cvt_pk_bf16(v0[0], v0[1]); o.y = cvt_pk_bf16(v0[2], v0[3]); o.z = cvt_pk_bf16(v1[0], v1[1]); o.w = cvt_pk_bf16(v1[2], v1[3]);
                    *(u32x4*)(xres + off + bj * HALF) = o; }
                asm volatile("" ::: "memory"); }
    }
};
}

__device__ __forceinline__ void transpose_item(const float* W, int K, int N, bf16* WT, int k0, int n0, int drow0, float* scr, int lane) {
    float tv[32];
#pragma unroll
    for (int i = 0; i < 32; ++i) tv[i] = W[(size_t)(k0 + 2 * i + (lane >> 5)) * N + n0 + (lane & 31)];
#pragma unroll
    for (int i = 0; i < 32; ++i) scr[(2 * i + (lane >> 5)) * 33 + (lane & 31)] = tv[i];
    __builtin_amdgcn_wave_barrier(); asm volatile("s_waitcnt lgkmcnt(0)" ::: "memory");
    const int c = lane & 7;
#pragma unroll
    for (int j = 0; j < 4; ++j) { const int n = (lane >> 3) + 8 * j; const float* s = scr + (8 * c) * 33 + n;
        uint4 o; o.x = pk2(s[0 * 33], s[1 * 33]); o.y = pk2(s[2 * 33], s[3 * 33]); o.z = pk2(s[4 * 33], s[5 * 33]); o.w = pk2(s[6 * 33], s[7 * 33]);
        *(uint4*)(WT + (size_t)(drow0 + n) * K + k0 + 8 * c) = o; }
    __builtin_amdgcn_wave_barrier(); asm volatile("s_waitcnt lgkmcnt(0)" ::: "memory");
}
constexpr size_t OFF_WT_EVIN = 17 * MiB, OFF_WT_EVOUT = 22 * MiB, OFF_WT_ODIN = 24 * MiB, OFF_WT_ODOUT = 28 * MiB;
constexpr size_t OFF_WGU = 491 * MiB, OFF_WDN = 536 * MiB;
constexpr size_t OFF_WGU1 = 100 * MiB, OFF_WDN1 = 144 * MiB;
constexpr size_t WGU_E = (size_t)2816 * 1024, WDN_E = (size_t)1024 * pg8::FFP;
__device__ __forceinline__ void transpose_item_f8(const float* W, int K, int N, int KP, unsigned char* WT, int k0, int n0, int drow0, float scale, float* scr, int lane) {
    if (k0 < K) {
        float tv[32];
#pragma unroll
        for (int i = 0; i < 32; ++i) tv[i] = W[(size_t)(k0 + 2 * i + (lane >> 5)) * N + n0 + (lane & 31)];
#pragma unroll
        for (int i = 0; i < 32; ++i) scr[(2 * i + (lane >> 5)) * 33 + (lane & 31)] = tv[i] * scale;
    }
    __builtin_amdgcn_wave_barrier(); asm volatile("s_waitcnt lgkmcnt(0)" ::: "memory");
    const int c = lane & 7;
#pragma unroll
    for (int j = 0; j < 4; ++j) { const int n = (lane >> 3) + 8 * j; const float* s = scr + (8 * c) * 33 + n;
        uint2 o = make_uint2(0u, 0u);
        if (k0 < K) { o.x = pg8::pack_fp8x4(s[0 * 33], s[1 * 33], s[2 * 33], s[3 * 33]); o.y = pg8::pack_fp8x4(s[4 * 33], s[5 * 33], s[6 * 33], s[7 * 33]); }
        *(uint2*)(WT + (size_t)(drow0 + n) * KP + k0 + 8 * c) = o; }
    __builtin_amdgcn_wave_barrier(); asm volatile("s_waitcnt lgkmcnt(0)" ::: "memory");
}
__device__ __forceinline__ void ph_convert_other(const P& p, float* sm) {
    const int tix = otid();
    const int lane = tix & 63, wave = tix >> 6; float* scr = sm + wave * (64 * 33);
    const int gw = blockIdx.x * 8 + wave, NGW = gridDim.x * 8;
    constexpr int I0 = 16 * 72, I1 = 16 * 32, I2 = 16 * 64, I3 = 16 * 32;
    for (int it = gw; it < I0 + I1 + I2 + I3; it += NGW) {
        int r = it; const float* W; int N; bf16* WT;
        if (r < I0) { W = p.in[I_EVWIN]; N = 2304; WT = (bf16*)(p.ws + OFF_WT_EVIN); }
        else if ((r -= I0) < I1) { W = p.in[I_EVWOUT]; N = 1024; WT = (bf16*)(p.ws + OFF_WT_EVOUT); }
        else if ((r -= I1) < I2) { W = p.in[I_ODWIN]; N = 2048; WT = (bf16*)(p.ws + OFF_WT_ODIN); }
        else { r -= I2; W = p.in[I_ODWOUT]; N = 1024; WT = (bf16*)(p.ws + OFF_WT_ODOUT); }
        const int nblk = N / 32, k0 = 64 * (r / nblk), n0 = 32 * (r % nblk);
        transpose_item(W, 1024, N, WT, k0, n0, n0, scr, lane);
    }
}
constexpr int CVT_IPE = 1408 + 24 * 32;
constexpr int CVT_ITEMS = NE * CVT_IPE;
__device__ __forceinline__ void ph_convert_moe_range(const P& p, int l, float* sm, const int it0, const int it1, const int widx0, const int nworkers) {
    const int tix = otid();
    const int lane = tix & 63, wave = tix >> 6; float* scr = sm + wave * (64 * 33);
    unsigned char* WGUl = (unsigned char*)(p.ws + (l ? OFF_WGU1 : OFF_WGU)); unsigned char* WDNl = (unsigned char*)(p.ws + (l ? OFF_WDN1 : OFF_WDN));
    for (int it = it0 + widx0 + wave; it < it1; it += nworkers) {
        const int e = it / CVT_IPE; int r = it % CVT_IPE;
        if (r < 1408) {
            const int up = r >= 704; if (up) r -= 704;
            const int k0 = 64 * (r / 44), n0 = 32 * (r % 44);
            const float* W = (up ? p.in[I_WU] : p.in[I_WG]) + (size_t)(l * NE + e) * D * FF;
            transpose_item_f8(W, 1024, FF, 1024, WGUl + (size_t)e * WGU_E, k0, n0, (n0 >> 7) * 256 + up * 128 + (n0 & 127), pg8::W8_SCALE, scr, lane);
        } else { r -= 1408;
            const int k0 = 64 * (r / 32), n0 = 32 * (r % 32);
            transpose_item_f8(p.in[I_WD] + (size_t)(l * NE + e) * FF * D, FF, 1024, pg8::FFP, WDNl + (size_t)e * WDN_E, k0, n0, n0, pg8::W8_SCALE, scr, lane);
        }
    }
}
__device__ __forceinline__ void ph_convert_moe(const P& p, int l, float* sm, const int it0 = 0) { ph_convert_moe_range(p, l, sm, it0, CVT_ITEMS, blockIdx.x * 8, gridDim.x * 8); }
__device__ __forceinline__ void ph_conv4v(const P& p) {
    const int tix = otid();
    const bf16* __restrict__ U = (const bf16*)(p.ws + OFF_H); bf16* __restrict__ UC = (bf16*)(p.ws + OFF_UC);
    const float* cw = p.in[I_ODCW]; const float* cb = p.in[I_ODCB];
    const int total = NT * 128, stride = gridDim.x * blockDim.x, i0 = blockIdx.x * blockDim.x + tix;
    const int j = (i0 & 127) * 8;
    float wv[4][8], bv[8];
    { const float4 b0 = *(const float4*)(cb + j), b1 = *(const float4*)(cb + j + 4); bv[0] = b0.x; bv[1] = b0.y; bv[2] = b0.z; bv[3] = b0.w; bv[4] = b1.x; bv[5] = b1.y; bv[6] = b1.z; bv[7] = b1.w; }
#pragma unroll
    for (int k = 0; k < 4; ++k) { const float4 w0 = *(const float4*)(cw + k * 1024 + j), w1 = *(const float4*)(cw + k * 1024 + j + 4);
        wv[k][0] = w0.x; wv[k][1] = w0.y; wv[k][2] = w0.z; wv[k][3] = w0.w; wv[k][4] = w1.x; wv[k][5] = w1.y; wv[k][6] = w1.z; wv[k][7] = w1.w; }
    for (int ib = i0; ib < total; ib += 4 * stride) {
        uint4 uu[4][4];
#pragma unroll
        for (int q = 0; q < 4; ++q) {
            const int i = ib + q * stride; const int r = min(i, total - 1) >> 7;
            int t, len; if (r < NL) { t = r & 4095; len = SEQ; } else { t = (r - NL) & 255; len = CTXL; }
#pragma unroll
            for (int k = 0; k < 4; ++k) { const int tt = t - 2 + k; uu[q][k] = (tt >= 0 && tt < len) ? *(const uint4*)(U + (size_t)(r - 2 + k) * D + j) : make_uint4(0u, 0u, 0u, 0u); }
        }
#pragma unroll
        for (int q = 0; q < 4; ++q) {
            const int i = ib + q * stride;
            float acc[8];
#pragma unroll
            for (int c = 0; c < 8; ++c) acc[c] = bv[c];
#pragma unroll
            for (int k = 0; k < 4; ++k) { float u[8]; unpack8(uu[q][k], u);
#pragma unroll
                for (int c = 0; c < 8; ++c) acc[c] += wv[k][c] * u[c]; }
            if (i < total) *(uint4*)(UC + (size_t)(i >> 7) * D + j) = pack8(acc);
        }
    }
}
__device__ __forceinline__ void ph_convert_gates(const P& p, float* sm) {
    const int tix = otid();
    const int lane = tix & 63, wave = tix >> 6; float* scr = sm + wave * (64 * 33);
    const int gw = blockIdx.x * 8 + wave, NGW = gridDim.x * 8;
    for (int it = gw; it < 256; it += NGW) {
        const int mat = it >> 3, r = it & 7, type = mat >> 4, dh = mat & 15;
        const float* W = (type ? p.in[I_ODWX] : p.in[I_ODWA]) + (size_t)dh * 16384;
        transpose_item(W, 128, 128, (bf16*)(p.ws + OFF_WT_GATES) + (size_t)mat * 16384, 64 * (r >> 2), 32 * (r & 3), 32 * (r & 3), scr, lane);
    }
}
typedef float af32x4 __attribute__((ext_vector_type(4)));
__device__ __forceinline__ float opq(float x) { asm("" : "+v"(x)); return x; }
template <bool REV>
__device__ __forceinline__ void lru_walk(const bf16* UC, bf16* HX, const int b, const int colbase  , const int ch, const abf16x8 (&wa)[4], const abf16x8 (&wx)[4], const abf16x8 (&efs)[4],
                                         const float ba_, const float bx_, const float c8l2, const int fr, const int fq) {
    float hstate = 0.f;
    const char* ubase = (const char*)(UC + colbase);
    const unsigned vld = (unsigned)(fr * D + 8 * fq) * 2u;
    char* sbase = (char*)HX; const unsigned vst = (unsigned)(4 * fq * D + ch) * 2u;
    const float NL2E = -1.4426950408889634f;
    const float nba_ = NL2E * ba_, nbx_ = NL2E * bx_;
#define LRU_ROW(q) ((q) < 16 ? (NL + b * CTXL + 16 * (REV ? 15 - (q) : (q))) : (b * SEQ + 16 * (REV ? 255 - ((q) - 16) : ((q) - 16))))
#define LRU_LOAD(buf, q) do { const char* ap_ = ubase + (size_t)LRU_ROW(q) * (D * 2); _Pragma("unroll") for (int s = 0; s < 4; ++s) buf[s] = *(const abf16x8*)(ap_ + vld + 64 * s); } while (0)
#define LRU_BODY(buf, q, STORE) do { \
        const int row0_ = LRU_ROW(q); \
        af32x4 zr = {0.f, 0.f, 0.f, 0.f}, zi = {0.f, 0.f, 0.f, 0.f}, uu = {0.f, 0.f, 0.f, 0.f}; \
        _Pragma("unroll") for (int s = 0; s < 4; ++s) { zr = __builtin_amdgcn_mfma_f32_16x16x32_bf16(buf[s], wa[s], zr, 0, 0, 0); zi = __builtin_amdgcn_mfma_f32_16x16x32_bf16(buf[s], wx[s], zi, 0, 0, 0); } \
        _Pragma("unroll") for (int s = 0; s < 4; ++s) uu = __builtin_amdgcn_mfma_f32_16x16x32_bf16(buf[s], efs[s], uu, 0, 0, 0);     \
        { const int qn_ = (q) + 4 < 272 ? (q) + 4 : 271; LRU_LOAD(buf, qn_); } \
        float av[4], bv[4]; \
        _Pragma("unroll") for (int i = 0; i < 4; ++i) {                  \
            const float d1 = 1.f + __builtin_amdgcn_exp2f(opq(NL2E * zr[i] + nba_)); \
            const float d2 = 1.f + __builtin_amdgcn_exp2f(__builtin_amdgcn_fmed3f(opq(NL2E * zi[i] + nbx_), -1e30f, 120.f)); \
            const float a = __builtin_amdgcn_exp2f(opq(c8l2 * __builtin_amdgcn_rcpf(d1))); \
            const float w = opq(1.f - a * a); \
            const float rs = __builtin_amdgcn_rsqf(opq(opq(w * d2) * d2 + 1e-30f)); \
            av[i] = a; bv[i] = opq(opq(w * rs) * uu[i]); } \
        float Ac, Bc; \
        if (!REV) { Ac = av[0]; Bc = bv[0]; _Pragma("unroll") for (int i = 1; i < 4; ++i) { Bc = av[i] * Bc + bv[i]; Ac *= av[i]; } } \
        else { Ac = av[3]; Bc = bv[3]; _Pragma("unroll") for (int i = 2; i >= 0; --i) { Bc = av[i] * Bc + bv[i]; Ac *= av[i]; } } \
        float Ag[4], Bg[4]; \
        _Pragma("unroll") for (int g = 0; g < 4; ++g) { Ag[g] = __shfl(Ac, fr + 16 * g); Bg[g] = __shfl(Bc, fr + 16 * g); } \
        float c = hstate, mine = 0.f; \
        if (!REV) { _Pragma("unroll") for (int g = 0; g < 4; ++g) { if (g == fq) mine = c; c = Ag[g] * c + Bg[g]; } } \
        else { _Pragma("unroll") for (int g = 3; g >= 0; --g) { if (g == fq) mine = c; c = Ag[g] * c + Bg[g]; } } \
        hstate = c; \
        if (STORE) { float hv[4]; float run = mine; \
            if (!REV) { _Pragma("unroll") for (int i = 0; i < 4; ++i) { run = av[i] * run + bv[i]; hv[i] = run; } } \
            else { _Pragma("unroll") for (int i = 3; i >= 0; --i) { run = av[i] * run + bv[i]; hv[i] = run; } } \
            const unsigned p01 = cvtpk(hv[0], hv[1]), p23 = cvtpk(hv[2], hv[3]); \
            char* op_ = sbase + (size_t)row0_ * (D * 2) + vst; \
            *(bf16*)(op_) = (bf16)(p01 & 0xffffu); *(bf16*)(op_ + D * 2) = (bf16)(p01 >> 16); *(bf16*)(op_ + D * 4) = (bf16)(p23 & 0xffffu); *(bf16*)(op_ + D * 6) = (bf16)(p23 >> 16); } \
    } while (0)
    abf16x8 A0[4], A1[4], A2[4], A3[4];
    LRU_LOAD(A0, 0); LRU_LOAD(A1, 1); LRU_LOAD(A2, 2); LRU_LOAD(A3, 3);
    for (int q = 0; q < 16; q += 4) { LRU_BODY(A0, q, false); LRU_BODY(A1, q + 1, false); LRU_BODY(A2, q + 2, false); LRU_BODY(A3, q + 3, false); }
    for (int q = 16; q < 272; q += 4) { LRU_BODY(A0, q, true); LRU_BODY(A1, q + 1, true); LRU_BODY(A2, q + 2, true); LRU_BODY(A3, q + 3, true); }
#undef LRU_ROW
#undef LRU_LOAD
#undef LRU_BODY
}
__device__ __forceinline__ void ph_lru(const P& p, float* sm) {
    const bf16* UC = (const bf16*)(p.ws + OFF_UC); const bf16* WTG = (const bf16*)(p.ws + OFF_WT_GATES);
    int tid_ = threadIdx.x; asm volatile("" : "+v"(tid_));
    const int lane = tid_ & 63, fr = lane & 15, fq = lane >> 4, wave = __builtin_amdgcn_readfirstlane(tid_ >> 6);
    if (wave < 4) {
        for (int task = blockIdx.x * 4 + wave; task < 1024; task += gridDim.x * 4) {
            const int cb = task & 7, d = (task >> 3) & 1, h = (task >> 4) & 7, b = task >> 7;
            const int ch = h * 128 + cb * 16 + fr;
            const float ba_ = p.in[I_ODBA][d * 1024 + ch], bx_ = p.in[I_ODBX][d * 1024 + ch];
            const float c8l2 = -8.f * log1pf(expf(-p.in[I_ODLAM][d * 1024 + ch])) * 1.4426950408889634f;
            abf16x8 wa[4], wx[4];
            const bf16* wpa = WTG + ((size_t)((0 * 2 + d) * 8 + h) * 128 + cb * 16 + fr) * 128 + 8 * fq;
            const bf16* wpx = WTG + ((size_t)((1 * 2 + d) * 8 + h) * 128 + cb * 16 + fr) * 128 + 8 * fq;
#pragma unroll
            for (int s = 0; s < 4; ++s) { wa[s] = *(const abf16x8*)(wpa + 32 * s); wx[s] = *(const abf16x8*)(wpx + 32 * s); }
            const int kl = (cb & 1) * 16 + fr; abf16x8 efs[4];
#pragma unroll
            for (int s = 0; s < 4; ++s)
#pragma unroll
                for (int j = 0; j < 8; ++j) efs[s][j] = (s == (cb >> 1) && (kl >> 3) == fq && (kl & 7) == j) ? (short)0x3F80 : (short)0;
            bf16* HX = (bf16*)(p.ws + (d ? OFF_HB : OFF_HF));
            if (d == 0) lru_walk<false>(UC, HX, b, h * 128, ch, wa, wx, efs, ba_, bx_, c8l2, fr, fq);
            else lru_walk<true>(UC, HX, b, h * 128, ch, wa, wx, efs, ba_, bx_, c8l2, fr, fq);
        }
    }
}
__device__ __forceinline__ void ph_lru_out(const P& p) {
    const int tix = otid();
    bf16* G = (bf16*)(p.ws + OFF_MIX); const bf16* __restrict__ HF = (const bf16*)(p.ws + OFF_HF); const bf16* __restrict__ HB = (const bf16*)(p.ws + OFF_HB);
    const int total = NL * 128, stride = gridDim.x * blockDim.x;
    for (int ib = blockIdx.x * blockDim.x + tix; ib < total; ib += 4 * stride) {
        uint4 gv[4], av[4], cv[4];
#pragma unroll
        for (int q = 0; q < 4; ++q) { const size_t off = (size_t)min(ib + q * stride, total - 1) * 8; gv[q] = *(const uint4*)(G + off); av[q] = *(const uint4*)(HF + off); cv[q] = *(const uint4*)(HB + off); }
#pragma unroll
        for (int q = 0; q < 4; ++q) {
            const int i = ib + q * stride;
            float g[8], a[8], c[8]; unpack8(gv[q], g); unpack8(av[q], a); unpack8(cv[q], c);
#pragma unroll
            for (int z = 0; z < 8; ++z) g[z] = gelu_tanh(g[z]) * (a[z] + c[z]);
            if (i < total) *(uint4*)(G + (size_t)i * 8) = pack8(g);
        }
    }
}

#define LAS __attribute__((address_space(3)))
#define XB_TMO      128
#define XB_XCNT(j)  (256  + 64 * (j))
#define XB_XSUB(j)  (1280 + 64 * (j))
#define XB_XGEN(j)  (2304 + 64 * (j))
#define XB_TOP      3328
#define XB_TOPGEN   3392
#define XCD_BAR_WORDS 3456
#define XB_SPIN_CAP (1u << 18)

__device__ __forceinline__ unsigned xb_ld(unsigned* p)              { return __hip_atomic_load(p, __ATOMIC_RELAXED, __HIP_MEMORY_SCOPE_AGENT); }
__device__ __forceinline__ unsigned xb_add(unsigned* p, unsigned v) { return __hip_atomic_fetch_add(p, v, __ATOMIC_RELAXED, __HIP_MEMORY_SCOPE_AGENT); }
__device__ __forceinline__ unsigned xb_xcc_id() { return (unsigned)__builtin_amdgcn_s_getreg((3 << 11) | 20) & 0xFu; }
#define XB_SPIN(cond, bar) do { unsigned _sp = 0; while (cond) { __builtin_amdgcn_s_sleep(1); \
    if ((++_sp & 255u) == 0u) { if (xb_ld(&(bar)[XB_TMO])) break; if (_sp > XB_SPIN_CAP) { atomicAdd(&(bar)[XB_TMO], 1u); break; } } } } while (0)

struct XcdBarrier {
    unsigned* bar; unsigned x;
    volatile LAS unsigned* st;
};

__device__ __forceinline__ XcdBarrier xcd_barrier_post(unsigned* bar, volatile LAS unsigned* st) {
    XcdBarrier b; b.bar = bar; b.x = xb_xcc_id(); b.st = st;
    if (threadIdx.x == 0) (void)xb_add(&bar[XB_XCNT(b.x)], 1u);
    return b;
}
__device__ __forceinline__ void xcd_barrier_complete(unsigned* bar, unsigned x, unsigned& nloc, unsigned& nx) {
    const unsigned G = gridDim.x * gridDim.y * gridDim.z;
    unsigned sum, cnt, mine, sp = 0u;
    for (;;) {
        sum = 0u; cnt = 0u; mine = 0u;
#pragma unroll
        for (unsigned j = 0; j < 16; ++j) { const unsigned c = xb_ld(&bar[XB_XCNT(j)]); sum += c; cnt += (c > 0u) ? 1u : 0u; mine = (j == x) ? c : mine; }
        if (sum == G) break;
        __builtin_amdgcn_s_sleep(1);
        if ((++sp & 255u) == 0u) { if (xb_ld(&bar[XB_TMO])) break; if (sp > XB_SPIN_CAP) { atomicAdd(&bar[XB_TMO], 1u); break; } }
    }
    nloc = mine > 0u ? mine : 1u; nx = cnt > 0u ? cnt : 1u;
}

__device__ __forceinline__ void xcd_barrier(const XcdBarrier& b) {
    asm volatile("s_waitcnt vmcnt(0)" ::: "memory");
    __syncthreads();
    if (threadIdx.x == 0) {
        unsigned* bar = b.bar;
        __builtin_amdgcn_s_waitcnt(0);
        unsigned nloc = b.st[0], nx = b.st[1];
        if (nloc == 0u) { xcd_barrier_complete(bar, b.x, nloc, nx); b.st[0] = nloc; b.st[1] = nx; }
        const unsigned old = xb_add(&bar[XB_XSUB(b.x)], 1u);
        const unsigned gen = old / nloc;
        if (old + 1u == (gen + 1u) * nloc) {
            __builtin_amdgcn_fence(__ATOMIC_RELEASE, "agent");
            asm volatile("s_waitcnt vmcnt(0)" ::: "memory");
            const unsigned og = xb_add(&bar[XB_TOP], 1u);
            const unsigned tg = og / nx;
            if (og + 1u == (tg + 1u) * nx) xb_add(&bar[XB_TOPGEN], 1u);
            else XB_SPIN(xb_ld(&bar[XB_TOPGEN]) == tg, bar);
            __builtin_amdgcn_fence(__ATOMIC_ACQUIRE, "agent");
            xb_add(&bar[XB_XGEN(b.x)], 1u);
            asm volatile("s_waitcnt vmcnt(0)" ::: "memory");
        } else {
            XB_SPIN(xb_ld(&bar[XB_XGEN(b.x)]) == gen, bar);
            __builtin_amdgcn_fence(__ATOMIC_ACQUIRE, "agent");
            asm volatile("s_waitcnt vmcnt(0)" ::: "memory");
        }
    }
    __syncthreads();
}

typedef float nf32x4 __attribute__((ext_vector_type(4)));
__device__ __forceinline__ void ph_normF(const P& p, const int l, const bool with_ctx, float* sm) {
    const float* modv = (const float*)(p.ws + OFF_MODV);
    const bf16* xres = (const bf16*)(p.ws + OFF_XRES);
    unsigned char* h8 = (unsigned char*)(p.ws + OFF_H);
    const float* rw = p.in[I_RW] + (size_t)l * 1024 * 16;
    const float* gvec = p.in[I_NFFN] + l * 1024;
    int tid_ = threadIdx.x; asm volatile("" : "+v"(tid_));
    const int tid = tid_, lane = tid & 63, fr = lane & 15, fq = lane >> 4, wave = __builtin_amdgcn_readfirstlane(tid >> 6);
    float* RWm = sm; float* biasv = sm + 18432; float* gm = sm + 18448; float* shv = sm + 19472;
    const int nitems = 256;
    for (int item = blockIdx.x; item < nitems; item += gridDim.x) {
        const bool isc = false;
        const int mr = isc ? 8 : (item >> 5);
        const float* mv = modv + (size_t)(l * 9 + mr) * 6144;
        __syncthreads();
        {
#pragma unroll
            for (int q = 0; q < 2; ++q) {
                const int k = 2 * tid + q; const float gmk = gvec[k] * (1.f + mv[4 * 1024 + k]);
                gm[k] = gmk; shv[k] = mv[3 * 1024 + k];
                const float4* w4 = (const float4*)(rw + (size_t)k * 16); float* dst = RWm + (k >> 3) * 144 + (k & 7) * 16;
#pragma unroll
                for (int c = 0; c < 4; ++c) { const float4 w = w4[c]; dst[4 * c] = gmk * w.x; dst[4 * c + 1] = gmk * w.y; dst[4 * c + 2] = gmk * w.z; dst[4 * c + 3] = gmk * w.w; }
            }
            float b0 = 0.f, b1 = 0.f;
            for (int k = lane; k < 1024; k += 64) { const float s = mv[3 * 1024 + k]; b0 += s * rw[(size_t)k * 16 + 2 * wave]; b1 += s * rw[(size_t)k * 16 + 2 * wave + 1]; }
            b0 = wave_sum(b0); b1 = wave_sum(b1);
            if (lane == 0) { biasv[2 * wave] = b0; biasv[2 * wave + 1] = b1; }
        }
        __syncthreads();
        const int tile = isc ? (item - 256) * 8 + wave : item * 8 + wave;
        const int row0 = isc ? NL + tile * 16 : tile * 16;
        const uint4* xq = (const uint4*)(xres + (size_t)(row0 + fr) * D + 8 * fq);
        const float* bq = RWm + fq * 144 + fr;
        nf32x4 acc0 = {0.f, 0.f, 0.f, 0.f}, acc1 = {0.f, 0.f, 0.f, 0.f}; float ss = 0.f;
#pragma unroll 1
        for (int s0 = 0; s0 < 32; s0 += 8) {
            uint4 xw[8];
#pragma unroll
            for (int u = 0; u < 8; ++u) xw[u] = xq[4 * (s0 + u)];
#pragma unroll
            for (int u = 0; u < 8; ++u) {
                float xf[8]; unpack8(xw[u], xf);
                const float* bb = bq + (s0 + u) * 576;
#pragma unroll
                for (int i = 0; i < 8; i += 2) {
                    ss += xf[i] * xf[i] + xf[i + 1] * xf[i + 1];
                    acc0 = __builtin_amdgcn_mfma_f32_16x16x4f32(xf[i], bb[i * 16], acc0, 0, 0, 0);
                    acc1 = __builtin_amdgcn_mfma_f32_16x16x4f32(xf[i + 1], bb[(i + 1) * 16], acc1, 0, 0, 0);
                }
            }
        }
        ss += __shfl_xor(ss, 16); ss += __shfl_xor(ss, 32);
        const float rstd = 1.f / sqrtf(ss * (1.f / D) + EPS);
        const float be = biasv[fr];
#pragma unroll
        for (int reg = 0; reg < 4; ++reg) {
            const float rs = __shfl(rstd, 4 * fq + reg);
            const float lg = (acc0[reg] + acc1[reg]) * rs + be;
            float mx = lg;
#pragma unroll
            for (int o = 1; o < 16; o <<= 1) mx = fmaxf(mx, __shfl_xor(mx, o));
            const float ex = expf(lg - mx); float den = ex;
#pragma unroll
            for (int o = 1; o < 16; o <<= 1) den += __shfl_xor(den, o);
            const float a = ex / den; const int rr = row0 + 4 * fq + reg;
            if (!isc) { const int b = rr >> 12, t = rr & 4095; ((float*)(p.ws + OFF_AFFL))[(size_t)(b * 16 + fr) * SEQ + t] = a; }
            else { const int rc = rr - NL, b = rc >> 8, t = rc & 255; ((float*)(p.ws + OFF_AFFC))[(size_t)(b * 16 + fr) * CTXL + t] = a; }
        }
#pragma unroll 2
        for (int r = 0; r < 16; ++r) {
            const float rs = __shfl(rstd, r);
            const uint2* xr = (const uint2*)(xres + (size_t)(row0 + r) * D);
#pragma unroll
            for (int j = 0; j < 4; ++j) {
                const uint2 xw = xr[lane + 64 * j]; float4 xv; xv.x = bf2f(xw.x & 0xffffu); xv.y = bf2f(xw.x >> 16); xv.z = bf2f(xw.y & 0xffffu); xv.w = bf2f(xw.y >> 16);
                const float4 g = ((const float4*)gm)[lane + 64 * j], sh = ((const float4*)shv)[lane + 64 * j];
                *(unsigned*)(h8 + (size_t)(row0 + r) * D + (lane + 64 * j) * 4) = pg8::pack_fp8x4(xv.x * rs * g.x + sh.x, xv.y * rs * g.y + sh.y, xv.z * rs * g.z + sh.z, xv.w * rs * g.w + sh.w);
            }
        }
    }
}

__device__ __forceinline__ void ph_normF_ctx(const P& p, const int l) {
    const int tix = otid();
    const float* mv = (const float*)(p.ws + OFF_MODV) + (size_t)(l * 9 + 8) * 6144;
    const bf16* xres = (const bf16*)(p.ws + OFF_XRES); unsigned char* h8 = (unsigned char*)(p.ws + OFF_H);
    const float* rw = p.in[I_RW] + (size_t)l * 1024 * 16; const float* gvec = p.in[I_NFFN] + l * 1024;
    const int lane = tix & 63, wave = tix >> 6;
    for (int rc = blockIdx.x * 8 + wave; rc < NC; rc += gridDim.x * 8) {
        const int r = NL + rc;
        const uint2* xr = (const uint2*)(xres + (size_t)r * D);
        float xv[16]; float ss = 0.f;
#pragma unroll
        for (int j = 0; j < 4; ++j) { const uint2 w = xr[lane + 64 * j]; xv[4 * j] = bf2f(w.x & 0xffffu); xv[4 * j + 1] = bf2f(w.x >> 16); xv[4 * j + 2] = bf2f(w.y & 0xffffu); xv[4 * j + 3] = bf2f(w.y >> 16);
            ss += xv[4 * j] * xv[4 * j] + xv[4 * j + 1] * xv[4 * j + 1] + xv[4 * j + 2] * xv[4 * j + 2] + xv[4 * j + 3] * xv[4 * j + 3]; }
        ss = wave_sum(ss);
        const float rstd = 1.f / sqrtf(ss * (1.f / D) + EPS);
        float part[16];
#pragma unroll
        for (int e = 0; e < 16; ++e) part[e] = 0.f;
#pragma unroll
        for (int j = 0; j < 4; ++j) {
            const float4 g = ((const float4*)gvec)[lane + 64 * j], sc = ((const float4*)(mv + 4 * 1024))[lane + 64 * j], sh = ((const float4*)(mv + 3 * 1024))[lane + 64 * j];
            float hh[4];
            hh[0] = xv[4 * j] * rstd * g.x * (1.f + sc.x) + sh.x; hh[1] = xv[4 * j + 1] * rstd * g.y * (1.f + sc.y) + sh.y;
            hh[2] = xv[4 * j + 2] * rstd * g.z * (1.f + sc.z) + sh.z; hh[3] = xv[4 * j + 3] * rstd * g.w * (1.f + sc.w) + sh.w;
            *(unsigned*)(h8 + (size_t)r * D + (lane + 64 * j) * 4) = pg8::pack_fp8x4(hh[0], hh[1], hh[2], hh[3]);
#pragma unroll
            for (int i = 0; i < 4; ++i) {
                const float4* w4 = (const float4*)(rw + (size_t)((lane + 64 * j) * 4 + i) * 16);
#pragma unroll
                for (int q = 0; q < 4; ++q) { const float4 w = w4[q]; part[q * 4 + 0] += hh[i] * w.x; part[q * 4 + 1] += hh[i] * w.y; part[q * 4 + 2] += hh[i] * w.z; part[q * 4 + 3] += hh[i] * w.w; }
            }
        }
        float mx = -1e30f;
#pragma unroll
        for (int e = 0; e < 16; ++e) { part[e] = wave_sum(part[e]); mx = fmaxf(mx, part[e]); }
        float den = 0.f, mine = 0.f;
#pragma unroll
        for (int e = 0; e < 16; ++e) { const float ex = expf(part[e] - mx); den += ex; if (lane == e) mine = ex; }
        if (lane < 16) { const int b = rc >> 8, t = rc & 255; ((float*)(p.ws + OFF_AFFC))[(size_t)(b * 16 + lane) * CTXL + t] = mine / den; }
    }
}

__device__ __forceinline__ void ph_norm0(const P& p) {
    const int tix = otid();
    const float* modv = (const float*)(p.ws + OFF_MODV); bf16* hout = (bf16*)(p.ws + OFF_H);
    const float4* g4 = (const float4*)p.in[I_NMIX];
    const int lane = tix & 63, wave = tix >> 6, stride = gridDim.x * 8;
    for (int rb = blockIdx.x * 8 + wave; rb < NT; rb += 4 * stride) {
        float4 v[4][4]; float ss[4];
#pragma unroll
        for (int q = 0; q < 4; ++q) { const int r = min(rb + q * stride, NT - 1); const float4* xr = (const float4*)in_row(p, r);
#pragma unroll
            for (int j = 0; j < 4; ++j) v[q][j] = xr[lane + 64 * j]; }
#pragma unroll
        for (int q = 0; q < 4; ++q) { float s = 0.f;
#pragma unroll
            for (int j = 0; j < 4; ++j) s += v[q][j].x * v[q][j].x + v[q][j].y * v[q][j].y + v[q][j].z * v[q][j].z + v[q][j].w * v[q][j].w;
            ss[q] = s; }
#pragma unroll
        for (int o = 1; o < 64; o <<= 1) {
#pragma unroll
            for (int q = 0; q < 4; ++q) ss[q] += __shfl_xor(ss[q], o); }
#pragma unroll
        for (int q = 0; q < 4; ++q) {
            const int r = rb + q * stride;
            if (r < NT) {
                const float rstd = 1.f / sqrtf(ss[q] * (1.f / D) + EPS);
                const float* mv = modv + (size_t)mod_row(r) * 6144;
#pragma unroll
                for (int j = 0; j < 4; ++j) {
                    const float4 g = g4[lane + 64 * j], sh = ((const float4*)mv)[lane + 64 * j], sc = ((const float4*)(mv + 1024))[lane + 64 * j];
                    uint2 o; o.x = pk2(v[q][j].x * rstd * g.x * (1.f + sc.x) + sh.x, v[q][j].y * rstd * g.y * (1.f + sc.y) + sh.y);
                    o.y = pk2(v[q][j].z * rstd * g.z * (1.f + sc.z) + sh.z, v[q][j].w * rstd * g.w * (1.f + sc.w) + sh.w);
                    *(uint2*)(hout + (size_t)r * D + (lane + 64 * j) * 4) = o;
                }
            }
        }
    }
}

#define LDSP ((__attribute__((address_space(3))) unsigned char*)lds)
__device__ __forceinline__ pg8::Sched mk_sched(int ng, int M, int N) { pg8::Sched S{}; S.ng = ng; S.nM = M / 256; S.nN = N / 256; S.nwg = ng * S.nM * S.nN; S.G = gridDim.x; S.c = blockIdx.x; return S; }
__device__ __forceinline__ void tail_convert(const P& p, const pg8::Sched& S, unsigned char* lds, const int it0, const int it1) {
    const int R = (S.nwg + S.G - 1) / S.G, T = S.nwg - (R - 1) * S.G;
    if (S.c >= T) ph_convert_moe_range(p, 1, (float*)lds, it0, it1, (S.c - T) * 8, (S.G - T) * 8);
}
constexpr int CVT_Q1 = 1344, CVT_Q2 = CVT_Q1 + 7168, CVT_Q3 = CVT_Q2 + 640, CVT_Q4 = CVT_Q3 + 1536, CVT_Q5 = CVT_Q4 + 4608;
__device__ __forceinline__ void fg_inproj_even(const P& p, unsigned char* lds) {
    pg8::Sched S = mk_sched(1, NT, EVIN);
    S.Abase = p.ws + OFF_H; S.a_tstride = (size_t)256 * D * 2; S.Bbase = p.ws + OFF_WT_EVIN; S.b_tstride = (size_t)256 * D * 2;
    pg8::EpiStoreBf16 E{(bf16*)(p.ws + OFF_PROJ), EVIN, 0, 1.f};
    pg8::gemm_phase<pg8::EpiStoreBf16, false>(LDSP, D * 2, S, E);
    tail_convert(p, S, lds, 0, CVT_Q1);
}
__device__ __forceinline__ void fg_outproj(const P& p, int l, bool first, size_t off_wt, int M, unsigned char* lds) {
    pg8::Sched S = mk_sched(1, M, D);
    S.Abase = p.ws + OFF_MIX; S.a_tstride = (size_t)256 * D * 2; S.Bbase = p.ws + off_wt; S.b_tstride = (size_t)256 * D * 2;
    pg8::EpiResid E{p.in[I_X], p.in[I_CTX], (bf16*)(p.ws + OFF_XRES), (const float*)(p.ws + OFF_MODV) + (size_t)l * 9 * 6144, first};
    pg8::gemm_phase<pg8::EpiResid, false>(LDSP, D * 2, S, E);
    if (l == 0) tail_convert(p, S, lds, CVT_Q1, CVT_Q2);
}
__device__ __forceinline__ void fg_inproj_odd(const P& p, unsigned char* lds) {
    pg8::Sched S = mk_sched(1, NT, 2048);
    S.Abase = p.ws + OFF_H1; S.a_tstride = (size_t)256 * D * 2; S.Bbase = p.ws + OFF_WT_ODIN; S.b_tstride = (size_t)256 * D * 2;
    pg8::EpiSplitBf16 E{(bf16*)(p.ws + OFF_MIX), (bf16*)(p.ws + OFF_H)};
    pg8::gemm_phase<pg8::EpiSplitBf16, false>(LDSP, D * 2, S, E);
    tail_convert(p, S, lds, CVT_Q4, CVT_Q5);
}
__device__ __forceinline__ void fg_moe_up(const P& p, int l, int Me, unsigned char* lds) {
    pg8::Sched S = mk_sched(NE, Me, 2816);
    S.Abase = p.ws + OFF_H; S.rowidx = (const int*)(p.ws + OFF_ROWL); S.idx_gstride = ME;
    S.Bbase = p.ws + (l ? OFF_WGU1 : OFF_WGU); S.b_gstride = WGU_E; S.b_tstride = (size_t)256 * D;
    pg8::EpiSwiGLU8 E{(unsigned char*)(p.ws + OFF_HID)};
    pg8::gemm_phase<pg8::EpiSwiGLU8, true, true>(LDSP, D, S, E);
    if (l == 0) tail_convert(p, S, lds, CVT_Q2, CVT_Q3);
}
__device__ __forceinline__ void fg_moe_down(const P& p, int l, int Me, unsigned char* lds) {
    pg8::Sched S = mk_sched(NE, Me, D);
    S.Abase = p.ws + OFF_HID; S.a_gstride = (size_t)ME * pg8::FFP; S.a_tstride = (size_t)256 * pg8::FFP;
    S.Bbase = p.ws + (l ? OFF_WDN1 : OFF_WDN); S.b_gstride = WDN_E; S.b_tstride = (size_t)256 * pg8::FFP;
    pg8::EpiStoreFp8 E{(unsigned char*)(p.ws + OFF_Y), D, (size_t)ME * D, Y8_SCALE / (pg8::W8_SCALE * pg8::HID8_SCALE)};
    pg8::gemm_phase<pg8::EpiStoreFp8, false, true>(LDSP, pg8::FFP, S, E);
    if (l == 0) tail_convert(p, S, lds, CVT_Q3, CVT_Q4);
}

constexpr int LDS_BYTES = 131072 + 4096;
constexpr size_t OFF_BAR = 640 * MiB;
__global__ void __launch_bounds__(512) k_all(P p) {
    cooperative_groups::grid_group grid = cooperative_groups::this_grid();
    extern __shared__ __attribute__((aligned(16))) unsigned char lds[];
    float* sm = (float*)lds;
    volatile LAS unsigned* st = (volatile LAS unsigned*)((LAS unsigned char*)lds + 131072 + 64);
    if (threadIdx.x < 4) st[threadIdx.x] = 0u;
    __syncthreads();
    XcdBarrier bar = xcd_barrier_post((unsigned*)(p.ws + OFF_BAR), st);
#define GSYNC() xcd_barrier(bar)
    ph_mod(p, sm); __syncthreads(); ph_convert_other(p, sm); ph_convert_gates(p, sm); ph_convert_moe(p, 0, sm); GSYNC();
    if (gridDim.x == 0x7fffffffu) grid.sync();
    ph_norm0(p); GSYNC();
    fg_inproj_even(p, lds); GSYNC();
    ph_prep_attn(p, sm); ph_conv3v(p); GSYNC();
    ph_attn_mfma(p, lds); GSYNC();
    fg_outproj(p, 0, true, OFF_WT_EVOUT, NT, lds); GSYNC();
    ph_normF(p, 0, true, sm); ph_normF_ctx(p, 0); GSYNC();
    ph_topk(p, true, sm); GSYNC();
    fg_moe_up(p, 0, ME, lds); GSYNC();
    fg_moe_down(p, 0, ME, lds); GSYNC();
    ph_combine(p, 0, false, NT); GSYNC();
    fg_inproj_odd(p, lds); GSYNC();
    ph_conv4v(p); GSYNC();
    ph_lru(p, sm); GSYNC();
    ph_lru_out(p); GSYNC();
    fg_outproj(p, 1, false, OFF_WT_ODOUT, NL, lds); GSYNC();
    ph_normF(p, 1, false, sm); GSYNC();
    ph_topk(p, false, sm); __syncthreads(); ph_convert_moe(p, 1, sm, CVT_Q5); GSYNC();
    fg_moe_up(p, 1, NB * CAPL, lds); GSYNC();
    fg_moe_down(p, 1, NB * CAPL, lds); GSYNC();
    ph_combine(p, 1, true, NL);
}
}

extern "C" void kernel_launch(void* const* d_in, const int* in_sizes, int n_in, void* d_out, int out_size, void* d_ws, size_t ws_size, hipStream_t stream) {
    if (n_in != N_IN || ws_size < 644 * MiB) { fprintf(stderr, "kernel_launch: unexpected n_in %d or ws_size %zu\n", n_in, ws_size); return; }
    static int grid_blocks = 0;
    if (!grid_blocks) {
        int dev = 0, cus = 0, per_cu = 0;
        (void)hipGetDevice(&dev);
        (void)hipDeviceGetAttribute(&cus, hipDeviceAttributeMultiprocessorCount, dev);
        (void)hipFuncSetAttribute((const void*)k_all, hipFuncAttributeMaxDynamicSharedMemorySize, LDS_BYTES);
        (void)hipOccupancyMaxActiveBlocksPerMultiprocessor(&per_cu, k_all, 512, LDS_BYTES);
        if (per_cu < 1) per_cu = 1;
        grid_blocks = cus * per_cu;
        fprintf(stderr, "kernel_launch: cus %d per_cu %d grid %d ws %zu\n", cus, per_cu, grid_blocks, ws_size);
    }
    P p{};
    for (int i = 0; i < N_IN; ++i) p.in[i] = (const float*)d_in[i];
    p.out = (float*)d_out; p.ws = (char*)d_ws;
    (void)hipMemsetAsync((char*)d_ws + OFF_BAR, 0, 16384, stream);
    void* args[] = {&p};
    hipError_t e = hipLaunchCooperativeKernel((void*)k_all, dim3(grid_blocks), dim3(512), args, LDS_BYTES, stream);
    if (e != hipSuccess) fprintf(stderr, "cooperative launch failed: %s (grid %d)\n", hipGetErrorString(e), grid_blocks);
}
```

```cpp
#include <hip/hip_runtime.h>
#include <hip/hip_cooperative_groups.h>
#include <cstdio>
#include <cstdint>

namespace {
typedef unsigned short bf16;
constexpr int D = 1024, NB = 8, SEQ = 4096, CTXL = 256;
constexpr int NL = NB * SEQ, NC = NB * CTXL, NT = NL + NC;
constexpr int NE = 16, FF = 1408, CAPL = 512, CAPC = 32;
constexpr int ME = NB * CAPL + NB * CAPC;
constexpr int EVIN = 2304;
constexpr float EPS = 1e-6f;
constexpr float Y8_SCALE = 16.f;

enum { I_X = 0, I_C, I_CTX, I_CCTX, I_ADAW, I_ADAB, I_NMIX, I_NFFN, I_EVWIN, I_EVWOUT, I_EVSINK, I_EVCW, I_EVCB,
       I_ODWIN, I_ODWOUT, I_ODCW, I_ODCB, I_ODWA, I_ODBA, I_ODWX, I_ODBX, I_ODLAM, I_RW, I_WG, I_WU, I_WD, I_FG, N_IN };

constexpr size_t MiB = 1u << 20;
constexpr size_t OFF_MODV = 0;
constexpr size_t OFF_ROPE = 512 * 1024;
constexpr size_t OFF_AFFL = 1 * MiB;
constexpr size_t OFF_AFFC = 3 * MiB;
constexpr size_t OFF_ROWL = 4 * MiB;
constexpr size_t OFF_GATEV = 5 * MiB;
constexpr size_t OFF_SLOT = 6 * MiB;
constexpr size_t OFF_VTL = 8 * MiB + 512 * 1024;
constexpr size_t OFF_KFL = 624 * MiB;
constexpr size_t OFF_KFC = 632 * MiB;
constexpr size_t OFF_WT_GATES = 30 * MiB;
constexpr size_t OFF_VTC = 31 * MiB;
constexpr size_t OFF_XRES = 32 * MiB;
constexpr size_t OFF_H = 168 * MiB;
constexpr size_t OFF_MIX = 236 * MiB;
constexpr size_t OFF_XE = OFF_MIX;
constexpr size_t OFF_Y = OFF_H;
constexpr size_t OFF_PROJ = 304 * MiB;
constexpr size_t OFF_HID = OFF_PROJ;
constexpr size_t OFF_H1 = OFF_PROJ;
constexpr size_t OFF_UC = OFF_PROJ;
constexpr size_t OFF_HF = 372 * MiB;
constexpr size_t OFF_HB = 168 * MiB;
constexpr size_t OFF_Z = 372 * MiB;

struct P { const float* in[N_IN]; float* out; char* ws; };

__device__ __forceinline__ float bf2f(unsigned v) { return __uint_as_float(v << 16); }
__device__ __forceinline__ unsigned f2bf(float f) { unsigned u = __float_as_uint(f); return (u + 0x7fffu + ((u >> 16) & 1u)) >> 16; }
__device__ __forceinline__ unsigned pk2(float lo, float hi) { unsigned r; asm("v_cvt_pk_bf16_f32 %0, %1, %2" : "=v"(r) : "v"(lo), "v"(hi)); return r; }
__device__ __forceinline__ float wave_sum(float v) {
#pragma unroll
    for (int o = 1; o < 64; o <<= 1) v += __shfl_xor(v, o);
    return v;
}
__device__ __forceinline__ float wave_max(float v) {
#pragma unroll
    for (int o = 1; o < 64; o <<= 1) v = fmaxf(v, __shfl_xor(v, o));
    return v;
}
__device__ __forceinline__ int otid() { int t = threadIdx.x; asm volatile("" : "+v"(t)); return t; }
__device__ __forceinline__ int mod_row(int r) { return r < NL ? (r >> 12) : 8; }
__device__ __forceinline__ const float* in_row(const P& p, int r) { return r < NL ? p.in[I_X] + (size_t)r * D : p.in[I_CTX] + (size_t)(r - NL) * D; }

__device__ __forceinline__ void ph_mod(const P& p, float* sm) {
    const int tix = otid();
    float* modv = (float*)(p.ws + OFF_MODV);
    float* red = sm + 9216;
    if (blockIdx.x < 192) {
        for (int i = tix; i < 9 * 1024; i += blockDim.x) {
            int r = i >> 10, k = i & 1023; float v = (r < 8) ? p.in[I_C][r * 1024 + k] : p.in[I_CCTX][k];
            sm[i] = v / (1.f + expf(-v));
        }
        __syncthreads();
    }
    for (int item = blockIdx.x; item < 192; item += gridDim.x) {
        const int l = item / 96, j0 = (item % 96) * 64, kc = tix >> 6, col = tix & 63;
        const float* w = p.in[I_ADAW] + (size_t)l * 1024 * 6144 + (size_t)(kc * 128) * 6144 + j0 + col;
        const float* sv = sm + kc * 128;
        float acc[9];
#pragma unroll
        for (int r = 0; r < 9; ++r) acc[r] = 0.f;
#pragma unroll 16
        for (int k = 0; k < 128; ++k) {
            const float wv = w[(size_t)k * 6144];
#pragma unroll
            for (int r = 0; r < 9; ++r) acc[r] += sv[r * 1024 + k] * wv;
        }
#pragma unroll
        for (int r = 0; r < 9; ++r) red[(r * 8 + kc) * 64 + col] = acc[r];
        __syncthreads();
        for (int i = tix; i < 576; i += blockDim.x) {
            const int r = i >> 6, c = i & 63; float s = 0.f;
#pragma unroll
            for (int q = 0; q < 8; ++q) s += red[(r * 8 + q) * 64 + c];
            modv[(l * 9 + r) * 6144 + j0 + c] = s + p.in[I_ADAB][l * 6144 + j0 + c];
        }
        __syncthreads();
    }
    if (blockIdx.x == gridDim.x - 1) {
        float* tab = (float*)(p.ws + OFF_ROPE);
        for (int i = tix; i < 1024; i += blockDim.x) {
            const int pos = i >> 4, f = i & 15;
            const float inv = powf(10000.f, -(float)f / 16.f);
            const float ang = (float)pos * inv;
            tab[i * 2] = cosf(ang); tab[i * 2 + 1] = sinf(ang);
        }
    }
}


__device__ __forceinline__ void ph_topk(const P& p, bool with_ctx, float* sm) {
    const int tix = otid();
    int* rowl = (int*)(p.ws + OFF_ROWL); float* gatev = (float*)(p.ws + OFF_GATEV); int* slot = (int*)(p.ws + OFF_SLOT);
    int* hist = (int*)sm; int* misc = hist + 256; int* wtot = hist + 272;
    const int lane = tix & 63, wave = tix >> 6;
    const int nitems = with_ctx ? 256 : 128;
    for (int it = blockIdx.x; it < nitems; it += gridDim.x) {
        const bool isc = it >= 128; const int be = it & 127, b = be >> 4, e = be & 15;
        const int n = isc ? CTXL : SEQ, cap = isc ? CAPC : CAPL;
        const float* aff = isc ? (const float*)(p.ws + OFF_AFFC) + (size_t)be * CTXL : (const float*)(p.ws + OFF_AFFL) + (size_t)be * SEQ;
        const bool have = tix * 8 < n;
        unsigned u[8];
        { float4 a = make_float4(0.f, 0.f, 0.f, 0.f), c = a; if (have) { a = *(const float4*)(aff + tix * 8); c = *(const float4*)(aff + tix * 8 + 4); }
          u[0] = __float_as_uint(a.x); u[1] = __float_as_uint(a.y); u[2] = __float_as_uint(a.z); u[3] = __float_as_uint(a.w);
          u[4] = __float_as_uint(c.x); u[5] = __float_as_uint(c.y); u[6] = __float_as_uint(c.z); u[7] = __float_as_uint(c.w); }
        unsigned prefix = 0u, pmask = 0u; int kk = cap;
#pragma unroll 1
        for (int shift = 24; shift >= 0; shift -= 8) {
            __syncthreads();
            if (tix < 256) hist[tix] = 0;
            __syncthreads();
            if (have) {
#pragma unroll
                for (int j = 0; j < 8; ++j) if ((u[j] & pmask) == prefix) atomicAdd(&hist[(u[j] >> shift) & 255u], 1);
            }
            __syncthreads();
            if (wave == 0) {
                const int h0 = hist[4 * lane], h1 = hist[4 * lane + 1], h2 = hist[4 * lane + 2], h3 = hist[4 * lane + 3];
                int tot = h0 + h1 + h2 + h3, suf = tot;
#pragma unroll
                for (int o = 1; o < 64; o <<= 1) { const int t = __shfl_down(suf, o); if (lane + o < 64) suf += t; }
                const int above = suf - tot;
                const int a3 = above, a2 = above + h3, a1 = a2 + h2, a0 = a1 + h1;
                int dsel = -1, kn = 0;
                if (a3 < kk && kk <= a3 + h3) { dsel = 4 * lane + 3; kn = kk - a3; }
                else if (a2 < kk && kk <= a2 + h2) { dsel = 4 * lane + 2; kn = kk - a2; }
                else if (a1 < kk && kk <= a1 + h1) { dsel = 4 * lane + 1; kn = kk - a1; }
                else if (a0 < kk && kk <= a0 + h0) { dsel = 4 * lane; kn = kk - a0; }
                if (dsel >= 0) { misc[0] = dsel; misc[1] = kn; }
            }
            __syncthreads();
            prefix |= (unsigned)misc[0] << shift; pmask |= 255u << shift; kk = misc[1];
        }
        int cg = 0, ce = 0;
        if (have) {
#pragma unroll
            for (int j = 0; j < 8; ++j) { cg += u[j] > prefix ? 1 : 0; ce += u[j] == prefix ? 1 : 0; }
        }
        int packed = cg | (ce << 16), inc = packed;
#pragma unroll
        for (int o = 1; o < 64; o <<= 1) { const int t = __shfl_up(inc, o); if (lane >= o) inc += t; }
        if (lane == 63) wtot[wave] = inc;
        __syncthreads();
        int before = inc - packed;
#pragma unroll
        for (int w = 0; w < 8; ++w) if (w < wave) before += wtot[w];
        int gb = before & 0xffff, eb = before >> 16;
        const int base = isc ? (NB * CAPL + b * CAPC) : b * CAPL;
        const int rowbase = isc ? (NL + b * CTXL) : b * SEQ;
        if (have) {
#pragma unroll
            for (int j = 0; j < 8; ++j) {
                const bool g = u[j] > prefix, q = u[j] == prefix, sel = g || (q && eb < kk);
                const int row = rowbase + tix * 8 + j;
                if (sel) { const int pos = base + gb + min(eb, kk); rowl[e * ME + pos] = row; gatev[e * ME + pos] = __uint_as_float(u[j]); slot[(size_t)e * NT + row] = pos; }
                else slot[(size_t)e * NT + row] = -1;
                gb += g ? 1 : 0; eb += q ? 1 : 0;
            }
        }
    }
}
__device__ __forceinline__ void ph_combine(const P& p, int l, bool last, int nrows) {
    const int tix = otid();
    const float* modv = (const float*)(p.ws + OFF_MODV); bf16* xres = (bf16*)(p.ws + OFF_XRES);
    const unsigned char* Y = (const unsigned char*)(p.ws + OFF_Y); const float* gatev = (const float*)(p.ws + OFF_GATEV); const int* slot = (const int*)(p.ws + OFF_SLOT);
    bf16* H1 = (bf16*)(p.ws + OFF_H1);
    const int lane = tix & 63, wave = tix >> 6;
    for (int r = blockIdx.x * 8 + wave; r < nrows; r += gridDim.x * 8) {
        float4 acc[4];
#pragma unroll
        for (int j = 0; j < 4; ++j) acc[j] = make_float4(0.f, 0.f, 0.f, 0.f);
        const int s_l = lane < NE ? slot[(size_t)lane * NT + r] : -1;
        const float g_l = s_l >= 0 ? gatev[lane * ME + s_l] : 0.f;
        unsigned mask = (unsigned)(__ballot(s_l >= 0) & 0xFFFFull);
        while (mask) {
            unsigned yv[4][4]; float gq[4];
#pragma unroll
            for (int q = 0; q < 4; ++q) {
                int e = 0, s = 0; float g = 0.f;
                if (mask) { e = __builtin_ctz(mask); mask &= mask - 1; s = __builtin_amdgcn_readlane(s_l, e); g = __uint_as_float(__builtin_amdgcn_readlane(__float_as_uint(g_l), e)); }
                gq[q] = g * (1.f / Y8_SCALE);
                const unsigned* yr = (const unsigned*)(Y + ((size_t)e * ME + s) * D);
#pragma unroll
                for (int j = 0; j < 4; ++j) yv[q][j] = yr[lane + 64 * j];
            }
#pragma unroll
            for (int q = 0; q < 4; ++q)
#pragma unroll
                for (int j = 0; j < 4; ++j) { const unsigned w = yv[q][j]; const float g = gq[q];
                    typedef float v2f_ __attribute__((ext_vector_type(2)));
                    const v2f_ lo = __builtin_amdgcn_cvt_pk_f32_fp8((int)w, false), hi2 = __builtin_amdgcn_cvt_pk_f32_fp8((int)w, true);
                    acc[j].x += g * lo[0]; acc[j].y += g * lo[1]; acc[j].z += g * hi2[0]; acc[j].w += g * hi2[1]; }
        }
        const float* mv = modv + (size_t)(l * 9 + mod_row(r)) * 6144;
        uint2* xr = (uint2*)(xres + (size_t)r * D);
        float4 v[4]; float ss = 0.f;
#pragma unroll
        for (int j = 0; j < 4; ++j) {
            const uint2 xw = xr[lane + 64 * j]; float4 x; x.x = bf2f(xw.x & 0xffffu); x.y = bf2f(xw.x >> 16); x.z = bf2f(xw.y & 0xffffu); x.w = bf2f(xw.y >> 16);
            const float4 g5 = ((const float4*)(mv + 5 * 1024))[lane + 64 * j];
            v[j].x = x.x + g5.x * acc[j].x; v[j].y = x.y + g5.y * acc[j].y; v[j].z = x.z + g5.z * acc[j].z; v[j].w = x.w + g5.w * acc[j].w;
            ss += v[j].x * v[j].x + v[j].y * v[j].y + v[j].z * v[j].z + v[j].w * v[j].w;
        }
        ss = wave_sum(ss);
        const float rstd = 1.f / sqrtf(ss * (1.f / D) + EPS);
        if (last) {
            float4* o = (float4*)(p.out + (size_t)r * D); const float4* g4 = (const float4*)p.in[I_FG];
#pragma unroll
            for (int j = 0; j < 4; ++j) { const float4 g = g4[lane + 64 * j]; float4 w; w.x = v[j].x * rstd * g.x; w.y = v[j].y * rstd * g.y; w.z = v[j].z * rstd * g.z; w.w = v[j].w * rstd * g.w; o[lane + 64 * j] = w; }
        } else {
            const float* mv1 = modv + (size_t)((l + 1) * 9 + mod_row(r)) * 6144;
            const float4* g4 = (const float4*)(p.in[I_NMIX] + (l + 1) * 1024);
#pragma unroll
            for (int j = 0; j < 4; ++j) {
                { uint2 xo; xo.x = pk2(v[j].x, v[j].y); xo.y = pk2(v[j].z, v[j].w); xr[lane + 64 * j] = xo; }
                const float4 g = g4[lane + 64 * j], sh = ((const float4*)mv1)[lane + 64 * j], sc = ((const float4*)(mv1 + 1024))[lane + 64 * j];
                uint2 o; o.x = pk2(v[j].x * rstd * g.x * (1.f + sc.x) + sh.x, v[j].y * rstd * g.y * (1.f + sc.y) + sh.y);
                o.y = pk2(v[j].z * rstd * g.z * (1.f + sc.z) + sh.z, v[j].w * rstd * g.w * (1.f + sc.w) + sh.w);
                *(uint2*)(H1 + (size_t)r * D + (lane + 64 * j) * 4) = o;
            }
        }
    }
}
__device__ __forceinline__ float gelu_tanh(float x) {
    const float u = 0.7978845608028654f * (x + 0.044715f * x * x * x);
    return x * __builtin_amdgcn_rcpf(1.f + __builtin_amdgcn_exp2f(-2.f * 1.4426950408889634f * u)); }

__device__ __forceinline__ void unpack8(const uint4& v, float* f) {
    f[0] = bf2f(v.x & 0xffffu); f[1] = bf2f(v.x >> 16); f[2] = bf2f(v.y & 0xffffu); f[3] = bf2f(v.y >> 16);
    f[4] = bf2f(v.z & 0xffffu); f[5] = bf2f(v.z >> 16); f[6] = bf2f(v.w & 0xffffu); f[7] = bf2f(v.w >> 16);
}
__device__ __forceinline__ uint4 pack8(const float* f) { uint4 o; o.x = pk2(f[0], f[1]); o.y = pk2(f[2], f[3]); o.z = pk2(f[4], f[5]); o.w = pk2(f[6], f[7]); return o; }
__device__ __forceinline__ void ph_prep_attn(const P& p, float* sm) {
    const int tix = otid();
    bf16* PROJ = (bf16*)(p.ws + OFF_PROJ); const float* tab = (const float*)(p.ws + OFF_ROPE);
    bf16* KFL = (bf16*)(p.ws + OFF_KFL); bf16* KFC = (bf16*)(p.ws + OFF_KFC);
    const int total = NL * 40;
    for (int i = blockIdx.x * blockDim.x + tix; i < total; i += gridDim.x * blockDim.x) {
        const int r = i / 40, rem = i % 40, hh = rem >> 2, part = (rem >> 1) & 1, hf = rem & 1, t = r & 4095;
        const int pos = part == 0 ? (t >> 6) : (t & 63);
        bf16* base = PROJ + (size_t)r * EVIN + (hh < 8 ? hh * 64 : 512 + (hh - 8) * 64) + part * 32 + hf * 8;
        const uint4 a = *(const uint4*)base, bq = *(const uint4*)(base + 16);
        float x1[8], x2[8], o1[8], o2[8]; unpack8(a, x1); unpack8(bq, x2);
        const float4* cs = (const float4*)(tab + (size_t)(pos * 16 + hf * 8) * 2);
#pragma unroll
        for (int q = 0; q < 4; ++q) { const float4 w = cs[q];
            o1[2 * q] = x1[2 * q] * w.x - x2[2 * q] * w.y; o2[2 * q] = x2[2 * q] * w.x + x1[2 * q] * w.y;
            o1[2 * q + 1] = x1[2 * q + 1] * w.z - x2[2 * q + 1] * w.w; o2[2 * q + 1] = x2[2 * q + 1] * w.z + x1[2 * q + 1] * w.w; }
        if (hh < 8) { *(uint4*)base = pack8(o1); *(uint4*)(base + 16) = pack8(o2); }
        else {
            const int b = r >> 12, hk = hh - 8;
            bf16* kf = KFL + ((((size_t)(b * 2 + hk) * 128 + (t >> 5)) * 4 + 2 * part) * 64 + hf * 32 + (t & 31)) * 8;
            *(uint4*)kf = pack8(o1); *(uint4*)(kf + 512) = pack8(o2);
        }
    }
    for (int i = blockIdx.x * blockDim.x + tix; i < NC * 16; i += gridDim.x * blockDim.x) {
        const int rc = i >> 4, hk = (i >> 3) & 1, s = (i >> 1) & 3, hf = i & 1, b = rc >> 8, t = rc & 255;
        const uint4 v = *(const uint4*)(PROJ + (size_t)(NL + rc) * EVIN + 512 + hk * 64 + 16 * s + 8 * hf);
        *(uint4*)(KFC + ((((size_t)(b * 2 + hk) * 8 + (t >> 5)) * 4 + s) * 64 + hf * 32 + (t & 31)) * 8) = v;
    }
    bf16* tile = (bf16*)sm;
    for (int it = blockIdx.x; it < 1024 + 64; it += gridDim.x) {
        int b, hk, t0, rowbase; bf16* vf;
        if (it < 1024) { b = it >> 7; hk = (it >> 6) & 1; t0 = (it & 63) * 64; rowbase = b * SEQ; vf = (bf16*)(p.ws + OFF_VTL) + (size_t)(b * 2 + hk) * 128 * 2048; }
        else { const int j = it - 1024; b = j >> 3; hk = (j >> 2) & 1; t0 = (j & 3) * 64; rowbase = NL + b * CTXL; vf = (bf16*)(p.ws + OFF_VTC) + (size_t)(b * 2 + hk) * 8 * 2048; }
        __syncthreads();
        for (int i = tix; i < 4096; i += blockDim.x) { const int tok = i >> 6, d = i & 63; tile[tok * 65 + d] = PROJ[(size_t)(rowbase + t0 + tok) * EVIN + 640 + hk * 64 + d]; }
        __syncthreads();
        {
            const int frag = tix >> 6, ln = tix & 63, T = frag >> 2, dt = (frag >> 1) & 1, s = frag & 1, rr = ln & 31, hi = ln >> 5;
            unsigned w[4];
#pragma unroll
            for (int jj = 0; jj < 4; ++jj) {
                const int j0 = 2 * jj, j1 = 2 * jj + 1;
                const unsigned lo = tile[(32 * T + 16 * s + 8 * (j0 >> 2) + 4 * hi + (j0 & 3)) * 65 + 32 * dt + rr];
                const unsigned hi16 = tile[(32 * T + 16 * s + 8 * (j1 >> 2) + 4 * hi + (j1 & 3)) * 65 + 32 * dt + rr];
                w[jj] = lo | (hi16 << 16);
            }
            uint4 o; o.x = w[0]; o.y = w[1]; o.z = w[2]; o.w = w[3];
            *(uint4*)(vf + ((((size_t)((t0 >> 5) + T) * 2 + dt) * 2 + s) * 64 + ln) * 8) = o;
        }
    }
}
typedef short abf16x8 __attribute__((ext_vector_type(8)));
typedef short abf16x4 __attribute__((ext_vector_type(4)));
typedef float af32x16 __attribute__((ext_vector_type(16)));
__device__ __forceinline__ unsigned cvtpk(float lo, float hi) { unsigned r; asm volatile("v_cvt_pk_bf16_f32 %0, %1, %2" : "=v"(r) : "v"(lo), "v"(hi)); return r; }
struct AttnK { abf16x8 k[8]; };
struct AttnV { abf16x8 v[8]; };
__device__ __forceinline__ void attn_load_k(AttnK& f, const char* ub, const unsigned vo) {
#pragma unroll
    for (int s = 0; s < 4; ++s) { f.k[2 * s] = *(const abf16x8*)(ub + vo + s * 1024); f.k[2 * s + 1] = *(const abf16x8*)(ub + vo + (4 + s) * 1024); }
}
__device__ __forceinline__ void attn_load_v(AttnV& f, const char* ub, const unsigned vo) {
#pragma unroll
    for (int dt = 0; dt < 2; ++dt)
#pragma unroll
        for (int T = 0; T < 2; ++T)
#pragma unroll
            for (int s = 0; s < 2; ++s) f.v[(dt * 2 + T) * 2 + s] = *(const abf16x8*)(ub + vo + ((T * 2 + dt) * 2 + s) * 1024);
}
__device__ __forceinline__ void attn_tile(AttnK& f, AttnV& fv, const bool has_next, const char* nkp, const char* nvp, const unsigned vo, const abf16x8* ql, const bool partial, const int kq0  , const int kmax  ,
                                          const int hi, float& m, float& l, af32x16& o0, af32x16& o1) {
    const float CS = 0.125f * 1.4426950408889634f;
    const int kqh = kq0 + 4 * hi;
    af32x16 s0, s1;
#pragma unroll
    for (int i = 0; i < 16; ++i) { s0[i] = 0.f; s1[i] = 0.f; }
    abf16x8 qf[4];
#pragma unroll
    for (int s = 0; s < 4; ++s) qf[s] = ql[s * 64];
#pragma unroll
    for (int s = 0; s < 4; ++s) {
        s0 = __builtin_amdgcn_mfma_f32_32x32x16_bf16(f.k[2 * s], qf[s], s0, 0, 0, 0);
        s1 = __builtin_amdgcn_mfma_f32_32x32x16_bf16(f.k[2 * s + 1], qf[s], s1, 0, 0, 0);
    }
    if (has_next) attn_load_k(f, nkp, vo);
    float tmax = -1e30f;
    if (partial) {
        asm volatile("" ::: "memory");
#pragma unroll
        for (int i = 0; i < 16; ++i) {
            const int c = (i & 3) + 8 * (i >> 2);
            if (kqh > 128 - c || kqh < -128 - c) s0[i] = -1e30f;
            if (kqh > 96 - c || kqh < -160 - c) s1[i] = -1e30f;
        }
    }
#pragma unroll
    for (int i = 0; i < 16; ++i) asm("v_max3_f32 %0, %0, %1, %2" : "+v"(tmax) : "v"(s0[i]), "v"(s1[i]));
    tmax = fmaxf(tmax, __shfl_xor(tmax, 32));
    const float mn = fmaxf(m, tmax * CS), alpha = __builtin_amdgcn_exp2f(m - mn), nmn = -mn; m = mn;
    float sum = 0.f;
#pragma unroll
    for (int i = 0; i < 16; ++i) { s0[i] = __builtin_amdgcn_exp2f(__builtin_fmaf(s0[i], CS, nmn)); s1[i] = __builtin_amdgcn_exp2f(__builtin_fmaf(s1[i], CS, nmn)); sum += s0[i] + s1[i]; }
    l = l * alpha + sum;
#pragma unroll
    for (int i = 0; i < 16; ++i) { float t0 = o0[i] * alpha, t1 = o1[i] * alpha; asm("" : "+v"(t0), "+v"(t1)); o0[i] = t0; o1[i] = t1; }
    typedef unsigned u32x4_ __attribute__((ext_vector_type(4)));
    abf16x8 pf[2][2];
#pragma unroll
    for (int s = 0; s < 2; ++s) {
        u32x4_ w0, w1;
        w0.x = cvtpk(s0[8 * s + 0], s0[8 * s + 1]); w0.y = cvtpk(s0[8 * s + 2], s0[8 * s + 3]); w0.z = cvtpk(s0[8 * s + 4], s0[8 * s + 5]); w0.w = cvtpk(s0[8 * s + 6], s0[8 * s + 7]);
        w1.x = cvtpk(s1[8 * s + 0], s1[8 * s + 1]); w1.y = cvtpk(s1[8 * s + 2], s1[8 * s + 3]); w1.z = cvtpk(s1[8 * s + 4], s1[8 * s + 5]); w1.w = cvtpk(s1[8 * s + 6], s1[8 * s + 7]);
        pf[0][s] = __builtin_bit_cast(abf16x8, w0); pf[1][s] = __builtin_bit_cast(abf16x8, w1);
    }
#pragma unroll
    for (int T = 0; T < 2; ++T)
#pragma unroll
        for (int s = 0; s < 2; ++s) {
            o0 = __builtin_amdgcn_mfma_f32_32x32x16_bf16(fv.v[(0 * 2 + T) * 2 + s], pf[T][s], o0, 0, 0, 0);
            o1 = __builtin_amdgcn_mfma_f32_32x32x16_bf16(fv.v[(1 * 2 + T) * 2 + s], pf[T][s], o1, 0, 0, 0);
        }
    if (has_next) attn_load_v(fv, nvp, vo);
}
__device__ __forceinline__ void ph_attn_mfma(const P& p, unsigned char* lds) {
    const bf16* PROJ = (const bf16*)(p.ws + OFF_PROJ); bf16* MIX = (bf16*)(p.ws + OFF_MIX);
    const bf16* VTL = (const bf16*)(p.ws + OFF_VTL); const bf16* VTC = (const bf16*)(p.ws + OFF_VTC);
    const bf16* KFL = (const bf16*)(p.ws + OFF_KFL); const bf16* KFC = (const bf16*)(p.ws + OFF_KFC);
    int tid_ = threadIdx.x; asm volatile("" : "+v"(tid_));
    const int lane = tid_ & 63, r = lane & 31, hi = lane >> 5, wave = __builtin_amdgcn_readfirstlane(tid_ >> 6);
    const int gw = blockIdx.x * 8 + wave, NGW = gridDim.x * 8;
    int task = gw; bool isctx = false;
    while (true) {
        if (!isctx && task >= 4096) { isctx = true; task = wave == 0 ? (int)blockIdx.x : (1 << 30); }
        if (isctx && task >= 256) break;
        int b, h, q0, rowq;
        if (!isctx) { h = task & 7; q0 = ((task >> 3) & 63) * 64; b = task >> 9; rowq = b * SEQ + q0; }
        else { h = task & 7; q0 = ((task >> 3) & 3) * 64; b = task >> 5; rowq = NL + b * CTXL + q0; }
        const int hk = h >> 2;
        const bf16* qp = PROJ + (size_t)(rowq + r) * EVIN + h * 64 + 8 * hi;
        {
            abf16x8* qw = (abf16x8*)(lds + wave * 8192) + lane;
#pragma unroll
            for (int s = 0; s < 4; ++s) { qw[s * 64] = *(const abf16x8*)(qp + 16 * s); qw[(4 + s) * 64] = *(const abf16x8*)(qp + (size_t)32 * EVIN + 16 * s); }
        }
        const float m0 = p.in[I_EVSINK][h] * 1.4426950408889634f;
        float ma = m0, mb = m0, la = hi ? 0.f : 1.f, lb = la;
        af32x16 oa0, oa1, ob0, ob1;
#pragma unroll
        for (int i = 0; i < 16; ++i) { oa0[i] = 0.f; oa1[i] = 0.f; ob0[i] = 0.f; ob1[i] = 0.f; }
        int kbeg = 0, nloc = 0;
        if (!isctx) { const int lo = max(0, q0 - 128), hik = min(SEQ - 1, q0 + 63 + 128); kbeg = lo & ~63; nloc = ((hik - kbeg) >> 6) + 1; }
        const int ntile = nloc + 4;
        const char* kloc = (const char*)(KFL + (size_t)(b * 2 + hk) * 128 * 2048);
        const char* vloc = (const char*)(VTL + (size_t)(b * 2 + hk) * 128 * 2048);
        const char* kctx = (const char*)(KFC + (size_t)(b * 2 + hk) * 8 * 2048);
        const char* vctx = (const char*)(VTC + (size_t)(b * 2 + hk) * 8 * 2048);
        const unsigned vo = lane * 16;
        AttnK ka; AttnV fv;
        {   const bool loc0 = nloc > 0; const size_t o0_ = loc0 ? (size_t)(kbeg >> 5) * 4096 : 0;
            attn_load_k(ka, (loc0 ? kloc : kctx) + o0_, vo); attn_load_v(fv, (loc0 ? vloc : vctx) + o0_, vo); }
        for (int ti = 0; ti < ntile; ++ti) {
            const int tn = ti + 1; const bool has_next = tn < ntile, nloc_ = tn < nloc;
            const size_t on_ = (size_t)(nloc_ ? ((kbeg >> 5) + 2 * tn) : 2 * (tn - nloc)) * 4096;
            const char* nkp = (nloc_ ? kloc : kctx) + on_; const char* nvp = (nloc_ ? vloc : vctx) + on_;
            unsigned qo_ = wave * 8192 + lane * 16; asm volatile("" : "+v"(qo_));
            const abf16x8* qa = (const abf16x8*)(lds + qo_); const abf16x8* qb = qa + 256;
            const bool loc_ = ti < nloc; const int k0_ = kbeg + 64 * ti;
            const bool pa_ = loc_ && !(k0_ >= q0 + 31 - 128 && k0_ + 63 <= q0 + 128 && k0_ + 63 < SEQ);
            const bool pb_ = loc_ && !(k0_ >= q0 + 63 - 128 && k0_ + 63 <= q0 + 32 + 128 && k0_ + 63 < SEQ);
            attn_tile(ka, fv, false, nkp, nvp, vo, qa, pa_, k0_ - q0 - r, SEQ - k0_, hi, ma, la, oa0, oa1);
            __builtin_amdgcn_sched_barrier(0);
            attn_tile(ka, fv, has_next, nkp, nvp, vo, qb, pb_, k0_ - q0 - 32 - r, SEQ - k0_, hi, mb, lb, ob0, ob1);
        }
        la += __shfl_xor(la, 32); lb += __shfl_xor(lb, 32);
        const float ia = 1.f / la, ib = 1.f / lb;
        bf16* op = MIX + (size_t)(rowq + r) * D + h * 64 + 4 * hi;
#pragma unroll
        for (int g = 0; g < 4; ++g) {
            uint2 w0, w1;
            w0.x = cvtpk(oa0[4 * g] * ia, oa0[4 * g + 1] * ia); w0.y = cvtpk(oa0[4 * g + 2] * ia, oa0[4 * g + 3] * ia);
            w1.x = cvtpk(oa1[4 * g] * ia, oa1[4 * g + 1] * ia); w1.y = cvtpk(oa1[4 * g + 2] * ia, oa1[4 * g + 3] * ia);
            *(uint2*)(op + 8 * g) = w0; *(uint2*)(op + 32 + 8 * g) = w1;
            w0.x = cvtpk(ob0[4 * g] * ib, ob0[4 * g + 1] * ib); w0.y = cvtpk(ob0[4 * g + 2] * ib, ob0[4 * g + 3] * ib);
            w1.x = cvtpk(ob1[4 * g] * ib, ob1[4 * g + 1] * ib); w1.y = cvtpk(ob1[4 * g + 2] * ib, ob1[4 * g + 3] * ib);
            *(uint2*)(op + (size_t)32 * D + 8 * g) = w0; *(uint2*)(op + (size_t)32 * D + 32 + 8 * g) = w1;
        }
        task += isctx ? (int)gridDim.x : NGW;
    }
}
__device__ __forceinline__ void ph_conv3v(const P& p) {
    const int tix = otid();
    const bf16* __restrict__ PROJ = (const bf16*)(p.ws + OFF_PROJ); bf16* __restrict__ MIX = (bf16*)(p.ws + OFF_MIX);
    const float* cw = p.in[I_EVCW]; const float* cb = p.in[I_EVCB];
    const int total = NT * 64, stride = gridDim.x * blockDim.x, i0 = blockIdx.x * blockDim.x + tix;
    const int j = (i0 & 63) * 8;
    float wv[3][8], bv[8];
    { const float4 b0 = *(const float4*)(cb + j), b1 = *(const float4*)(cb + j + 4); bv[0] = b0.x; bv[1] = b0.y; bv[2] = b0.z; bv[3] = b0.w; bv[4] = b1.x; bv[5] = b1.y; bv[6] = b1.z; bv[7] = b1.w; }
#pragma unroll
    for (int k = 0; k < 3; ++k) { const float4 w0 = *(const float4*)(cw + k * 512 + j), w1 = *(const float4*)(cw + k * 512 + j + 4);
        wv[k][0] = w0.x; wv[k][1] = w0.y; wv[k][2] = w0.z; wv[k][3] = w0.w; wv[k][4] = w1.x; wv[k][5] = w1.y; wv[k][6] = w1.z; wv[k][7] = w1.w; }
    for (int ib = i0; ib < total; ib += 2 * stride) {
        uint4 gcv[2][3], uv[2][3], gbv[2];
#pragma unroll
        for (int q = 0; q < 2; ++q) {
            const int i = ib + q * stride; const int r = min(i, total - 1) >> 6;
            int t, len; if (r < NL) { t = r & 4095; len = SEQ; } else { t = (r - NL) & 255; len = CTXL; }
#pragma unroll
            for (int k = 0; k < 3; ++k) { const int tt = t - 1 + k; const bool ok = tt >= 0 && tt < len; const bf16* row = PROJ + (size_t)(r - 1 + k) * EVIN;
                gcv[q][k] = ok ? *(const uint4*)(row + 1280 + j) : make_uint4(0u, 0u, 0u, 0u); uv[q][k] = ok ? *(const uint4*)(row + 1792 + j) : make_uint4(0u, 0u, 0u, 0u); }
            gbv[q] = *(const uint4*)(PROJ + (size_t)r * EVIN + 768 + j);
        }
#pragma unroll
        for (int q = 0; q < 2; ++q) {
            const int i = ib + q * stride;
            float acc[8];
#pragma unroll
            for (int c = 0; c < 8; ++c) acc[c] = bv[c];
#pragma unroll
            for (int k = 0; k < 3; ++k) { float gc[8], u[8]; unpack8(gcv[q][k], gc); unpack8(uv[q][k], u);
#pragma unroll
                for (int c = 0; c < 8; ++c) acc[c] += wv[k][c] * (gc[c] * u[c]); }
            float gb[8]; unpack8(gbv[q], gb);
#pragma unroll
            for (int c = 0; c < 8; ++c) acc[c] *= gb[c];
            if (i < total) *(uint4*)(MIX + (size_t)(i >> 6) * D + 512 + j) = pack8(acc);
        }
    }
}

namespace pg8 {
#define PG8_LAS __attribute__((address_space(3)))
typedef short bf16x8 __attribute__((ext_vector_type(8)));
typedef float f32x4 __attribute__((ext_vector_type(4)));
typedef unsigned u32x4 __attribute__((ext_vector_type(4)));
constexpr int BM = 256, BK = 64, HALF = 128, HTB = HALF * BK * 2, STAGE_BYTES = 8 * HTB, NXCD = 8, WGM = 8;
__device__ __forceinline__ int lds_byte(int r, int c) { const int st = (r >> 4) * 2 + (c >> 5), rr = r & 15, cc = c & 31, ob = rr * 64 + cc * 2; return st * 1024 + (ob ^ (((ob >> 9) & 1) << 5)); }
__device__ __forceinline__ void stage_rc(int b, int& R, int& C) { const int st = b / 1024, sb = b % 1024, swz = sb ^ (((sb >> 9) & 1) << 5); R = (st >> 1) * 16 + swz / 64; C = (st & 1) * 32 + (swz % 64) / 2; }
__device__ __forceinline__ int perm32(int rho) { const int n = rho >> 4, i = rho & 15; return 8 * (i >> 2) + 4 * n + (i & 3); }
__device__ __forceinline__ unsigned cvt_pk_bf16(float lo, float hi) { unsigned r; asm volatile("v_cvt_pk_bf16_f32 %0, %1, %2" : "=v"(r) : "v"(lo), "v"(hi)); return r; }

struct Unit { int g, pm, pn; };
struct Sched {
    int ng, nM, nN, nwg, G, c;
    const char* Abase; size_t a_gstride, a_tstride;
    const char* Bbase; size_t b_gstride, b_tstride;
    const int* rowidx; int idx_gstride;
    __device__ __forceinline__ bool next(int i, Unit& u) const {
        const long L = (long)i * G + c; if (L >= nwg) return false;
        int wgid = (int)L; { const int q = nwg / NXCD, r = nwg % NXCD, xcd = wgid % NXCD, off = wgid / NXCD; wgid = (xcd < r ? xcd * (q + 1) : r * (q + 1) + (xcd - r) * q) + off; }
        const int tpg = nM * nN; u.g = wgid / tpg; const int w = wgid % tpg;
        const int nig = WGM * nN, gid = w / nig, fm = gid * WGM, gsz = (nM - fm) < WGM ? (nM - fm) : WGM;
        u.pm = fm + ((w % nig) % gsz); u.pn = (w % nig) / gsz; return true;
    }
    __device__ __forceinline__ const char* a_base(const Unit& u) const { return Abase + (size_t)u.g * a_gstride + (size_t)u.pm * a_tstride; }
    __device__ __forceinline__ const char* b_base(const Unit& u) const { return Bbase + (size_t)u.g * b_gstride + (size_t)u.pn * b_tstride; }
};

template <class Epi, bool GATHER, bool F8 = false>
__device__ __forceinline__ void gemm_phase(PG8_LAS unsigned char* lds, const int KB  , const Sched& S, const Epi& E) {
    int tid_ = threadIdx.x; asm volatile("" : "+v"(tid_));
    const int tid = tid_, wid = __builtin_amdgcn_readfirstlane(tid >> 6), lane = tid & 63, wr = wid >> 2, wc = wid & 3, fr = lane & 15, fq = lane >> 4;
    const int nt = KB / (BK * 2);
    int Rr[2], Cc[2]; unsigned voffB[2];
#pragma unroll
    for (int i = 0; i < 2; ++i) { stage_rc(tid * 16 + i * 8192, Rr[i], Cc[i]); const int Rb = Epi::PERM ? ((Rr[i] & ~31) + perm32(Rr[i] & 31)) : Rr[i]; voffB[i] = (unsigned)(Rb * KB + Cc[i] * 2); }
    const size_t kstep = (size_t)(BK * 2);
    const size_t hstep = (size_t)HALF * KB;
    const unsigned ldsw = (unsigned)wid * 1024u;
    const int aoff = lds_byte(wr * 64 + fr, fq * 8), boff = lds_byte(wc * 32 + fr, fq * 8);
#define PG8_SA(b, h) (((b) * 2 + (h)) * HTB)
#define PG8_SB(b, h) ((4 + (b) * 2 + (h)) * HTB)
#define PG8_STAGE2(bufoff, gbase, v0, v1) do { unsigned o0_ = (v0), o1_ = (v1); asm volatile("" : "+v"(o0_), "+v"(o1_));     \
        __builtin_amdgcn_global_load_lds((const unsigned*)((const char*)(gbase) + o0_), (PG8_LAS unsigned*)(lds + (bufoff) + ldsw), 16, 0, 0); \
        __builtin_amdgcn_global_load_lds((const unsigned*)((const char*)(gbase) + o1_), (PG8_LAS unsigned*)(lds + (bufoff) + ldsw + 8192), 16, 0, 0); } while (0)
#define PG8_STAGEB(bufoff, gbase) PG8_STAGE2(bufoff, gbase, voffB[0], voffB[1])
#define PG8_STAGEA1(bufoff, gbase, v10, v11, v00, v01) do { if constexpr (GATHER) PG8_STAGE2(bufoff, gbase, v10, v11); else PG8_STAGE2(bufoff, (gbase) + hstep, v00, v01); } while (0)
#define PG8_LDA(dst, b, h) do { _Pragma("unroll") for (int m = 0; m < 4; ++m) { if constexpr (F8) dst##8[m] = __builtin_shufflevector(*(const PG8_LAS v4i_*)(lds + PG8_SA(b, h) + aoff + m * 2048), *(const PG8_LAS v4i_*)(lds + PG8_SA(b, h) + aoff + m * 2048 + 1024), 0, 1, 2, 3, 4, 5, 6, 7); \
        else { _Pragma("unroll") for (int k = 0; k < 2; ++k) dst[m][k] = *(const PG8_LAS bf16x8*)(lds + PG8_SA(b, h) + aoff + m * 2048 + k * 1024); } } } while (0)
#define PG8_LDB(dst, b, h) do { _Pragma("unroll") for (int n = 0; n < 2; ++n) { if constexpr (F8) dst##8[n] = __builtin_shufflevector(*(const PG8_LAS v4i_*)(lds + PG8_SB(b, h) + boff + n * 2048), *(const PG8_LAS v4i_*)(lds + PG8_SB(b, h) + boff + n * 2048 + 1024), 0, 1, 2, 3, 4, 5, 6, 7); \
        else { _Pragma("unroll") for (int k = 0; k < 2; ++k) dst[n][k] = *(const PG8_LAS bf16x8*)(lds + PG8_SB(b, h) + boff + n * 2048 + k * 1024); } } } while (0)
#define PG8_MMA(ai, bj, At, Bt) do { __builtin_amdgcn_s_setprio(1); _Pragma("unroll") for (int m = 0; m < 4; ++m) _Pragma("unroll") for (int n = 0; n < 2; ++n) { \
        if constexpr (F8) asm volatile("v_mfma_scale_f32_16x16x128_f8f6f4 %0, %1, %2, %0, %3, %3 op_sel_hi:[0,0,0]" : "+v"(acc[ai][bj][m][n]) : "v"(Bt##8[n]), "v"(At##8[m]), "v"(scl8));   \
        else { _Pragma("unroll") for (int k = 0; k < 2; ++k) acc[ai][bj][m][n] = __builtin_amdgcn_mfma_f32_16x16x32_bf16(Bt[n][k], At[m][k], acc[ai][bj][m][n], 0, 0, 0); } } \
        __builtin_amdgcn_s_setprio(0); } while (0)
#define PG8_WAIT_V(n) asm volatile("s_waitcnt vmcnt(" #n ")" ::: "memory")
#define PG8_WAIT_L(n) asm volatile("s_waitcnt lgkmcnt(" #n ")" ::: "memory")
#define PG8_BAR __builtin_amdgcn_s_barrier()
#define PG8_SCHED __builtin_amdgcn_sched_barrier(0)
    Unit cur, nxt; int ui = 0;
    if (!S.next(0, cur)) return;
    f32x4 acc[2][2][4][2];
#pragma unroll
    for (int a = 0; a < 2; ++a)
#pragma unroll
        for (int b = 0; b < 2; ++b)
#pragma unroll
            for (int m = 0; m < 4; ++m)
#pragma unroll
                for (int n = 0; n < 2; ++n) acc[a][b][m][n] = (f32x4){0.f, 0.f, 0.f, 0.f};
    typedef int v8i_ __attribute__((ext_vector_type(8))); typedef int v4i_ __attribute__((ext_vector_type(4)));
    unsigned scl8 = 0x7F7F7F7Fu; asm volatile("" : "+v"(scl8));
    bf16x8 At[4][2], B0[2][2], B1[2][2]; v8i_ At8[4], B08[2], B18[2];
    unsigned c00, c01, c10, c11, n00, n01, n10, n11;
#define PG8_VOFFA(u, v00, v01, v10, v11) do { \
        if constexpr (GATHER) { const int* ix = S.rowidx + (size_t)(u).g * S.idx_gstride + (u).pm * BM; \
            int t2_ = tid; asm volatile("" : "+v"(t2_)); int R0_, C0_, R1_, C1_; stage_rc(t2_ * 16, R0_, C0_); stage_rc(t2_ * 16 + 8192, R1_, C1_);     \
            v00 = (unsigned)(ix[R0_] * KB + C0_ * 2); v01 = (unsigned)(ix[R1_] * KB + C1_ * 2); \
            v10 = (unsigned)(ix[HALF + R0_] * KB + C0_ * 2); v11 = (unsigned)(ix[HALF + R1_] * KB + C1_ * 2); } \
        else { v00 = (unsigned)(Rr[0] * KB + Cc[0] * 2); v01 = (unsigned)(Rr[1] * KB + Cc[1] * 2); \
            v10 = (unsigned)((HALF + Rr[0]) * KB + Cc[0] * 2); v11 = (unsigned)((HALF + Rr[1]) * KB + Cc[1] * 2); } } while (0)
    PG8_VOFFA(cur, c00, c01, c10, c11);
    const char* cA = GATHER ? S.Abase : S.a_base(cur); const char* cB = S.b_base(cur);
    PG8_STAGEB(PG8_SB(0, 0), cB); PG8_STAGEB(PG8_SB(0, 1), cB + hstep); PG8_STAGE2(PG8_SA(0, 0), cA, c00, c01); PG8_STAGEA1(PG8_SA(0, 1), cA, c10, c11, c00, c01);
    if (wr == 1) PG8_BAR;
    PG8_WAIT_V(2); PG8_BAR;
    PG8_STAGEB(PG8_SB(1, 0), cB + kstep); PG8_STAGE2(PG8_SA(1, 0), cA + kstep, c00, c01); PG8_STAGEB(PG8_SB(1, 1), cB + hstep + kstep);
    PG8_WAIT_V(6); PG8_BAR;
    for (;;) {
        const bool has_next = S.next(ui + 1, nxt);
        const char* nA = has_next ? (GATHER ? S.Abase : S.a_base(nxt)) : cA; const char* nB = has_next ? S.b_base(nxt) : cB;
        if (has_next) { PG8_VOFFA(nxt, n00, n01, n10, n11); } else { n00 = c00; n01 = c01; n10 = c10; n11 = c11; }
#pragma unroll 1
        for (int t = 0; t < nt; t += 2) {
            const bool last = (t == nt - 2);
            const char* a1 = cA + (size_t)(t + 1) * kstep;
            const char* a2 = last ? nA : cA + (size_t)(t + 2) * kstep; const char* b2 = last ? nB : cB + (size_t)(t + 2) * kstep;
            const char* a3 = a2 + kstep; const char* b3 = b2 + kstep;
            const unsigned x00 = last ? n00 : c00, x01 = last ? n01 : c01, x10 = last ? n10 : c10, x11 = last ? n11 : c11;
            PG8_LDB(B0, 0, 0); PG8_LDB(B1, 0, 1); PG8_SCHED; PG8_LDA(At, 0, 0); PG8_STAGEA1(PG8_SA(1, 1), a1, c10, c11, c00, c01);
            PG8_WAIT_V(8); PG8_WAIT_L(0); PG8_BAR; PG8_MMA(0, 0, At, B0); PG8_MMA(0, 1, At, B1); PG8_BAR; PG8_SCHED;
            PG8_LDA(At, 0, 1); PG8_STAGEB(PG8_SB(0, 0), b2); PG8_STAGEB(PG8_SB(0, 1), b2 + hstep); PG8_STAGE2(PG8_SA(0, 0), a2, x00, x01);
            PG8_WAIT_V(8); PG8_WAIT_L(0); PG8_BAR; PG8_MMA(1, 0, At, B0); PG8_MMA(1, 1, At, B1); PG8_BAR; PG8_SCHED;
            PG8_LDB(B0, 1, 0); PG8_LDB(B1, 1, 1); PG8_SCHED; PG8_LDA(At, 1, 0); PG8_STAGEA1(PG8_SA(0, 1), a2, x10, x11, x00, x01);
            PG8_WAIT_V(8); PG8_WAIT_L(0); PG8_BAR; PG8_MMA(0, 0, At, B0); PG8_MMA(0, 1, At, B1); PG8_BAR; PG8_SCHED;
            PG8_LDA(At, 1, 1); PG8_STAGEB(PG8_SB(1, 0), b3); PG8_STAGEB(PG8_SB(1, 1), b3 + hstep); PG8_STAGE2(PG8_SA(1, 0), a3, x00, x01);
            PG8_WAIT_V(8); PG8_WAIT_L(0); PG8_BAR; PG8_MMA(1, 0, At, B0); PG8_MMA(1, 1, At, B1); PG8_BAR; PG8_SCHED;
        }
        if (wr == 0) PG8_BAR;
        if constexpr (F8) asm volatile("s_nop 15\n\ts_nop 15" ::: "memory");
        { int efr = fr, efq = fq; asm volatile("" : "+v"(efr), "+v"(efq));
          E(acc, cur, wr, wc, efr, efq); }
        if (!has_next) break;
#pragma unroll
        for (int a = 0; a < 2; ++a)
#pragma unroll
            for (int b = 0; b < 2; ++b)
#pragma unroll
                for (int m = 0; m < 4; ++m)
#pragma unroll
                    for (int n = 0; n < 2; ++n) acc[a][b][m][n] = (f32x4){0.f, 0.f, 0.f, 0.f};
        cur = nxt; cA = nA; cB = nB; c00 = n00; c01 = n01; c10 = n10; c11 = n11; ++ui;
        if (wr == 1) PG8_BAR;
    }
    PG8_WAIT_V(0);
    PG8_BAR;
#undef PG8_SA
#undef PG8_SB
#undef PG8_STAGE2
#undef PG8_STAGEB
#undef PG8_STAGEA1
#undef PG8_LDA
#undef PG8_LDB
#undef PG8_MMA
#undef PG8_WAIT_V
#undef PG8_WAIT_L
#undef PG8_BAR
#undef PG8_SCHED
#undef PG8_VOFFA
}

__device__ __forceinline__ float clamp448(float v) { return fminf(fmaxf(v, -448.f), 448.f); }
__device__ __forceinline__ unsigned pack_fp8x4(float a, float b, float c, float d) {
    int w = __builtin_amdgcn_cvt_pk_fp8_f32(clamp448(a), clamp448(b), 0, false);
    w = __builtin_amdgcn_cvt_pk_fp8_f32(clamp448(c), clamp448(d), w, true);
    return (unsigned)w;
}
struct EpiStoreBf16 {
    static constexpr bool PERM = true;
    bf16* C; int ldc; size_t gstride; float scale;
    __device__ __forceinline__ void operator()(const f32x4 (&acc)[2][2][4][2], const Unit& u, int wr, int wc, int fr, int fq) const {
        bf16* base = C + (size_t)u.g * gstride + (size_t)(u.pm * BM + wr * 64 + fr) * ldc + u.pn * BM + wc * 32 + 8 * fq;
#pragma unroll
        for (int ai = 0; ai < 2; ++ai)
#pragma unroll
            for (int m = 0; m < 4; ++m) { bf16* rowp = base + (size_t)(ai * HALF + m * 16) * ldc;
#pragma unroll
                for (int bj = 0; bj < 2; ++bj) { const f32x4 v0 = acc[ai][bj][m][0] * scale, v1 = acc[ai][bj][m][1] * scale;
                    u32x4 w; w.x = cvt_pk_bf16(v0[0], v0[1]); w.y = cvt_pk_bf16(v0[2], v0[3]); w.z = cvt_pk_bf16(v1[0], v1[1]); w.w = cvt_pk_bf16(v1[2], v1[3]);
                    *(u32x4*)(rowp + bj * HALF) = w; } }
    }
};
struct EpiStoreFp8 {
    static constexpr bool PERM = true;
    unsigned char* C; int ldc; size_t gstride; float scale;
    __device__ __forceinline__ void operator()(const f32x4 (&acc)[2][2][4][2], const Unit& u, int wr, int wc, int fr, int fq) const {
        unsigned char* base = C + (size_t)u.g * gstride + (size_t)(u.pm * BM + wr * 64 + fr) * ldc + u.pn * BM + wc * 32 + 8 * fq;
#pragma unroll
        for (int ai = 0; ai < 2; ++ai)
#pragma unroll
            for (int m = 0; m < 4; ++m) { unsigned char* rowp = base + (size_t)(ai * HALF + m * 16) * ldc;
#pragma unroll
                for (int bj = 0; bj < 2; ++bj) { const f32x4 v0 = acc[ai][bj][m][0] * scale, v1 = acc[ai][bj][m][1] * scale;
                    uint2 w; w.x = pack_fp8x4(v0[0], v0[1], v0[2], v0[3]); w.y = pack_fp8x4(v1[0], v1[1], v1[2], v1[3]);
                    *(uint2*)(rowp + bj * HALF) = w; } }
    }
};
struct EpiSplitBf16 {
    static constexpr bool PERM = true;
    bf16* C0; bf16* C1;
    __device__ __forceinline__ void operator()(const f32x4 (&acc)[2][2][4][2], const Unit& u, int wr, int wc, int fr, int fq) const {
        const int colt = u.pn * BM; bf16* Cb = colt < 1024 ? C0 : C1;
        bf16* base = Cb + (size_t)(u.pm * BM + wr * 64 + fr) * 1024 + (colt & 1023) + wc * 32 + 8 * fq;
#pragma unroll
        for (int ai = 0; ai < 2; ++ai)
#pragma unroll
            for (int m = 0; m < 4; ++m) { bf16* rowp = base + (size_t)(ai * HALF + m * 16) * 1024;
#pragma unroll
                for (int bj = 0; bj < 2; ++bj) { const f32x4 v0 = acc[ai][bj][m][0], v1 = acc[ai][bj][m][1];
                    u32x4 w; w.x = cvt_pk_bf16(v0[0], v0[1]); w.y = cvt_pk_bf16(v0[2], v0[3]); w.z = cvt_pk_bf16(v1[0], v1[1]); w.w = cvt_pk_bf16(v1[2], v1[3]);
                    *(u32x4*)(rowp + bj * HALF) = w; } }
    }
};
constexpr int FFP = 1536;
constexpr float W8_SCALE = 32.f, HID8_SCALE = 8.f;
struct EpiSwiGLU8 {
    static constexpr bool PERM = true;
    unsigned char* HID;
    __device__ __forceinline__ void operator()(const f32x4 (&acc)[2][2][4][2], const Unit& u, int wr, int wc, int fr, int fq) const {
        unsigned char* base = HID + ((size_t)u.g * ME + u.pm * BM + wr * 64 + fr) * FFP + u.pn * HALF + wc * 32 + 8 * fq;
        const float sg = 1.f / W8_SCALE, su = HID8_SCALE / W8_SCALE;
#pragma unroll
        for (int ai = 0; ai < 2; ++ai)
#pragma unroll
            for (int m = 0; m < 4; ++m) {
                float h[8];
#pragma unroll
                for (int n = 0; n < 2; ++n)
#pragma unroll
                    for (int j = 0; j < 4; ++j) { const float a = acc[ai][0][m][n][j] * sg, uu = acc[ai][1][m][n][j] * su; h[n * 4 + j] = a * __builtin_amdgcn_rcpf(1.f + __builtin_amdgcn_exp2f(-1.4426950408889634f * a)) * uu; }
                uint2 w; w.x = pack_fp8x4(h[0], h[1], h[2], h[3]); w.y = pack_fp8x4(h[4], h[5], h[6], h[7]);
                unsigned char* dst = base + (size_t)(ai * HALF + m * 16) * FFP;
                *(uint2*)dst = w;
                if (u.pn == 10) *(uint2*)(dst + 128) = make_uint2(0u, 0u);
            }
    }
};
struct EpiResid {
    static constexpr bool PERM = true;
    const float* x_in; const float* ctx_in; bf16* xres; const float* modv_l; bool first;
    __device__ __forceinline__ void operator()(const f32x4 (&acc)[2][2][4][2], const Unit& u, int wr, int wc, int fr, int fq) const {
        const int row0t = u.pm * BM;
        const float* rb = row0t < NL ? x_in : ctx_in - (size_t)NL * D;
        const int mr = row0t < NL ? (row0t >> 12) : 8;
        const int row0 = row0t + wr * 64 + fr, col0 = u.pn * BM + wc * 32 + 8 * fq;
        const float* gate = modv_l + (size_t)mr * 6144 + 2 * 1024 + col0;
#pragma unroll
        for (int ai = 0; ai < 2; ++ai)
#pragma unroll
            for (int m = 0; m < 4; ++m) { const size_t off = (size_t)(row0 + ai * HALF + m * 16) * D + col0;
#pragma unroll
                for (int bj = 0; bj < 2; ++bj) {
                    const f32x4 g0 = *(const f32x4*)(gate + bj * HALF), g1 = *(const f32x4*)(gate + bj * HALF + 4);
                    f32x4 r0, r1;
                    if (first) { r0 = *(const f32x4*)(rb + off + bj * HALF); r1 = *(const f32x4*)(rb + off + bj * HALF + 4); }
                    else { const u32x4 w = *(const u32x4*)(xres + off + bj * HALF);
                        r0 = (f32x4){__uint_as_float(w.x << 16), __uint_as_float(w.x & 0xffff0000u), __uint_as_float(w.y << 16), __uint_as_float(w.y & 0xffff0000u)};
                        r1 = (f32x4){__uint_as_float(w.z << 16), __uint_as_float(w.z & 0xffff0000u), __uint_as_float(w.w << 16), __uint_as_float(w.w & 0xffff0000u)}; }
                    const f32x4 v0 = r0 + g0 * acc[ai][bj][m][0], v1 = r1 + g1 * acc[ai][bj][m][1];
                    u32x4 o; o.x = cvt_pk_bf16(v0[0], v0[1]); o.y = cvt_pk_bf16(v0[2], v0[3]); o.z = cvt_pk_bf16(v1[0], v1[1]); o.w = cvt_pk_bf16(v1[2], v1[3]);
                    *(u32x4*)(xres + off + bj * HALF) = o; }
                asm volatile("" ::: "memory"); }
    }
};
}

__device__ __forceinline__ void transpose_item(const float* W, int K, int N, bf16* WT, int k0, int n0, int drow0, float* scr, int lane) {
    float tv[32];
#pragma unroll
    for (int i = 0; i < 32; ++i) tv[i] = W[(size_t)(k0 + 2 * i + (lane >> 5)) * N + n0 + (lane & 31)];
#pragma unroll
    for (int i = 0; i < 32; ++i) scr[(2 * i + (lane >> 5)) * 33 + (lane & 31)] = tv[i];
    __builtin_amdgcn_wave_barrier(); asm volatile("s_waitcnt lgkmcnt(0)" ::: "memory");
    const int c = lane & 7;
#pragma unroll
    for (int j = 0; j < 4; ++j) { const int n = (lane >> 3) + 8 * j; const float* s = scr + (8 * c) * 33 + n;
        uint4 o; o.x = pk2(s[0 * 33], s[1 * 33]); o.y = pk2(s[2 * 33], s[3 * 33]); o.z = pk2(s[4 * 33], s[5 * 33]); o.w = pk2(s[6 * 33], s[7 * 33]);
        *(uint4*)(WT + (size_t)(drow0 + n) * K + k0 + 8 * c) = o; }
    __builtin_amdgcn_wave_barrier(); asm volatile("s_waitcnt lgkmcnt(0)" ::: "memory");
}
constexpr size_t OFF_WT_EVIN = 17 * MiB, OFF_WT_EVOUT = 22 * MiB, OFF_WT_ODIN = 24 * MiB, OFF_WT_ODOUT = 28 * MiB;
constexpr size_t OFF_WGU = 491 * MiB, OFF_WDN = 536 * MiB;
constexpr size_t OFF_WGU1 = 100 * MiB, OFF_WDN1 = 144 * MiB;
constexpr size_t WGU_E = (size_t)2816 * 1024, WDN_E = (size_t)1024 * pg8::FFP;
__device__ __forceinline__ void transpose_item_f8(const float* W, int K, int N, int KP, unsigned char* WT, int k0, int n0, int drow0, float scale, float* scr, int lane) {
    if (k0 < K) {
        float tv[32];
#pragma unroll
        for (int i = 0; i < 32; ++i) tv[i] = W[(size_t)(k0 + 2 * i + (lane >> 5)) * N + n0 + (lane & 31)];
#pragma unroll
        for (int i = 0; i < 32; ++i) scr[(2 * i + (lane >> 5)) * 33 + (lane & 31)] = tv[i] * scale;
    }
    __builtin_amdgcn_wave_barrier(); asm volatile("s_waitcnt lgkmcnt(0)" ::: "memory");
    const int c = lane & 7;
#pragma unroll
    for (int j = 0; j < 4; ++j) { const int n = (lane >> 3) + 8 * j; const float* s = scr + (8 * c) * 33 + n;
        uint2 o = make_uint2(0u, 0u);
        if (k0 < K) { o.x = pg8::pack_fp8x4(s[0 * 33], s[1 * 33], s[2 * 33], s[3 * 33]); o.y = pg8::pack_fp8x4(s[4 * 33], s[5 * 33], s[6 * 33], s[7 * 33]); }
        *(uint2*)(WT + (size_t)(drow0 + n) * KP + k0 + 8 * c) = o; }
    __builtin_amdgcn_wave_barrier(); asm volatile("s_waitcnt lgkmcnt(0)" ::: "memory");
}
__device__ __forceinline__ void ph_convert_other(const P& p, float* sm) {
    const int tix = otid();
    const int lane = tix & 63, wave = tix >> 6; float* scr = sm + wave * (64 * 33);
    const int gw = blockIdx.x * 8 + wave, NGW = gridDim.x * 8;
    constexpr int I0 = 16 * 72, I1 = 16 * 32, I2 = 16 * 64, I3 = 16 * 32;
    for (int it = gw; it < I0 + I1 + I2 + I3; it += NGW) {
        int r = it; const float* W; int N; bf16* WT;
        if (r < I0) { W = p.in[I_EVWIN]; N = 2304; WT = (bf16*)(p.ws + OFF_WT_EVIN); }
        else if ((r -= I0) < I1) { W = p.in[I_EVWOUT]; N = 1024; WT = (bf16*)(p.ws + OFF_WT_EVOUT); }
        else if ((r -= I1) < I2) { W = p.in[I_ODWIN]; N = 2048; WT = (bf16*)(p.ws + OFF_WT_ODIN); }
        else { r -= I2; W = p.in[I_ODWOUT]; N = 1024; WT = (bf16*)(p.ws + OFF_WT_ODOUT); }
        const int nblk = N / 32, k0 = 64 * (r / nblk), n0 = 32 * (r % nblk);
        transpose_item(W, 1024, N, WT, k0, n0, n0, scr, lane);
    }
}
constexpr int CVT_IPE = 1408 + 24 * 32;
constexpr int CVT_ITEMS = NE * CVT_IPE;
__device__ __forceinline__ void ph_convert_moe_range(const P& p, int l, float* sm, const int it0, const int it1, const int widx0, const int nworkers) {
    const int tix = otid();
    const int lane = tix & 63, wave = tix >> 6; float* scr = sm + wave * (64 * 33);
    unsigned char* WGUl = (unsigned char*)(p.ws + (l ? OFF_WGU1 : OFF_WGU)); unsigned char* WDNl = (unsigned char*)(p.ws + (l ? OFF_WDN1 : OFF_WDN));
    for (int it = it0 + widx0 + wave; it < it1; it += nworkers) {
        const int e = it / CVT_IPE; int r = it % CVT_IPE;
        if (r < 1408) {
            const int up = r >= 704; if (up) r -= 704;
            const int k0 = 64 * (r / 44), n0 = 32 * (r % 44);
            const float* W = (up ? p.in[I_WU] : p.in[I_WG]) + (size_t)(l * NE + e) * D * FF;
            transpose_item_f8(W, 1024, FF, 1024, WGUl + (size_t)e * WGU_E, k0, n0, (n0 >> 7) * 256 + up * 128 + (n0 & 127), pg8::W8_SCALE, scr, lane);
        } else { r -= 1408;
            const int k0 = 64 * (r / 32), n0 = 32 * (r % 32);
            transpose_item_f8(p.in[I_WD] + (size_t)(l * NE + e) * FF * D, FF, 1024, pg8::FFP, WDNl + (size_t)e * WDN_E, k0, n0, n0, pg8::W8_SCALE, scr, lane);
        }
    }
}
__device__ __forceinline__ void ph_convert_moe(const P& p, int l, float* sm, const int it0 = 0) { ph_convert_moe_range(p, l, sm, it0, CVT_ITEMS, blockIdx.x * 8, gridDim.x * 8); }
__device__ __forceinline__ void ph_conv4v(const P& p) {
    const int tix = otid();
    const bf16* __restrict__ U = (const bf16*)(p.ws + OFF_H); bf16* __restrict__ UC = (bf16*)(p.ws + OFF_UC);
    const float* cw = p.in[I_ODCW]; const float* cb = p.in[I_ODCB];
    const int total = NT * 128, stride = gridDim.x * blockDim.x, i0 = blockIdx.x * blockDim.x + tix;
    const int j = (i0 & 127) * 8;
    float wv[4][8], bv[8];
    { const float4 b0 = *(const float4*)(cb + j), b1 = *(const float4*)(cb + j + 4); bv[0] = b0.x; bv[1] = b0.y; bv[2] = b0.z; bv[3] = b0.w; bv[4] = b1.x; bv[5] = b1.y; bv[6] = b1.z; bv[7] = b1.w; }
#pragma unroll
    for (int k = 0; k < 4; ++k) { const float4 w0 = *(const float4*)(cw + k * 1024 + j), w1 = *(const float4*)(cw + k * 1024 + j + 4);
        wv[k][0] = w0.x; wv[k][1] = w0.y; wv[k][2] = w0.z; wv[k][3] = w0.w; wv[k][4] = w1.x; wv[k][5] = w1.y; wv[k][6] = w1.z; wv[k][7] = w1.w; }
    for (int ib = i0; ib < total; ib += 4 * stride) {
        uint4 uu[4][4];
#pragma unroll
        for (int q = 0; q < 4; ++q) {
            const int i = ib + q * stride; const int r = min(i, total - 1) >> 7;
            int t, len; if (r < NL) { t = r & 4095; len = SEQ; } else { t = (r - NL) & 255; len = CTXL; }
#pragma unroll
            for (int k = 0; k < 4; ++k) { const int tt = t - 2 + k; uu[q][k] = (tt >= 0 && tt < len) ? *(const uint4*)(U + (size_t)(r - 2 + k) * D + j) : make_uint4(0u, 0u, 0u, 0u); }
        }
#pragma unroll
        for (int q = 0; q < 4; ++q) {
            const int i = ib + q * stride;
            float acc[8];
#pragma unroll
            for (int c = 0; c < 8; ++c) acc[c] = bv[c];
#pragma unroll
            for (int k = 0; k < 4; ++k) { float u[8]; unpack8(uu[q][k], u);
#pragma unroll
                for (int c = 0; c < 8; ++c) acc[c] += wv[k][c] * u[c]; }
            if (i < total) *(uint4*)(UC + (size_t)(i >> 7) * D + j) = pack8(acc);
        }
    }
}
__device__ __forceinline__ void ph_convert_gates(const P& p, float* sm) {
    const int tix = otid();
    const int lane = tix & 63, wave = tix >> 6; float* scr = sm + wave * (64 * 33);
    const int gw = blockIdx.x * 8 + wave, NGW = gridDim.x * 8;
    for (int it = gw; it < 256; it += NGW) {
        const int mat = it >> 3, r = it & 7, type = mat >> 4, dh = mat & 15;
        const float* W = (type ? p.in[I_ODWX] : p.in[I_ODWA]) + (size_t)dh * 16384;
        transpose_item(W, 128, 128, (bf16*)(p.ws + OFF_WT_GATES) + (size_t)mat * 16384, 64 * (r >> 2), 32 * (r & 3), 32 * (r & 3), scr, lane);
    }
}
typedef float af32x4 __attribute__((ext_vector_type(4)));
__device__ __forceinline__ float opq(float x) { asm("" : "+v"(x)); return x; }
template <bool REV>
__device__ __forceinline__ void lru_walk(const bf16* UC, bf16* HX, const int b, const int colbase  , const int ch, const abf16x8 (&wa)[4], const abf16x8 (&wx)[4], const abf16x8 (&efs)[4],
                                         const float ba_, const float bx_, const float c8l2, const int fr, const int fq, char* wl  ) {
    float hstate = 0.f;
    const char* ubase = (const char*)(UC + colbase);
    const unsigned vld = (unsigned)(fr * D + 8 * fq) * 2u;
    const int ln_ = fr + 16 * fq;
    char* sbase = (char*)HX; const unsigned vst = (unsigned)((ln_ >> 1) * D + (ch - fr) + (ln_ & 1) * 8) * 2u;
    char* wlw = wl + (4 * fq) * 48 + 2 * fr; const char* wlr = wl + (ln_ >> 1) * 48 + (ln_ & 1) * 16;
    const float NL2E = -1.4426950408889634f;
    const float nba_ = NL2E * ba_, nbx_ = NL2E * bx_;
#define LRU_ROW(q) ((q) < 16 ? (NL + b * CTXL + 16 * (REV ? 15 - (q) : (q))) : (b * SEQ + 16 * (REV ? 255 - ((q) - 16) : ((q) - 16))))
#define LRU_LOAD(buf, q) do { const char* ap_ = ubase + (size_t)LRU_ROW(q) * (D * 2); _Pragma("unroll") for (int s = 0; s < 4; ++s) buf[s] = *(const abf16x8*)(ap_ + vld + 64 * s); } while (0)
    af32x4 zr, zi, uu; float pav[4], pbv[4], pAg[4], pBg[4]; int prow0 = 0;
#define LRU_MFMA(buf, q) do { \
        zr = (af32x4){0.f, 0.f, 0.f, 0.f}; zi = zr; uu = zr; \
        _Pragma("unroll") for (int s = 0; s < 4; ++s) { zr = __builtin_amdgcn_mfma_f32_16x16x32_bf16(buf[s], wa[s], zr, 0, 0, 0); zi = __builtin_amdgcn_mfma_f32_16x16x32_bf16(buf[s], wx[s], zi, 0, 0, 0); } \
        _Pragma("unroll") for (int s = 0; s < 4; ++s) uu = __builtin_amdgcn_mfma_f32_16x16x32_bf16(buf[s], efs[s], uu, 0, 0, 0);     \
        { const int qn_ = (q) + 6 < 272 ? (q) + 6 : 271; LRU_LOAD(buf, qn_); } \
        __builtin_amdgcn_sched_barrier(0); } while (0)
#define LRU_GATES(q) do { \
        _Pragma("unroll") for (int i = 0; i < 4; ++i) {                  \
            const float d1 = 1.f + __builtin_amdgcn_exp2f(opq(NL2E * zr[i] + nba_)); \
            const float d2 = 1.f + __builtin_amdgcn_exp2f(__builtin_amdgcn_fmed3f(opq(NL2E * zi[i] + nbx_), -1e30f, 120.f)); \
            const float a = __builtin_amdgcn_exp2f(opq(c8l2 * __builtin_amdgcn_rcpf(d1))); \
            const float w = opq(1.f - a * a); \
            const float rs = __builtin_amdgcn_rsqf(opq(opq(w * d2) * d2 + 1e-30f)); \
            pav[i] = a; pbv[i] = opq(opq(w * rs) * uu[i]); } \
        float Ac, Bc; \
        if (!REV) { Ac = pav[0]; Bc = pbv[0]; _Pragma("unroll") for (int i = 1; i < 4; ++i) { Bc = pav[i] * Bc + pbv[i]; Ac *= pav[i]; } } \
        else { Ac = pav[3]; Bc = pbv[3]; _Pragma("unroll") for (int i = 2; i >= 0; --i) { Bc = pav[i] * Bc + pbv[i]; Ac *= pav[i]; } } \
        _Pragma("unroll") for (int g = 0; g < 4; ++g) { pAg[g] = __shfl(Ac, fr + 16 * g); pBg[g] = __shfl(Bc, fr + 16 * g); } \
        prow0 = LRU_ROW(q); \
        __builtin_amdgcn_sched_barrier(0); } while (0)
#define LRU_SCAN(STORE) do { \
        float c = hstate, mine = 0.f; \
        if (!REV) { _Pragma("unroll") for (int g = 0; g < 4; ++g) { if (g == fq) mine = c; c = pAg[g] * c + pBg[g]; } } \
        else { _Pragma("unroll") for (int g = 3; g >= 0; --g) { if (g == fq) mine = c; c = pAg[g] * c + pBg[g]; } } \
        hstate = c; \
        if (STORE) { float hv[4]; float run = mine; \
            if (!REV) { _Pragma("unroll") for (int i = 0; i < 4; ++i) { run = pav[i] * run + pbv[i]; hv[i] = run; } } \
            else { _Pragma("unroll") for (int i = 3; i >= 0; --i) { run = pav[i] * run + pbv[i]; hv[i] = run; } } \
            const unsigned p01 = cvtpk(hv[0], hv[1]), p23 = cvtpk(hv[2], hv[3]); \
            *(bf16*)(wlw) = (bf16)(p01 & 0xffffu); *(bf16*)(wlw + 48) = (bf16)(p01 >> 16); *(bf16*)(wlw + 96) = (bf16)(p23 & 0xffffu); *(bf16*)(wlw + 144) = (bf16)(p23 >> 16); \
            if (ln_ < 32) { const uint4 tv_ = *(const uint4*)wlr; *(uint4*)(sbase + (size_t)prow0 * (D * 2) + vst) = tv_; } } \
        __builtin_amdgcn_sched_barrier(0); } while (0)
#define LRU_STEP(buf, q, STORE) do { LRU_MFMA(buf, q); LRU_SCAN(STORE); LRU_GATES(q); } while (0)
    abf16x8 A0[4], A1[4], A2[4], A3[4], A4[4], A5[4];
    LRU_LOAD(A0, 0); LRU_LOAD(A1, 1); LRU_LOAD(A2, 2); LRU_LOAD(A3, 3); LRU_LOAD(A4, 4); LRU_LOAD(A5, 5);
    LRU_MFMA(A0, 0); LRU_GATES(0);
    for (int q = 1; q < 271; q += 6) {
        LRU_STEP(A1, q, q > 16); LRU_STEP(A2, q + 1, q + 1 > 16); LRU_STEP(A3, q + 2, q + 2 > 16); LRU_STEP(A4, q + 3, q + 3 > 16); LRU_STEP(A5, q + 4, q + 4 > 16); LRU_STEP(A0, q + 5, q + 5 > 16); }
    LRU_STEP(A1, 271, true);
    LRU_SCAN(true);
#undef LRU_ROW
#undef LRU_LOAD
#undef LRU_MFMA
#undef LRU_GATES
#undef LRU_SCAN
#undef LRU_STEP
}
__device__ __forceinline__ void ph_lru(const P& p, float* sm) {
    const bf16* UC = (const bf16*)(p.ws + OFF_UC); const bf16* WTG = (const bf16*)(p.ws + OFF_WT_GATES);
    int tid_ = threadIdx.x; asm volatile("" : "+v"(tid_));
    const int lane = tid_ & 63, fr = lane & 15, fq = lane >> 4, wave = __builtin_amdgcn_readfirstlane(tid_ >> 6);
    if (wave < 4) {
        for (int task = blockIdx.x * 4 + wave; task < 1024; task += gridDim.x * 4) {
            const int cb = task & 7, d = (task >> 3) & 1, h = (task >> 4) & 7, b = task >> 7;
            const int ch = h * 128 + cb * 16 + fr;
            const float ba_ = p.in[I_ODBA][d * 1024 + ch], bx_ = p.in[I_ODBX][d * 1024 + ch];
            const float c8l2 = -8.f * log1pf(expf(-p.in[I_ODLAM][d * 1024 + ch])) * 1.4426950408889634f;
            abf16x8 wa[4], wx[4];
            const bf16* wpa = WTG + ((size_t)((0 * 2 + d) * 8 + h) * 128 + cb * 16 + fr) * 128 + 8 * fq;
            const bf16* wpx = WTG + ((size_t)((1 * 2 + d) * 8 + h) * 128 + cb * 16 + fr) * 128 + 8 * fq;
#pragma unroll
            for (int s = 0; s < 4; ++s) { wa[s] = *(const abf16x8*)(wpa + 32 * s); wx[s] = *(const abf16x8*)(wpx + 32 * s); }
            const int kl = (cb & 1) * 16 + fr; abf16x8 efs[4];
#pragma unroll
            for (int s = 0; s < 4; ++s)
#pragma unroll
                for (int j = 0; j < 8; ++j) efs[s][j] = (s == (cb >> 1) && (kl >> 3) == fq && (kl & 7) == j) ? (short)0x3F80 : (short)0;
            bf16* HX = (bf16*)(p.ws + (d ? OFF_HB : OFF_HF));
            char* wl = (char*)sm + wave * 768;
            if (d == 0) lru_walk<false>(UC, HX, b, h * 128, ch, wa, wx, efs, ba_, bx_, c8l2, fr, fq, wl);
            else lru_walk<true>(UC, HX, b, h * 128, ch, wa, wx, efs, ba_, bx_, c8l2, fr, fq, wl);
        }
    }
}
__device__ __forceinline__ void ph_lru_out(const P& p) {
    const int tix = otid();
    bf16* G = (bf16*)(p.ws + OFF_MIX); const bf16* __restrict__ HF = (const bf16*)(p.ws + OFF_HF); const bf16* __restrict__ HB = (const bf16*)(p.ws + OFF_HB);
    const int total = NL * 128, stride = gridDim.x * blockDim.x;
    for (int ib = blockIdx.x * blockDim.x + tix; ib < total; ib += 4 * stride) {
        uint4 gv[4], av[4], cv[4];
#pragma unroll
        for (int q = 0; q < 4; ++q) { const size_t off = (size_t)min(ib + q * stride, total - 1) * 8; gv[q] = *(const uint4*)(G + off); av[q] = *(const uint4*)(HF + off); cv[q] = *(const uint4*)(HB + off); }
#pragma unroll
        for (int q = 0; q < 4; ++q) {
            const int i = ib + q * stride;
            float g[8], a[8], c[8]; unpack8(gv[q], g); unpack8(av[q], a); unpack8(cv[q], c);
#pragma unroll
            for (int z = 0; z < 8; ++z) g[z] = gelu_tanh(g[z]) * (a[z] + c[z]);
            if (i < total) *(uint4*)(G + (size_t)i * 8) = pack8(g);
        }
    }
}

#define LAS __attribute__((address_space(3)))
#define XB_TMO      128
#define XB_XCNT(j)  (256  + 64 * (j))
#define XB_XSUB(j)  (1280 + 64 * (j))
#define XB_XGEN(j)  (2304 + 64 * (j))
#define XB_TOP      3328
#define XB_TOPGEN   3392
#define XCD_BAR_WORDS 3456
#define XB_SPIN_CAP (1u << 18)

__device__ __forceinline__ unsigned xb_ld(unsigned* p)              { return __hip_atomic_load(p, __ATOMIC_RELAXED, __HIP_MEMORY_SCOPE_AGENT); }
__device__ __forceinline__ unsigned xb_add(unsigned* p, unsigned v) { return __hip_atomic_fetch_add(p, v, __ATOMIC_RELAXED, __HIP_MEMORY_SCOPE_AGENT); }
__device__ __forceinline__ unsigned xb_xcc_id() { return (unsigned)__builtin_amdgcn_s_getreg((3 << 11) | 20) & 0xFu; }
#define XB_SPIN(cond, bar) do { unsigned _sp = 0; while (cond) { __builtin_amdgcn_s_sleep(1); \
    if ((++_sp & 255u) == 0u) { if (xb_ld(&(bar)[XB_TMO])) break; if (_sp > XB_SPIN_CAP) { atomicAdd(&(bar)[XB_TMO], 1u); break; } } } } while (0)

struct XcdBarrier {
    unsigned* bar; unsigned x;
    volatile LAS unsigned* st;
};

__device__ __forceinline__ XcdBarrier xcd_barrier_post(unsigned* bar, volatile LAS unsigned* st) {
    XcdBarrier b; b.bar = bar; b.x = xb_xcc_id(); b.st = st;
    if (threadIdx.x == 0) (void)xb_add(&bar[XB_XCNT(b.x)], 1u);
    return b;
}
__device__ __forceinline__ void xcd_barrier_complete(unsigned* bar, unsigned x, unsigned& nloc, unsigned& nx) {
    const unsigned G = gridDim.x * gridDim.y * gridDim.z;
    unsigned sum, cnt, mine, sp = 0u;
    for (;;) {
        sum = 0u; cnt = 0u; mine = 0u;
#pragma unroll
        for (unsigned j = 0; j < 16; ++j) { const unsigned c = xb_ld(&bar[XB_XCNT(j)]); sum += c; cnt += (c > 0u) ? 1u : 0u; mine = (j == x) ? c : mine; }
        if (sum == G) break;
        __builtin_amdgcn_s_sleep(1);
        if ((++sp & 255u) == 0u) { if (xb_ld(&bar[XB_TMO])) break; if (sp > XB_SPIN_CAP) { atomicAdd(&bar[XB_TMO], 1u); break; } }
    }
    nloc = mine > 0u ? mine : 1u; nx = cnt > 0u ? cnt : 1u;
}

__device__ __forceinline__ void xcd_barrier(const XcdBarrier& b) {
    asm volatile("s_waitcnt vmcnt(0)" ::: "memory");
    __syncthreads();
    if (threadIdx.x == 0) {
        unsigned* bar = b.bar;
        __builtin_amdgcn_s_waitcnt(0);
        unsigned nloc = b.st[0], nx = b.st[1];
        if (nloc == 0u) { xcd_barrier_complete(bar, b.x, nloc, nx); b.st[0] = nloc; b.st[1] = nx; }
        const unsigned old = xb_add(&bar[XB_XSUB(b.x)], 1u);
        const unsigned gen = old / nloc;
        if (old + 1u == (gen + 1u) * nloc) {
            __builtin_amdgcn_fence(__ATOMIC_RELEASE, "agent");
            asm volatile("s_waitcnt vmcnt(0)" ::: "memory");
            const unsigned og = xb_add(&bar[XB_TOP], 1u);
            const unsigned tg = og / nx;
            if (og + 1u == (tg + 1u) * nx) xb_add(&bar[XB_TOPGEN], 1u);
            else XB_SPIN(xb_ld(&bar[XB_TOPGEN]) == tg, bar);
            __builtin_amdgcn_fence(__ATOMIC_ACQUIRE, "agent");
            xb_add(&bar[XB_XGEN(b.x)], 1u);
            asm volatile("s_waitcnt vmcnt(0)" ::: "memory");
        } else {
            XB_SPIN(xb_ld(&bar[XB_XGEN(b.x)]) == gen, bar);
            __builtin_amdgcn_fence(__ATOMIC_ACQUIRE, "agent");
            asm volatile("s_waitcnt vmcnt(0)" ::: "memory");
        }
    }
    __syncthreads();
}

typedef float nf32x4 __attribute__((ext_vector_type(4)));
__device__ __forceinline__ void ph_normF(const P& p, const int l, const bool with_ctx, float* sm) {
    const float* modv = (const float*)(p.ws + OFF_MODV);
    const bf16* xres = (const bf16*)(p.ws + OFF_XRES);
    unsigned char* h8 = (unsigned char*)(p.ws + OFF_H);
    const float* rw = p.in[I_RW] + (size_t)l * 1024 * 16;
    const float* gvec = p.in[I_NFFN] + l * 1024;
    int tid_ = threadIdx.x; asm volatile("" : "+v"(tid_));
    const int tid = tid_, lane = tid & 63, fr = lane & 15, fq = lane >> 4, wave = __builtin_amdgcn_readfirstlane(tid >> 6);
    float* RWm = sm; float* biasv = sm + 18432; float* gm = sm + 18448; float* shv = sm + 19472;
    const int nitems = 256;
    for (int item = blockIdx.x; item < nitems; item += gridDim.x) {
        const bool isc = false;
        const int mr = isc ? 8 : (item >> 5);
        const float* mv = modv + (size_t)(l * 9 + mr) * 6144;
        __syncthreads();
        {
#pragma unroll
            for (int q = 0; q < 2; ++q) {
                const int k = 2 * tid + q; const float gmk = gvec[k] * (1.f + mv[4 * 1024 + k]);
                gm[k] = gmk; shv[k] = mv[3 * 1024 + k];
                const float4* w4 = (const float4*)(rw + (size_t)k * 16); float* dst = RWm + (k >> 3) * 144 + (k & 7) * 16;
#pragma unroll
                for (int c = 0; c < 4; ++c) { const float4 w = w4[c]; dst[4 * c] = gmk * w.x; dst[4 * c + 1] = gmk * w.y; dst[4 * c + 2] = gmk * w.z; dst[4 * c + 3] = gmk * w.w; }
            }
            float b0 = 0.f, b1 = 0.f;
            for (int k = lane; k < 1024; k += 64) { const float s = mv[3 * 1024 + k]; b0 += s * rw[(size_t)k * 16 + 2 * wave]; b1 += s * rw[(size_t)k * 16 + 2 * wave + 1]; }
            b0 = wave_sum(b0); b1 = wave_sum(b1);
            if (lane == 0) { biasv[2 * wave] = b0; biasv[2 * wave + 1] = b1; }
        }
        __syncthreads();
        const int tile = isc ? (item - 256) * 8 + wave : item * 8 + wave;
        const int row0 = isc ? NL + tile * 16 : tile * 16;
        const uint4* xq = (const uint4*)(xres + (size_t)(row0 + fr) * D + 8 * fq);
        const float* bq = RWm + fq * 144 + fr;
        nf32x4 acc0 = {0.f, 0.f, 0.f, 0.f}, acc1 = {0.f, 0.f, 0.f, 0.f}; float ss = 0.f;
#pragma unroll 1
        for (int s0 = 0; s0 < 32; s0 += 8) {
            uint4 xw[8];
#pragma unroll
            for (int u = 0; u < 8; ++u) xw[u] = xq[4 * (s0 + u)];
#pragma unroll
            for (int u = 0; u < 8; ++u) {
                float xf[8]; unpack8(xw[u], xf);
                const float* bb = bq + (s0 + u) * 576;
#pragma unroll
                for (int i = 0; i < 8; i += 2) {
                    ss += xf[i] * xf[i] + xf[i + 1] * xf[i + 1];
                    acc0 = __builtin_amdgcn_mfma_f32_16x16x4f32(xf[i], bb[i * 16], acc0, 0, 0, 0);
                    acc1 = __builtin_amdgcn_mfma_f32_16x16x4f32(xf[i + 1], bb[(i + 1) * 16], acc1, 0, 0, 0);
                }
            }
        }
        ss += __shfl_xor(ss, 16); ss += __shfl_xor(ss, 32);
        const float rstd = 1.f / sqrtf(ss * (1.f / D) + EPS);
        const float be = biasv[fr];
#pragma unroll
        for (int reg = 0; reg < 4; ++reg) {
            const float rs = __shfl(rstd, 4 * fq + reg);
            const float lg = (acc0[reg] + acc1[reg]) * rs + be;
            float mx = lg;
#pragma unroll
            for (int o = 1; o < 16; o <<= 1) mx = fmaxf(mx, __shfl_xor(mx, o));
            const float ex = expf(lg - mx); float den = ex;
#pragma unroll
            for (int o = 1; o < 16; o <<= 1) den += __shfl_xor(den, o);
            const float a = ex / den; const int rr = row0 + 4 * fq + reg;
            if (!isc) { const int b = rr >> 12, t = rr & 4095; ((float*)(p.ws + OFF_AFFL))[(size_t)(b * 16 + fr) * SEQ + t] = a; }
            else { const int rc = rr - NL, b = rc >> 8, t = rc & 255; ((float*)(p.ws + OFF_AFFC))[(size_t)(b * 16 + fr) * CTXL + t] = a; }
        }
#pragma unroll 2
        for (int r = 0; r < 16; ++r) {
            const float rs = __shfl(rstd, r);
            const uint2* xr = (const uint2*)(xres + (size_t)(row0 + r) * D);
#pragma unroll
            for (int j = 0; j < 4; ++j) {
                const uint2 xw = xr[lane + 64 * j]; float4 xv; xv.x = bf2f(xw.x & 0xffffu); xv.y = bf2f(xw.x >> 16); xv.z = bf2f(xw.y & 0xffffu); xv.w = bf2f(xw.y >> 16);
                const float4 g = ((const float4*)gm)[lane + 64 * j], sh = ((const float4*)shv)[lane + 64 * j];
                *(unsigned*)(h8 + (size_t)(row0 + r) * D + (lane + 64 * j) * 4) = pg8::pack_fp8x4(xv.x * rs * g.x + sh.x, xv.y * rs * g.y + sh.y, xv.z * rs * g.z + sh.z, xv.w * rs * g.w + sh.w);
            }
        }
    }
}

__device__ __forceinline__ void ph_normF_ctx(const P& p, const int l) {
    const int tix = otid();
    const float* mv = (const float*)(p.ws + OFF_MODV) + (size_t)(l * 9 + 8) * 6144;
    const bf16* xres = (const bf16*)(p.ws + OFF_XRES); unsigned char* h8 = (unsigned char*)(p.ws + OFF_H);
    const float* rw = p.in[I_RW] + (size_t)l * 1024 * 16; const float* gvec = p.in[I_NFFN] + l * 1024;
    const int lane = tix & 63, wave = tix >> 6;
    for (int rc = blockIdx.x * 8 + wave; rc < NC; rc += gridDim.x * 8) {
        const int r = NL + rc;
        const uint2* xr = (const uint2*)(xres + (size_t)r * D);
        float xv[16]; float ss = 0.f;
#pragma unroll
        for (int j = 0; j < 4; ++j) { const uint2 w = xr[lane + 64 * j]; xv[4 * j] = bf2f(w.x & 0xffffu); xv[4 * j + 1] = bf2f(w.x >> 16); xv[4 * j + 2] = bf2f(w.y & 0xffffu); xv[4 * j + 3] = bf2f(w.y >> 16);
            ss += xv[4 * j] * xv[4 * j] + xv[4 * j + 1] * xv[4 * j + 1] + xv[4 * j + 2] * xv[4 * j + 2] + xv[4 * j + 3] * xv[4 * j + 3]; }
        ss = wave_sum(ss);
        const float rstd = 1.f / sqrtf(ss * (1.f / D) + EPS);
        float part[16];
#pragma unroll
        for (int e = 0; e < 16; ++e) part[e] = 0.f;
#pragma unroll
        for (int j = 0; j < 4; ++j) {
            const float4 g = ((const float4*)gvec)[lane + 64 * j], sc = ((const float4*)(mv + 4 * 1024))[lane + 64 * j], sh = ((const float4*)(mv + 3 * 1024))[lane + 64 * j];
            float hh[4];
            hh[0] = xv[4 * j] * rstd * g.x * (1.f + sc.x) + sh.x; hh[1] = xv[4 * j + 1] * rstd * g.y * (1.f + sc.y) + sh.y;
            hh[2] = xv[4 * j + 2] * rstd * g.z * (1.f + sc.z) + sh.z; hh[3] = xv[4 * j + 3] * rstd * g.w * (1.f + sc.w) + sh.w;
            *(unsigned*)(h8 + (size_t)r * D + (lane + 64 * j) * 4) = pg8::pack_fp8x4(hh[0], hh[1], hh[2], hh[3]);
#pragma unroll
            for (int i = 0; i < 4; ++i) {
                const float4* w4 = (const float4*)(rw + (size_t)((lane + 64 * j) * 4 + i) * 16);
#pragma unroll
                for (int q = 0; q < 4; ++q) { const float4 w = w4[q]; part[q * 4 + 0] += hh[i] * w.x; part[q * 4 + 1] += hh[i] * w.y; part[q * 4 + 2] += hh[i] * w.z; part[q * 4 + 3] += hh[i] * w.w; }
            }
        }
        float mx = -1e30f;
#pragma unroll
        for (int e = 0; e < 16; ++e) { part[e] = wave_sum(part[e]); mx = fmaxf(mx, part[e]); }
        float den = 0.f, mine = 0.f;
#pragma unroll
        for (int e = 0; e < 16; ++e) { const float ex = expf(part[e] - mx); den += ex; if (lane == e) mine = ex; }
        if (lane < 16) { const int b = rc >> 8, t = rc & 255; ((float*)(p.ws + OFF_AFFC))[(size_t)(b * 16 + lane) * CTXL + t] = mine / den; }
    }
}

__device__ __forceinline__ void ph_norm0(const P& p) {
    const int tix = otid();
    const float* modv = (const float*)(p.ws + OFF_MODV); bf16* hout = (bf16*)(p.ws + OFF_H);
    const float4* g4 = (const float4*)p.in[I_NMIX];
    const int lane = tix & 63, wave = tix >> 6, stride = gridDim.x * 8;
    for (int rb = blockIdx.x * 8 + wave; rb < NT; rb += 4 * stride) {
        float4 v[4][4]; float ss[4];
#pragma unroll
        for (int q = 0; q < 4; ++q) { const int r = min(rb + q * stride, NT - 1); const float4* xr = (const float4*)in_row(p, r);
#pragma unroll
            for (int j = 0; j < 4; ++j) v[q][j] = xr[lane + 64 * j]; }
#pragma unroll
        for (int q = 0; q < 4; ++q) { float s = 0.f;
#pragma unroll
            for (int j = 0; j < 4; ++j) s += v[q][j].x * v[q][j].x + v[q][j].y * v[q][j].y + v[q][j].z * v[q][j].z + v[q][j].w * v[q][j].w;
            ss[q] = s; }
#pragma unroll
        for (int o = 1; o < 64; o <<= 1) {
#pragma unroll
            for (int q = 0; q < 4; ++q) ss[q] += __shfl_xor(ss[q], o); }
#pragma unroll
        for (int q = 0; q < 4; ++q) {
            const int r = rb + q * stride;
            if (r < NT) {
                const float rstd = 1.f / sqrtf(ss[q] * (1.f / D) + EPS);
                const float* mv = modv + (size_t)mod_row(r) * 6144;
#pragma unroll
                for (int j = 0; j < 4; ++j) {
                    const float4 g = g4[lane + 64 * j], sh = ((const float4*)mv)[lane + 64 * j], sc = ((const float4*)(mv + 1024))[lane + 64 * j];
                    uint2 o; o.x = pk2(v[q][j].x * rstd * g.x * (1.f + sc.x) + sh.x, v[q][j].y * rstd * g.y * (1.f + sc.y) + sh.y);
                    o.y = pk2(v[q][j].z * rstd * g.z * (1.f + sc.z) + sh.z, v[q][j].w * rstd * g.w * (1.f + sc.w) + sh.w);
                    *(uint2*)(hout + (size_t)r * D + (lane + 64 * j) * 4) = o;
                }
            }
        }
    }
}

#define LDSP ((__attribute__((address_space(3))) unsigned char*)lds)
__device__ __forceinline__ pg8::Sched mk_sched(int ng, int M, int N) { pg8::Sched S{}; S.ng = ng; S.nM = M / 256; S.nN = N / 256; S.nwg = ng * S.nM * S.nN; S.G = gridDim.x; S.c = blockIdx.x; return S; }
__device__ __forceinline__ void tail_convert(const P& p, const pg8::Sched& S, unsigned char* lds, const int it0, const int it1) {
    const int R = (S.nwg + S.G - 1) / S.G, T = S.nwg - (R - 1) * S.G;
    if (S.c >= T) ph_convert_moe_range(p, 1, (float*)lds, it0, it1, (S.c - T) * 8, (S.G - T) * 8);
}
constexpr int CVT_Q1 = 1344, CVT_Q2 = CVT_Q1 + 7168, CVT_Q3 = CVT_Q2 + 640, CVT_Q4 = CVT_Q3 + 1536, CVT_Q5 = CVT_Q4 + 4608;
__device__ __forceinline__ void fg_inproj_even(const P& p, unsigned char* lds) {
    pg8::Sched S = mk_sched(1, NT, EVIN);
    S.Abase = p.ws + OFF_H; S.a_tstride = (size_t)256 * D * 2; S.Bbase = p.ws + OFF_WT_EVIN; S.b_tstride = (size_t)256 * D * 2;
    pg8::EpiStoreBf16 E{(bf16*)(p.ws + OFF_PROJ), EVIN, 0, 1.f};
    pg8::gemm_phase<pg8::EpiStoreBf16, false>(LDSP, D * 2, S, E);
    tail_convert(p, S, lds, 0, CVT_Q1);
}
__device__ __forceinline__ void fg_outproj(const P& p, int l, bool first, size_t off_wt, int M, unsigned char* lds) {
    pg8::Sched S = mk_sched(1, M, D);
    S.Abase = p.ws + OFF_MIX; S.a_tstride = (size_t)256 * D * 2; S.Bbase = p.ws + off_wt; S.b_tstride = (size_t)256 * D * 2;
    pg8::EpiResid E{p.in[I_X], p.in[I_CTX], (bf16*)(p.ws + OFF_XRES), (const float*)(p.ws + OFF_MODV) + (size_t)l * 9 * 6144, first};
    pg8::gemm_phase<pg8::EpiResid, false>(LDSP, D * 2, S, E);
    if (l == 0) tail_convert(p, S, lds, CVT_Q1, CVT_Q2);
}
__device__ __forceinline__ void fg_inproj_odd(const P& p, unsigned char* lds) {
    pg8::Sched S = mk_sched(1, NT, 2048);
    S.Abase = p.ws + OFF_H1; S.a_tstride = (size_t)256 * D * 2; S.Bbase = p.ws + OFF_WT_ODIN; S.b_tstride = (size_t)256 * D * 2;
    pg8::EpiSplitBf16 E{(bf16*)(p.ws + OFF_MIX), (bf16*)(p.ws + OFF_H)};
    pg8::gemm_phase<pg8::EpiSplitBf16, false>(LDSP, D * 2, S, E);
    tail_convert(p, S, lds, CVT_Q4, CVT_Q5);
}
__device__ __forceinline__ void fg_moe_up(const P& p, int l, int Me, unsigned char* lds) {
    pg8::Sched S = mk_sched(NE, Me, 2816);
    S.Abase = p.ws + OFF_H; S.rowidx = (const int*)(p.ws + OFF_ROWL); S.idx_gstride = ME;
    S.Bbase = p.ws + (l ? OFF_WGU1 : OFF_WGU); S.b_gstride = WGU_E; S.b_tstride = (size_t)256 * D;
    pg8::EpiSwiGLU8 E{(unsigned char*)(p.ws + OFF_HID)};
    pg8::gemm_phase<pg8::EpiSwiGLU8, true, true>(LDSP, D, S, E);
    if (l == 0) tail_convert(p, S, lds, CVT_Q2, CVT_Q3);
}
__device__ __forceinline__ void fg_moe_down(const P& p, int l, int Me, unsigned char* lds) {
    pg8::Sched S = mk_sched(NE, Me, D);
    S.Abase = p.ws + OFF_HID; S.a_gstride = (size_t)ME * pg8::FFP; S.a_tstride = (size_t)256 * pg8::FFP;
    S.Bbase = p.ws + (l ? OFF_WDN1 : OFF_WDN); S.b_gstride = WDN_E; S.b_tstride = (size_t)256 * pg8::FFP;
    pg8::EpiStoreFp8 E{(unsigned char*)(p.ws + OFF_Y), D, (size_t)ME * D, Y8_SCALE / (pg8::W8_SCALE * pg8::HID8_SCALE)};
    pg8::gemm_phase<pg8::EpiStoreFp8, false, true>(LDSP, pg8::FFP, S, E);
    if (l == 0) tail_convert(p, S, lds, CVT_Q3, CVT_Q4);
}

constexpr int LDS_BYTES = 131072 + 4096;
constexpr size_t OFF_BAR = 640 * MiB;
__global__ void __launch_bounds__(512) k_all(P p) {
    cooperative_groups::grid_group grid = cooperative_groups::this_grid();
    extern __shared__ __attribute__((aligned(16))) unsigned char lds[];
    float* sm = (float*)lds;
    volatile LAS unsigned* st = (volatile LAS unsigned*)((LAS unsigned char*)lds + 131072 + 64);
    if (threadIdx.x < 4) st[threadIdx.x] = 0u;
    __syncthreads();
    XcdBarrier bar = xcd_barrier_post((unsigned*)(p.ws + OFF_BAR), st);
#define GSYNC() xcd_barrier(bar)
    ph_mod(p, sm); __syncthreads(); ph_convert_other(p, sm); ph_convert_gates(p, sm); ph_convert_moe(p, 0, sm); GSYNC();
    if (gridDim.x == 0x7fffffffu) grid.sync();
    ph_norm0(p); GSYNC();
    fg_inproj_even(p, lds); GSYNC();
    ph_prep_attn(p, sm); ph_conv3v(p); GSYNC();
    ph_attn_mfma(p, lds); GSYNC();
    fg_outproj(p, 0, true, OFF_WT_EVOUT, NT, lds); GSYNC();
    ph_normF(p, 0, true, sm); ph_normF_ctx(p, 0); GSYNC();
    ph_topk(p, true, sm); GSYNC();
    fg_moe_up(p, 0, ME, lds); GSYNC();
    fg_moe_down(p, 0, ME, lds); GSYNC();
    ph_combine(p, 0, false, NT); GSYNC();
    fg_inproj_odd(p, lds); GSYNC();
    ph_conv4v(p); GSYNC();
    ph_lru(p, sm); GSYNC();
    ph_lru_out(p); GSYNC();
    fg_outproj(p, 1, false, OFF_WT_ODOUT, NL, lds); GSYNC();
    ph_normF(p, 1, false, sm); GSYNC();
    ph_topk(p, false, sm); __syncthreads(); ph_convert_moe(p, 1, sm, CVT_Q5); GSYNC();
    fg_moe_up(p, 1, NB * CAPL, lds); GSYNC();
    fg_moe_down(p, 1, NB * CAPL, lds); GSYNC();
    ph_combine(p, 1, true, NL);
}
}

extern "C" void kernel_launch(void* const* d_in, const int* in_sizes, int n_in, void* d_out, int out_size, void* d_ws, size_t ws_size, hipStream_t stream) {
    if (n_in != N_IN || ws_size < 644 * MiB) { fprintf(stderr, "kernel_launch: unexpected n_in %d or ws_size %zu\n", n_in, ws_size); return; }
    static int grid_blocks = 0;
    if (!grid_blocks) {
        int dev = 0, cus = 0, per_cu = 0;
        (void)hipGetDevice(&dev);
        (void)hipDeviceGetAttribute(&cus, hipDeviceAttributeMultiprocessorCount, dev);
        (void)hipFuncSetAttribute((const void*)k_all, hipFuncAttributeMaxDynamicSharedMemorySize, LDS_BYTES);
        (void)hipOccupancyMaxActiveBlocksPerMultiprocessor(&per_cu, k_all, 512, LDS_BYTES);
        if (per_cu < 1) per_cu = 1;
        grid_blocks = cus * per_cu;
        fprintf(stderr, "kernel_launch: cus %d per_cu %d grid %d ws %zu\n", cus, per_cu, grid_blocks, ws_size);
    }
    P p{};
    for (int i = 0; i < N_IN; ++i) p.in[i] = (const float*)d_in[i];
    p.out = (float*)d_out; p.ws = (char*)d_ws;
    (void)hipMemsetAsync((char*)d_ws + OFF_BAR, 0, 16384, stream);
    void* args[] = {&p};
    hipError_t e = hipLaunchCooperativeKernel((void*)k_all, dim3(grid_blocks), dim3(512), args, LDS_BYTES, stream);
    if (e != hipSuccess) fprintf(stderr, "cooperative launch failed: %s (grid %d)\n", hipGetErrorString(e), grid_blocks);
}
```

```cpp
#include <hip/hip_runtime.h>
#include <hip/hip_cooperative_groups.h>
#include <cstdio>
#include <cstdint>

namespace {
typedef unsigned short bf16;
constexpr int D = 1024, NB = 8, SEQ = 4096, CTXL = 256;
constexpr int NL = NB * SEQ, NC = NB * CTXL, NT = NL + NC;
constexpr int NE = 16, FF = 1408, CAPL = 512, CAPC = 32;
constexpr int ME = NB * CAPL + NB * CAPC;
constexpr int EVIN = 2304;
constexpr float EPS = 1e-6f;
constexpr float Y8_SCALE = 16.f;

enum { I_X = 0, I_C, I_CTX, I_CCTX, I_ADAW, I_ADAB, I_NMIX, I_NFFN, I_EVWIN, I_EVWOUT, I_EVSINK, I_EVCW, I_EVCB,
       I_ODWIN, I_ODWOUT, I_ODCW, I_ODCB, I_ODWA, I_ODBA, I_ODWX, I_ODBX, I_ODLAM, I_RW, I_WG, I_WU, I_WD, I_FG, N_IN };

constexpr size_t MiB = 1u << 20;
constexpr size_t OFF_MODV = 0;
constexpr size_t OFF_ROPE = 512 * 1024;
constexpr size_t OFF_AFFL = 1 * MiB;
constexpr size_t OFF_AFFC = 3 * MiB;
constexpr size_t OFF_ROWL = 4 * MiB;
constexpr size_t OFF_GATEV = 5 * MiB;
constexpr size_t OFF_SLOT = 6 * MiB;
constexpr size_t OFF_VTL = 8 * MiB + 512 * 1024;
constexpr size_t OFF_KFL = 624 * MiB;
constexpr size_t OFF_KFC = 632 * MiB;
constexpr size_t OFF_WT_GATES = 30 * MiB;
constexpr size_t OFF_VTC = 31 * MiB;
constexpr size_t OFF_XRES = 32 * MiB;
constexpr size_t OFF_H = 168 * MiB;
constexpr size_t OFF_MIX = 236 * MiB;
constexpr size_t OFF_XE = OFF_MIX;
constexpr size_t OFF_Y = OFF_H;
constexpr size_t OFF_PROJ = 304 * MiB;
constexpr size_t OFF_HID = OFF_PROJ;
constexpr size_t OFF_H1 = OFF_PROJ;
constexpr size_t OFF_UC = OFF_PROJ;
constexpr size_t OFF_HF = 372 * MiB;
constexpr size_t OFF_HB = 168 * MiB;
constexpr size_t OFF_Z = 372 * MiB;

struct P { const float* in[N_IN]; float* out; char* ws; };

__device__ __forceinline__ float bf2f(unsigned v) { return __uint_as_float(v << 16); }
__device__ __forceinline__ unsigned f2bf(float f) { unsigned u = __float_as_uint(f); return (u + 0x7fffu + ((u >> 16) & 1u)) >> 16; }
__device__ __forceinline__ unsigned pk2(float lo, float hi) { unsigned r; asm("v_cvt_pk_bf16_f32 %0, %1, %2" : "=v"(r) : "v"(lo), "v"(hi)); return r; }
__device__ __forceinline__ float wave_sum(float v) {
#pragma unroll
    for (int o = 1; o < 64; o <<= 1) v += __shfl_xor(v, o);
    return v;
}
__device__ __forceinline__ float wave_max(float v) {
#pragma unroll
    for (int o = 1; o < 64; o <<= 1) v = fmaxf(v, __shfl_xor(v, o));
    return v;
}
__device__ __forceinline__ int otid() { int t = threadIdx.x; asm volatile("" : "+v"(t)); return t; }
__device__ __forceinline__ int mod_row(int r) { return r < NL ? (r >> 12) : 8; }
__device__ __forceinline__ const float* in_row(const P& p, int r) { return r < NL ? p.in[I_X] + (size_t)r * D : p.in[I_CTX] + (size_t)(r - NL) * D; }

__device__ __forceinline__ void ph_mod(const P& p, float* sm) {
    const int tix = otid();
    float* modv = (float*)(p.ws + OFF_MODV);
    float* red = sm + 9216;
    if (blockIdx.x < 192) {
        for (int i = tix; i < 9 * 1024; i += blockDim.x) {
            int r = i >> 10, k = i & 1023; float v = (r < 8) ? p.in[I_C][r * 1024 + k] : p.in[I_CCTX][k];
            sm[i] = v / (1.f + expf(-v));
        }
        __syncthreads();
    }
    for (int item = blockIdx.x; item < 192; item += gridDim.x) {
        const int l = item / 96, j0 = (item % 96) * 64, kc = tix >> 6, col = tix & 63;
        const float* w = p.in[I_ADAW] + (size_t)l * 1024 * 6144 + (size_t)(kc * 128) * 6144 + j0 + col;
        const float* sv = sm + kc * 128;
        float acc[9];
#pragma unroll
        for (int r = 0; r < 9; ++r) acc[r] = 0.f;
#pragma unroll 16
        for (int k = 0; k < 128; ++k) {
            const float wv = w[(size_t)k * 6144];
#pragma unroll
            for (int r = 0; r < 9; ++r) acc[r] += sv[r * 1024 + k] * wv;
        }
#pragma unroll
        for (int r = 0; r < 9; ++r) red[(r * 8 + kc) * 64 + col] = acc[r];
        __syncthreads();
        for (int i = tix; i < 576; i += blockDim.x) {
            const int r = i >> 6, c = i & 63; float s = 0.f;
#pragma unroll
            for (int q = 0; q < 8; ++q) s += red[(r * 8 + q) * 64 + c];
            modv[(l * 9 + r) * 6144 + j0 + c] = s + p.in[I_ADAB][l * 6144 + j0 + c];
        }
        __syncthreads();
    }
    if (blockIdx.x == gridDim.x - 1) {
        float* tab = (float*)(p.ws + OFF_ROPE);
        for (int i = tix; i < 1024; i += blockDim.x) {
            const int pos = i >> 4, f = i & 15;
            const float inv = powf(10000.f, -(float)f / 16.f);
            const float ang = (float)pos * inv;
            tab[i * 2] = cosf(ang); tab[i * 2 + 1] = sinf(ang);
        }
    }
}


__device__ __forceinline__ void ph_topk(const P& p, bool with_ctx, float* sm) {
    const int tix = otid();
    int* rowl = (int*)(p.ws + OFF_ROWL); float* gatev = (float*)(p.ws + OFF_GATEV); int* slot = (int*)(p.ws + OFF_SLOT);
    int* hist = (int*)sm; int* misc = hist + 256; int* wtot = hist + 272;
    const int lane = tix & 63, wave = tix >> 6;
    const int nitems = with_ctx ? 256 : 128;
    for (int it = blockIdx.x; it < nitems; it += gridDim.x) {
        const bool isc = it >= 128; const int be = it & 127, b = be >> 4, e = be & 15;
        const int n = isc ? CTXL : SEQ, cap = isc ? CAPC : CAPL;
        const float* aff = isc ? (const float*)(p.ws + OFF_AFFC) + (size_t)be * CTXL : (const float*)(p.ws + OFF_AFFL) + (size_t)be * SEQ;
        const bool have = tix * 8 < n;
        unsigned u[8];
        { float4 a = make_float4(0.f, 0.f, 0.f, 0.f), c = a; if (have) { a = *(const float4*)(aff + tix * 8); c = *(const float4*)(aff + tix * 8 + 4); }
          u[0] = __float_as_uint(a.x); u[1] = __float_as_uint(a.y); u[2] = __float_as_uint(a.z); u[3] = __float_as_uint(a.w);
          u[4] = __float_as_uint(c.x); u[5] = __float_as_uint(c.y); u[6] = __float_as_uint(c.z); u[7] = __float_as_uint(c.w); }
        unsigned prefix = 0u, pmask = 0u; int kk = cap;
#pragma unroll 1
        for (int shift = 24; shift >= 0; shift -= 8) {
            __syncthreads();
            if (tix < 256) hist[tix] = 0;
            __syncthreads();
            if (have) {
#pragma unroll
                for (int j = 0; j < 8; ++j) if ((u[j] & pmask) == prefix) atomicAdd(&hist[(u[j] >> shift) & 255u], 1);
            }
            __syncthreads();
            if (wave == 0) {
                const int h0 = hist[4 * lane], h1 = hist[4 * lane + 1], h2 = hist[4 * lane + 2], h3 = hist[4 * lane + 3];
                int tot = h0 + h1 + h2 + h3, suf = tot;
#pragma unroll
                for (int o = 1; o < 64; o <<= 1) { const int t = __shfl_down(suf, o); if (lane + o < 64) suf += t; }
                const int above = suf - tot;
                const int a3 = above, a2 = above + h3, a1 = a2 + h2, a0 = a1 + h1;
                int dsel = -1, kn = 0;
                if (a3 < kk && kk <= a3 + h3) { dsel = 4 * lane + 3; kn = kk - a3; }
                else if (a2 < kk && kk <= a2 + h2) { dsel = 4 * lane + 2; kn = kk - a2; }
                else if (a1 < kk && kk <= a1 + h1) { dsel = 4 * lane + 1; kn = kk - a1; }
                else if (a0 < kk && kk <= a0 + h0) { dsel = 4 * lane; kn = kk - a0; }
                if (dsel >= 0) { misc[0] = dsel; misc[1] = kn; }
            }
            __syncthreads();
            prefix |= (unsigned)misc[0] << shift; pmask |= 255u << shift; kk = misc[1];
        }
        int cg = 0, ce = 0;
        if (have) {
#pragma unroll
            for (int j = 0; j < 8; ++j) { cg += u[j] > prefix ? 1 : 0; ce += u[j] == prefix ? 1 : 0; }
        }
        int packed = cg | (ce << 16), inc = packed;
#pragma unroll
        for (int o = 1; o < 64; o <<= 1) { const int t = __shfl_up(inc, o); if (lane >= o) inc += t; }
        if (lane == 63) wtot[wave] = inc;
        __syncthreads();
        int before = inc - packed;
#pragma unroll
        for (int w = 0; w < 8; ++w) if (w < wave) before += wtot[w];
        int gb = before & 0xffff, eb = before >> 16;
        const int base = isc ? (NB * CAPL + b * CAPC) : b * CAPL;
        const int rowbase = isc ? (NL + b * CTXL) : b * SEQ;
        if (have) {
#pragma unroll
            for (int j = 0; j < 8; ++j) {
                const bool g = u[j] > prefix, q = u[j] == prefix, sel = g || (q && eb < kk);
                const int row = rowbase + tix * 8 + j;
                if (sel) { const int pos = base + gb + min(eb, kk); rowl[e * ME + pos] = row; gatev[e * ME + pos] = __uint_as_float(u[j]); slot[(size_t)e * NT + row] = pos; }
                else slot[(size_t)e * NT + row] = -1;
                gb += g ? 1 : 0; eb += q ? 1 : 0;
            }
        }
    }
}
__device__ __forceinline__ void ph_combine(const P& p, int l, bool last, int nrows) {
    const int tix = otid();
    const float* modv = (const float*)(p.ws + OFF_MODV); bf16* xres = (bf16*)(p.ws + OFF_XRES);
    const unsigned char* Y = (const unsigned char*)(p.ws + OFF_Y); const float* gatev = (const float*)(p.ws + OFF_GATEV); const int* slot = (const int*)(p.ws + OFF_SLOT);
    bf16* H1 = (bf16*)(p.ws + OFF_H1);
    const int lane = tix & 63, wave = tix >> 6;
    for (int r = blockIdx.x * 8 + wave; r < nrows; r += gridDim.x * 8) {
        float4 acc[4];
#pragma unroll
        for (int j = 0; j < 4; ++j) acc[j] = make_float4(0.f, 0.f, 0.f, 0.f);
        const int s_l = lane < NE ? slot[(size_t)lane * NT + r] : -1;
        const float g_l = s_l >= 0 ? gatev[lane * ME + s_l] : 0.f;
        unsigned mask = (unsigned)(__ballot(s_l >= 0) & 0xFFFFull);
        while (mask) {
            unsigned yv[4][4]; float gq[4];
#pragma unroll
            for (int q = 0; q < 4; ++q) {
                int e = 0, s = 0; float g = 0.f;
                if (mask) { e = __builtin_ctz(mask); mask &= mask - 1; s = __builtin_amdgcn_readlane(s_l, e); g = __uint_as_float(__builtin_amdgcn_readlane(__float_as_uint(g_l), e)); }
                gq[q] = g * (1.f / Y8_SCALE);
                const unsigned* yr = (const unsigned*)(Y + ((size_t)e * ME + s) * D);
#pragma unroll
                for (int j = 0; j < 4; ++j) yv[q][j] = yr[lane + 64 * j];
            }
#pragma unroll
            for (int q = 0; q < 4; ++q)
#pragma unroll
                for (int j = 0; j < 4; ++j) { const unsigned w = yv[q][j]; const float g = gq[q];
                    typedef float v2f_ __attribute__((ext_vector_type(2)));
                    const v2f_ lo = __builtin_amdgcn_cvt_pk_f32_fp8((int)w, false), hi2 = __builtin_amdgcn_cvt_pk_f32_fp8((int)w, true);
                    acc[j].x += g * lo[0]; acc[j].y += g * lo[1]; acc[j].z += g * hi2[0]; acc[j].w += g * hi2[1]; }
        }
        const float* mv = modv + (size_t)(l * 9 + mod_row(r)) * 6144;
        uint2* xr = (uint2*)(xres + (size_t)r * D);
        float4 v[4]; float ss = 0.f;
#pragma unroll
        for (int j = 0; j < 4; ++j) {
            const uint2 xw = xr[lane + 64 * j]; float4 x; x.x = bf2f(xw.x & 0xffffu); x.y = bf2f(xw.x >> 16); x.z = bf2f(xw.y & 0xffffu); x.w = bf2f(xw.y >> 16);
            const float4 g5 = ((const float4*)(mv + 5 * 1024))[lane + 64 * j];
            v[j].x = x.x + g5.x * acc[j].x; v[j].y = x.y + g5.y * acc[j].y; v[j].z = x.z + g5.z * acc[j].z; v[j].w = x.w + g5.w * acc[j].w;
            ss += v[j].x * v[j].x + v[j].y * v[j].y + v[j].z * v[j].z + v[j].w * v[j].w;
        }
        ss = wave_sum(ss);
        const float rstd = 1.f / sqrtf(ss * (1.f / D) + EPS);
        if (last) {
            float4* o = (float4*)(p.out + (size_t)r * D); const float4* g4 = (const float4*)p.in[I_FG];
#pragma unroll
            for (int j = 0; j < 4; ++j) { const float4 g = g4[lane + 64 * j]; float4 w; w.x = v[j].x * rstd * g.x; w.y = v[j].y * rstd * g.y; w.z = v[j].z * rstd * g.z; w.w = v[j].w * rstd * g.w; o[lane + 64 * j] = w; }
        } else {
            const float* mv1 = modv + (size_t)((l + 1) * 9 + mod_row(r)) * 6144;
            const float4* g4 = (const float4*)(p.in[I_NMIX] + (l + 1) * 1024);
#pragma unroll
            for (int j = 0; j < 4; ++j) {
                { uint2 xo; xo.x = pk2(v[j].x, v[j].y); xo.y = pk2(v[j].z, v[j].w); xr[lane + 64 * j] = xo; }
                const float4 g = g4[lane + 64 * j], sh = ((const float4*)mv1)[lane + 64 * j], sc = ((const float4*)(mv1 + 1024))[lane + 64 * j];
                uint2 o; o.x = pk2(v[j].x * rstd * g.x * (1.f + sc.x) + sh.x, v[j].y * rstd * g.y * (1.f + sc.y) + sh.y);
                o.y = pk2(v[j].z * rstd * g.z * (1.f + sc.z) + sh.z, v[j].w * rstd * g.w * (1.f + sc.w) + sh.w);
                *(uint2*)(H1 + (size_t)r * D + (lane + 64 * j) * 4) = o;
            }
        }
    }
}
__device__ __forceinline__ float gelu_tanh(float x) {
    const float u = 0.7978845608028654f * (x + 0.044715f * x * x * x);
    return x * __builtin_amdgcn_rcpf(1.f + __builtin_amdgcn_exp2f(-2.f * 1.4426950408889634f * u)); }

__device__ __forceinline__ void unpack8(const uint4& v, float* f) {
    f[0] = bf2f(v.x & 0xffffu); f[1] = bf2f(v.x >> 16); f[2] = bf2f(v.y & 0xffffu); f[3] = bf2f(v.y >> 16);
    f[4] = bf2f(v.z & 0xffffu); f[5] = bf2f(v.z >> 16); f[6] = bf2f(v.w & 0xffffu); f[7] = bf2f(v.w >> 16);
}
__device__ __forceinline__ uint4 pack8(const float* f) { uint4 o; o.x = pk2(f[0], f[1]); o.y = pk2(f[2], f[3]); o.z = pk2(f[4], f[5]); o.w = pk2(f[6], f[7]); return o; }
__device__ __forceinline__ void ph_prep_attn(const P& p, float* sm) {
    const int tix = otid();
    bf16* PROJ = (bf16*)(p.ws + OFF_PROJ); const float* tab = (const float*)(p.ws + OFF_ROPE);
    bf16* KFL = (bf16*)(p.ws + OFF_KFL); bf16* KFC = (bf16*)(p.ws + OFF_KFC);
    const int total = NL * 40;
    for (int i = blockIdx.x * blockDim.x + tix; i < total; i += gridDim.x * blockDim.x) {
        const int r = i / 40, rem = i % 40, hh = rem >> 2, part = (rem >> 1) & 1, hf = rem & 1, t = r & 4095;
        const int pos = part == 0 ? (t >> 6) : (t & 63);
        bf16* base = PROJ + (size_t)r * EVIN + (hh < 8 ? hh * 64 : 512 + (hh - 8) * 64) + part * 32 + hf * 8;
        const uint4 a = *(const uint4*)base, bq = *(const uint4*)(base + 16);
        float x1[8], x2[8], o1[8], o2[8]; unpack8(a, x1); unpack8(bq, x2);
        const float4* cs = (const float4*)(tab + (size_t)(pos * 16 + hf * 8) * 2);
#pragma unroll
        for (int q = 0; q < 4; ++q) { const float4 w = cs[q];
            o1[2 * q] = x1[2 * q] * w.x - x2[2 * q] * w.y; o2[2 * q] = x2[2 * q] * w.x + x1[2 * q] * w.y;
            o1[2 * q + 1] = x1[2 * q + 1] * w.z - x2[2 * q + 1] * w.w; o2[2 * q + 1] = x2[2 * q + 1] * w.z + x1[2 * q + 1] * w.w; }
        if (hh < 8) { *(uint4*)base = pack8(o1); *(uint4*)(base + 16) = pack8(o2); }
        else {
            const int b = r >> 12, hk = hh - 8;
            bf16* kf = KFL + ((((size_t)(b * 2 + hk) * 128 + (t >> 5)) * 4 + 2 * part) * 64 + hf * 32 + (t & 31)) * 8;
            *(uint4*)kf = pack8(o1); *(uint4*)(kf + 512) = pack8(o2);
        }
    }
    for (int i = blockIdx.x * blockDim.x + tix; i < NC * 16; i += gridDim.x * blockDim.x) {
        const int rc = i >> 4, hk = (i >> 3) & 1, s = (i >> 1) & 3, hf = i & 1, b = rc >> 8, t = rc & 255;
        const uint4 v = *(const uint4*)(PROJ + (size_t)(NL + rc) * EVIN + 512 + hk * 64 + 16 * s + 8 * hf);
        *(uint4*)(KFC + ((((size_t)(b * 2 + hk) * 8 + (t >> 5)) * 4 + s) * 64 + hf * 32 + (t & 31)) * 8) = v;
    }
    bf16* tile = (bf16*)sm;
    for (int it = blockIdx.x; it < 1024 + 64; it += gridDim.x) {
        int b, hk, t0, rowbase; bf16* vf;
        if (it < 1024) { b = it >> 7; hk = (it >> 6) & 1; t0 = (it & 63) * 64; rowbase = b * SEQ; vf = (bf16*)(p.ws + OFF_VTL) + (size_t)(b * 2 + hk) * 128 * 2048; }
        else { const int j = it - 1024; b = j >> 3; hk = (j >> 2) & 1; t0 = (j & 3) * 64; rowbase = NL + b * CTXL; vf = (bf16*)(p.ws + OFF_VTC) + (size_t)(b * 2 + hk) * 8 * 2048; }
        __syncthreads();
        for (int i = tix; i < 4096; i += blockDim.x) { const int tok = i >> 6, d = i & 63; tile[tok * 65 + d] = PROJ[(size_t)(rowbase + t0 + tok) * EVIN + 640 + hk * 64 + d]; }
        __syncthreads();
        {
            const int frag = tix >> 6, ln = tix & 63, T = frag >> 2, dt = (frag >> 1) & 1, s = frag & 1, rr = ln & 31, hi = ln >> 5;
            unsigned w[4];
#pragma unroll
            for (int jj = 0; jj < 4; ++jj) {
                const int j0 = 2 * jj, j1 = 2 * jj + 1;
                const unsigned lo = tile[(32 * T + 16 * s + 8 * (j0 >> 2) + 4 * hi + (j0 & 3)) * 65 + 32 * dt + rr];
                const unsigned hi16 = tile[(32 * T + 16 * s + 8 * (j1 >> 2) + 4 * hi + (j1 & 3)) * 65 + 32 * dt + rr];
                w[jj] = lo | (hi16 << 16);
            }
            uint4 o; o.x = w[0]; o.y = w[1]; o.z = w[2]; o.w = w[3];
            *(uint4*)(vf + ((((size_t)((t0 >> 5) + T) * 2 + dt) * 2 + s) * 64 + ln) * 8) = o;
        }
    }
}
typedef short abf16x8 __attribute__((ext_vector_type(8)));
typedef short abf16x4 __attribute__((ext_vector_type(4)));
typedef float af32x16 __attribute__((ext_vector_type(16)));
__device__ __forceinline__ unsigned cvtpk(float lo, float hi) { unsigned r; asm volatile("v_cvt_pk_bf16_f32 %0, %1, %2" : "=v"(r) : "v"(lo), "v"(hi)); return r; }
struct AttnK { abf16x8 k[8]; };
struct AttnV { abf16x8 v[8]; };
__device__ __forceinline__ void attn_load_k(AttnK& f, const char* ub, const unsigned vo) {
#pragma unroll
    for (int s = 0; s < 4; ++s) { f.k[2 * s] = *(const abf16x8*)(ub + vo + s * 1024); f.k[2 * s + 1] = *(const abf16x8*)(ub + vo + (4 + s) * 1024); }
}
__device__ __forceinline__ void attn_load_v(AttnV& f, const char* ub, const unsigned vo) {
#pragma unroll
    for (int dt = 0; dt < 2; ++dt)
#pragma unroll
        for (int T = 0; T < 2; ++T)
#pragma unroll
            for (int s = 0; s < 2; ++s) f.v[(dt * 2 + T) * 2 + s] = *(const abf16x8*)(ub + vo + ((T * 2 + dt) * 2 + s) * 1024);
}
__device__ __forceinline__ void attn_tile(AttnK& f, AttnV& fv, const bool has_next, const char* nkp, const char* nvp, const unsigned vo, const abf16x8* ql, const bool partial, const int kq0  , const int kmax  ,
                                          const int hi, float& m, float& l, af32x16& o0, af32x16& o1) {
    const float CS = 0.125f * 1.4426950408889634f;
    const int kqh = kq0 + 4 * hi;
    af32x16 s0, s1;
#pragma unroll
    for (int i = 0; i < 16; ++i) { s0[i] = 0.f; s1[i] = 0.f; }
    abf16x8 qf[4];
#pragma unroll
    for (int s = 0; s < 4; ++s) qf[s] = ql[s * 64];
#pragma unroll
    for (int s = 0; s < 4; ++s) {
        s0 = __builtin_amdgcn_mfma_f32_32x32x16_bf16(f.k[2 * s], qf[s], s0, 0, 0, 0);
        s1 = __builtin_amdgcn_mfma_f32_32x32x16_bf16(f.k[2 * s + 1], qf[s], s1, 0, 0, 0);
    }
    if (has_next) attn_load_k(f, nkp, vo);
    float tmax = -1e30f;
    if (partial) {
        asm volatile("" ::: "memory");
#pragma unroll
        for (int i = 0; i < 16; ++i) {
            const int c = (i & 3) + 8 * (i >> 2);
            if (kqh > 128 - c || kqh < -128 - c) s0[i] = -1e30f;
            if (kqh > 96 - c || kqh < -160 - c) s1[i] = -1e30f;
        }
    }
#pragma unroll
    for (int i = 0; i < 16; ++i) asm("v_max3_f32 %0, %0, %1, %2" : "+v"(tmax) : "v"(s0[i]), "v"(s1[i]));
    tmax = fmaxf(tmax, __shfl_xor(tmax, 32));
    const float mn = fmaxf(m, tmax * CS), alpha = __builtin_amdgcn_exp2f(m - mn), nmn = -mn; m = mn;
    float sum = 0.f;
#pragma unroll
    for (int i = 0; i < 16; ++i) { s0[i] = __builtin_amdgcn_exp2f(__builtin_fmaf(s0[i], CS, nmn)); s1[i] = __builtin_amdgcn_exp2f(__builtin_fmaf(s1[i], CS, nmn)); sum += s0[i] + s1[i]; }
    l = l * alpha + sum;
    if (__builtin_amdgcn_ballot_w64(alpha != 1.f) != 0ull) {
#pragma unroll
        for (int i = 0; i < 16; ++i) { float t0 = o0[i] * alpha, t1 = o1[i] * alpha; asm("" : "+v"(t0), "+v"(t1)); o0[i] = t0; o1[i] = t1; }
    }
    typedef unsigned u32x4_ __attribute__((ext_vector_type(4)));
    abf16x8 pf[2][2];
#pragma unroll
    for (int s = 0; s < 2; ++s) {
        u32x4_ w0, w1;
        w0.x = cvtpk(s0[8 * s + 0], s0[8 * s + 1]); w0.y = cvtpk(s0[8 * s + 2], s0[8 * s + 3]); w0.z = cvtpk(s0[8 * s + 4], s0[8 * s + 5]); w0.w = cvtpk(s0[8 * s + 6], s0[8 * s + 7]);
        w1.x = cvtpk(s1[8 * s + 0], s1[8 * s + 1]); w1.y = cvtpk(s1[8 * s + 2], s1[8 * s + 3]); w1.z = cvtpk(s1[8 * s + 4], s1[8 * s + 5]); w1.w = cvtpk(s1[8 * s + 6], s1[8 * s + 7]);
        pf[0][s] = __builtin_bit_cast(abf16x8, w0); pf[1][s] = __builtin_bit_cast(abf16x8, w1);
    }
#pragma unroll
    for (int T = 0; T < 2; ++T)
#pragma unroll
        for (int s = 0; s < 2; ++s) {
            o0 = __builtin_amdgcn_mfma_f32_32x32x16_bf16(fv.v[(0 * 2 + T) * 2 + s], pf[T][s], o0, 0, 0, 0);
            o1 = __builtin_amdgcn_mfma_f32_32x32x16_bf16(fv.v[(1 * 2 + T) * 2 + s], pf[T][s], o1, 0, 0, 0);
        }
    if (has_next) attn_load_v(fv, nvp, vo);
}
__device__ __forceinline__ void ph_attn_mfma(const P& p, unsigned char* lds) {
    const bf16* PROJ = (const bf16*)(p.ws + OFF_PROJ); bf16* MIX = (bf16*)(p.ws + OFF_MIX);
    const bf16* VTL = (const bf16*)(p.ws + OFF_VTL); const bf16* VTC = (const bf16*)(p.ws + OFF_VTC);
    const bf16* KFL = (const bf16*)(p.ws + OFF_KFL); const bf16* KFC = (const bf16*)(p.ws + OFF_KFC);
    int tid_ = threadIdx.x; asm volatile("" : "+v"(tid_));
    const int lane = tid_ & 63, r = lane & 31, hi = lane >> 5, wave = __builtin_amdgcn_readfirstlane(tid_ >> 6);
    const int gw = blockIdx.x * 8 + wave, NGW = gridDim.x * 8;
    int task = gw; bool isctx = false;
    while (true) {
        if (!isctx && task >= 4096) { isctx = true; task = wave == 0 ? (int)blockIdx.x : (1 << 30); }
        if (isctx && task >= 256) break;
        int b, h, q0, rowq;
        if (!isctx) { h = task & 7; q0 = ((task >> 3) & 63) * 64; b = task >> 9; rowq = b * SEQ + q0; }
        else { h = task & 7; q0 = ((task >> 3) & 3) * 64; b = task >> 5; rowq = NL + b * CTXL + q0; }
        const int hk = h >> 2;
        const bf16* qp = PROJ + (size_t)(rowq + r) * EVIN + h * 64 + 8 * hi;
        {
            abf16x8* qw = (abf16x8*)(lds + wave * 8192) + lane;
#pragma unroll
            for (int s = 0; s < 4; ++s) { qw[s * 64] = *(const abf16x8*)(qp + 16 * s); qw[(4 + s) * 64] = *(const abf16x8*)(qp + (size_t)32 * EVIN + 16 * s); }
        }
        const float m0 = p.in[I_EVSINK][h] * 1.4426950408889634f;
        float ma = m0, mb = m0, la = hi ? 0.f : 1.f, lb = la;
        af32x16 oa0, oa1, ob0, ob1;
#pragma unroll
        for (int i = 0; i < 16; ++i) { oa0[i] = 0.f; oa1[i] = 0.f; ob0[i] = 0.f; ob1[i] = 0.f; }
        int kbeg = 0, nloc = 0;
        if (!isctx) { const int lo = max(0, q0 - 128), hik = min(SEQ - 1, q0 + 63 + 128); kbeg = lo & ~63; nloc = ((hik - kbeg) >> 6) + 1; }
        const int ntile = nloc + 4;
        const char* kloc = (const char*)(KFL + (size_t)(b * 2 + hk) * 128 * 2048);
        const char* vloc = (const char*)(VTL + (size_t)(b * 2 + hk) * 128 * 2048);
        const char* kctx = (const char*)(KFC + (size_t)(b * 2 + hk) * 8 * 2048);
        const char* vctx = (const char*)(VTC + (size_t)(b * 2 + hk) * 8 * 2048);
        const unsigned vo = lane * 16;
        AttnK ka; AttnV fv;
        {   const bool loc0 = nloc > 0; const size_t o0_ = loc0 ? (size_t)(kbeg >> 5) * 4096 : 0;
            attn_load_k(ka, (loc0 ? kloc : kctx) + o0_, vo); attn_load_v(fv, (loc0 ? vloc : vctx) + o0_, vo); }
        for (int ti = 0; ti < ntile; ++ti) {
            const int tn = ti + 1; const bool has_next = tn < ntile, nloc_ = tn < nloc;
            const size_t on_ = (size_t)(nloc_ ? ((kbeg >> 5) + 2 * tn) : 2 * (tn - nloc)) * 4096;
            const char* nkp = (nloc_ ? kloc : kctx) + on_; const char* nvp = (nloc_ ? vloc : vctx) + on_;
            unsigned qo_ = wave * 8192 + lane * 16; asm volatile("" : "+v"(qo_));
            const abf16x8* qa = (const abf16x8*)(lds + qo_); const abf16x8* qb = qa + 256;
            const bool loc_ = ti < nloc; const int k0_ = kbeg + 64 * ti;
            const bool pa_ = loc_ && !(k0_ >= q0 + 31 - 128 && k0_ + 63 <= q0 + 128 && k0_ + 63 < SEQ);
            const bool pb_ = loc_ && !(k0_ >= q0 + 63 - 128 && k0_ + 63 <= q0 + 32 + 128 && k0_ + 63 < SEQ);
            attn_tile(ka, fv, false, nkp, nvp, vo, qa, pa_, k0_ - q0 - r, SEQ - k0_, hi, ma, la, oa0, oa1);
            __builtin_amdgcn_sched_barrier(0);
            attn_tile(ka, fv, has_next, nkp, nvp, vo, qb, pb_, k0_ - q0 - 32 - r, SEQ - k0_, hi, mb, lb, ob0, ob1);
        }
        la += __shfl_xor(la, 32); lb += __shfl_xor(lb, 32);
        const float ia = 1.f / la, ib = 1.f / lb;
        bf16* op = MIX + (size_t)(rowq + r) * D + h * 64 + 4 * hi;
#pragma unroll
        for (int g = 0; g < 4; ++g) {
            uint2 w0, w1;
            w0.x = cvtpk(oa0[4 * g] * ia, oa0[4 * g + 1] * ia); w0.y = cvtpk(oa0[4 * g + 2] * ia, oa0[4 * g + 3] * ia);
            w1.x = cvtpk(oa1[4 * g] * ia, oa1[4 * g + 1] * ia); w1.y = cvtpk(oa1[4 * g + 2] * ia, oa1[4 * g + 3] * ia);
            *(uint2*)(op + 8 * g) = w0; *(uint2*)(op + 32 + 8 * g) = w1;
            w0.x = cvtpk(ob0[4 * g] * ib, ob0[4 * g + 1] * ib); w0.y = cvtpk(ob0[4 * g + 2] * ib, ob0[4 * g + 3] * ib);
            w1.x = cvtpk(ob1[4 * g] * ib, ob1[4 * g + 1] * ib); w1.y = cvtpk(ob1[4 * g + 2] * ib, ob1[4 * g + 3] * ib);
            *(uint2*)(op + (size_t)32 * D + 8 * g) = w0; *(uint2*)(op + (size_t)32 * D + 32 + 8 * g) = w1;
        }
        task += isctx ? (int)gridDim.x : NGW;
    }
}
__device__ __forceinline__ void ph_conv3v(const P& p) {
    const int tix = otid();
    const bf16* __restrict__ PROJ = (const bf16*)(p.ws + OFF_PROJ); bf16* __restrict__ MIX = (bf16*)(p.ws + OFF_MIX);
    const float* cw = p.in[I_EVCW]; const float* cb = p.in[I_EVCB];
    const int total = NT * 64, stride = gridDim.x * blockDim.x, i0 = blockIdx.x * blockDim.x + tix;
    const int j = (i0 & 63) * 8;
    float wv[3][8], bv[8];
    { const float4 b0 = *(const float4*)(cb + j), b1 = *(const float4*)(cb + j + 4); bv[0] = b0.x; bv[1] = b0.y; bv[2] = b0.z; bv[3] = b0.w; bv[4] = b1.x; bv[5] = b1.y; bv[6] = b1.z; bv[7] = b1.w; }
#pragma unroll
    for (int k = 0; k < 3; ++k) { const float4 w0 = *(const float4*)(cw + k * 512 + j), w1 = *(const float4*)(cw + k * 512 + j + 4);
        wv[k][0] = w0.x; wv[k][1] = w0.y; wv[k][2] = w0.z; wv[k][3] = w0.w; wv[k][4] = w1.x; wv[k][5] = w1.y; wv[k][6] = w1.z; wv[k][7] = w1.w; }
    for (int ib = i0; ib < total; ib += 2 * stride) {
        uint4 gcv[2][3], uv[2][3], gbv[2];
#pragma unroll
        for (int q = 0; q < 2; ++q) {
            const int i = ib + q * stride; const int r = min(i, total - 1) >> 6;
            int t, len; if (r < NL) { t = r & 4095; len = SEQ; } else { t = (r - NL) & 255; len = CTXL; }
#pragma unroll
            for (int k = 0; k < 3; ++k) { const int tt = t - 1 + k; const bool ok = tt >= 0 && tt < len; const bf16* row = PROJ + (size_t)(r - 1 + k) * EVIN;
                gcv[q][k] = ok ? *(const uint4*)(row + 1280 + j) : make_uint4(0u, 0u, 0u, 0u); uv[q][k] = ok ? *(const uint4*)(row + 1792 + j) : make_uint4(0u, 0u, 0u, 0u); }
            gbv[q] = *(const uint4*)(PROJ + (size_t)r * EVIN + 768 + j);
        }
#pragma unroll
        for (int q = 0; q < 2; ++q) {
            const int i = ib + q * stride;
            float acc[8];
#pragma unroll
            for (int c = 0; c < 8; ++c) acc[c] = bv[c];
#pragma unroll
            for (int k = 0; k < 3; ++k) { float gc[8], u[8]; unpack8(gcv[q][k], gc); unpack8(uv[q][k], u);
#pragma unroll
                for (int c = 0; c < 8; ++c) acc[c] += wv[k][c] * (gc[c] * u[c]); }
            float gb[8]; unpack8(gbv[q], gb);
#pragma unroll
            for (int c = 0; c < 8; ++c) acc[c] *= gb[c];
            if (i < total) *(uint4*)(MIX + (size_t)(i >> 6) * D + 512 + j) = pack8(acc);
        }
    }
}

namespace pg8 {
#define PG8_LAS __attribute__((address_space(3)))
typedef short bf16x8 __attribute__((ext_vector_type(8)));
typedef float f32x4 __attribute__((ext_vector_type(4)));
typedef unsigned u32x4 __attribute__((ext_vector_type(4)));
constexpr int BM = 256, BK = 64, HALF = 128, HTB = HALF * BK * 2, STAGE_BYTES = 8 * HTB, NXCD = 8, WGM = 8;
__device__ __forceinline__ int lds_byte(int r, int c) { const int st = (r >> 4) * 2 + (c >> 5), rr = r & 15, cc = c & 31, ob = rr * 64 + cc * 2; return st * 1024 + (ob ^ (((ob >> 9) & 1) << 5)); }
__device__ __forceinline__ void stage_rc(int b, int& R, int& C) { const int st = b / 1024, sb = b % 1024, swz = sb ^ (((sb >> 9) & 1) << 5); R = (st >> 1) * 16 + swz / 64; C = (st & 1) * 32 + (swz % 64) / 2; }
__device__ __forceinline__ int perm32(int rho) { const int n = rho >> 4, i = rho & 15; return 8 * (i >> 2) + 4 * n + (i & 3); }
__device__ __forceinline__ unsigned cvt_pk_bf16(float lo, float hi) { unsigned r; asm volatile("v_cvt_pk_bf16_f32 %0, %1, %2" : "=v"(r) : "v"(lo), "v"(hi)); return r; }

struct Unit { int g, pm, pn; };
struct Sched {
    int ng, nM, nN, nwg, G, c;
    const char* Abase; size_t a_gstride, a_tstride;
    const char* Bbase; size_t b_gstride, b_tstride;
    const int* rowidx; int idx_gstride;
    __device__ __forceinline__ bool next(int i, Unit& u) const {
        const long L = (long)i * G + c; if (L >= nwg) return false;
        int wgid = (int)L; { const int q = nwg / NXCD, r = nwg % NXCD, xcd = wgid % NXCD, off = wgid / NXCD; wgid = (xcd < r ? xcd * (q + 1) : r * (q + 1) + (xcd - r) * q) + off; }
        const int tpg = nM * nN; u.g = wgid / tpg; const int w = wgid % tpg;
        const int nig = WGM * nN, gid = w / nig, fm = gid * WGM, gsz = (nM - fm) < WGM ? (nM - fm) : WGM;
        u.pm = fm + ((w % nig) % gsz); u.pn = (w % nig) / gsz; return true;
    }
    __device__ __forceinline__ const char* a_base(const Unit& u) const { return Abase + (size_t)u.g * a_gstride + (size_t)u.pm * a_tstride; }
    __device__ __forceinline__ const char* b_base(const Unit& u) const { return Bbase + (size_t)u.g * b_gstride + (size_t)u.pn * b_tstride; }
};

template <class Epi, bool GATHER, bool F8 = false>
__device__ __forceinline__ void gemm_phase(PG8_LAS unsigned char* lds, const int KB  , const Sched& S, const Epi& E) {
    int tid_ = threadIdx.x; asm volatile("" : "+v"(tid_));
    const int tid = tid_, wid = __builtin_amdgcn_readfirstlane(tid >> 6), lane = tid & 63, wr = wid >> 2, wc = wid & 3, fr = lane & 15, fq = lane >> 4;
    const int nt = KB / (BK * 2);
    int Rr[2], Cc[2]; unsigned voffB[2];
#pragma unroll
    for (int i = 0; i < 2; ++i) { stage_rc(tid * 16 + i * 8192, Rr[i], Cc[i]); const int Rb = Epi::PERM ? ((Rr[i] & ~31) + perm32(Rr[i] & 31)) : Rr[i]; voffB[i] = (unsigned)(Rb * KB + Cc[i] * 2); }
    const size_t kstep = (size_t)(BK * 2);
    const size_t hstep = (size_t)HALF * KB;
    const unsigned ldsw = (unsigned)wid * 1024u;
    const int aoff = lds_byte(wr * 64 + fr, fq * 8), boff = lds_byte(wc * 32 + fr, fq * 8);
#define PG8_SA(b, h) (((b) * 2 + (h)) * HTB)
#define PG8_SB(b, h) ((4 + (b) * 2 + (h)) * HTB)
#define PG8_STAGE2(bufoff, gbase, v0, v1) do { unsigned o0_ = (v0), o1_ = (v1); asm volatile("" : "+v"(o0_), "+v"(o1_));     \
        __builtin_amdgcn_global_load_lds((const unsigned*)((const char*)(gbase) + o0_), (PG8_LAS unsigned*)(lds + (bufoff) + ldsw), 16, 0, 0); \
        __builtin_amdgcn_global_load_lds((const unsigned*)((const char*)(gbase) + o1_), (PG8_LAS unsigned*)(lds + (bufoff) + ldsw + 8192), 16, 0, 0); } while (0)
#define PG8_STAGEB(bufoff, gbase) PG8_STAGE2(bufoff, gbase, voffB[0], voffB[1])
#define PG8_STAGEA1(bufoff, gbase, v10, v11, v00, v01) do { if constexpr (GATHER) PG8_STAGE2(bufoff, gbase, v10, v11); else PG8_STAGE2(bufoff, (gbase) + hstep, v00, v01); } while (0)
#define PG8_LDA(dst, b, h) do { _Pragma("unroll") for (int m = 0; m < 4; ++m) { if constexpr (F8) dst##8[m] = __builtin_shufflevector(*(const PG8_LAS v4i_*)(lds + PG8_SA(b, h) + aoff + m * 2048), *(const PG8_LAS v4i_*)(lds + PG8_SA(b, h) + aoff + m * 2048 + 1024), 0, 1, 2, 3, 4, 5, 6, 7); \
        else { _Pragma("unroll") for (int k = 0; k < 2; ++k) dst[m][k] = *(const PG8_LAS bf16x8*)(lds + PG8_SA(b, h) + aoff + m * 2048 + k * 1024); } } } while (0)
#define PG8_LDB(dst, b, h) do { _Pragma("unroll") for (int n = 0; n < 2; ++n) { if constexpr (F8) dst##8[n] = __builtin_shufflevector(*(const PG8_LAS v4i_*)(lds + PG8_SB(b, h) + boff + n * 2048), *(const PG8_LAS v4i_*)(lds + PG8_SB(b, h) + boff + n * 2048 + 1024), 0, 1, 2, 3, 4, 5, 6, 7); \
        else { _Pragma("unroll") for (int k = 0; k < 2; ++k) dst[n][k] = *(const PG8_LAS bf16x8*)(lds + PG8_SB(b, h) + boff + n * 2048 + k * 1024); } } } while (0)
#define PG8_MMA(ai, bj, At, Bt) do { __builtin_amdgcn_s_setprio(1); _Pragma("unroll") for (int m = 0; m < 4; ++m) _Pragma("unroll") for (int n = 0; n < 2; ++n) { \
        if constexpr (F8) asm volatile("v_mfma_scale_f32_16x16x128_f8f6f4 %0, %1, %2, %0, %3, %3 op_sel_hi:[0,0,0]" : "+v"(acc[ai][bj][m][n]) : "v"(Bt##8[n]), "v"(At##8[m]), "v"(scl8));   \
        else { _Pragma("unroll") for (int k = 0; k < 2; ++k) acc[ai][bj][m][n] = __builtin_amdgcn_mfma_f32_16x16x32_bf16(Bt[n][k], At[m][k], acc[ai][bj][m][n], 0, 0, 0); } } \
        __builtin_amdgcn_s_setprio(0); } while (0)
#define PG8_WAIT_V(n) asm volatile("s_waitcnt vmcnt(" #n ")" ::: "memory")
#define PG8_WAIT_L(n) asm volatile("s_waitcnt lgkmcnt(" #n ")" ::: "memory")
#define PG8_BAR __builtin_amdgcn_s_barrier()
#define PG8_SCHED __builtin_amdgcn_sched_barrier(0)
    Unit cur, nxt; int ui = 0;
    if (!S.next(0, cur)) return;
    f32x4 acc[2][2][4][2];
#pragma unroll
    for (int a = 0; a < 2; ++a)
#pragma unroll
        for (int b = 0; b < 2; ++b)
#pragma unroll
            for (int m = 0; m < 4; ++m)
#pragma unroll
                for (int n = 0; n < 2; ++n) acc[a][b][m][n] = (f32x4){0.f, 0.f, 0.f, 0.f};
    typedef int v8i_ __attribute__((ext_vector_type(8))); typedef int v4i_ __attribute__((ext_vector_type(4)));
    unsigned scl8 = 0x7F7F7F7Fu; asm volatile("" : "+v"(scl8));
    bf16x8 At[4][2], B0[2][2], B1[2][2]; v8i_ At8[4], B08[2], B18[2];
    unsigned c00, c01, c10, c11, n00, n01, n10, n11;
#define PG8_VOFFA(u, v00, v01, v10, v11) do { \
        if constexpr (GATHER) { const int* ix = S.rowidx + (size_t)(u).g * S.idx_gstride + (u).pm * BM; \
            int t2_ = tid; asm volatile("" : "+v"(t2_)); int R0_, C0_, R1_, C1_; stage_rc(t2_ * 16, R0_, C0_); stage_rc(t2_ * 16 + 8192, R1_, C1_);     \
            v00 = (unsigned)(ix[R0_] * KB + C0_ * 2); v01 = (unsigned)(ix[R1_] * KB + C1_ * 2); \
            v10 = (unsigned)(ix[HALF + R0_] * KB + C0_ * 2); v11 = (unsigned)(ix[HALF + R1_] * KB + C1_ * 2); } \
        else { v00 = (unsigned)(Rr[0] * KB + Cc[0] * 2); v01 = (unsigned)(Rr[1] * KB + Cc[1] * 2); \
            v10 = (unsigned)((HALF + Rr[0]) * KB + Cc[0] * 2); v11 = (unsigned)((HALF + Rr[1]) * KB + Cc[1] * 2); } } while (0)
    PG8_VOFFA(cur, c00, c01, c10, c11);
    const char* cA = GATHER ? S.Abase : S.a_base(cur); const char* cB = S.b_base(cur);
    PG8_STAGEB(PG8_SB(0, 0), cB); PG8_STAGEB(PG8_SB(0, 1), cB + hstep); PG8_STAGE2(PG8_SA(0, 0), cA, c00, c01); PG8_STAGEA1(PG8_SA(0, 1), cA, c10, c11, c00, c01);
    if (wr == 1) PG8_BAR;
    PG8_WAIT_V(2); PG8_BAR;
    PG8_STAGEB(PG8_SB(1, 0), cB + kstep); PG8_STAGE2(PG8_SA(1, 0), cA + kstep, c00, c01); PG8_STAGEB(PG8_SB(1, 1), cB + hstep + kstep);
    PG8_WAIT_V(6); PG8_BAR;
    for (;;) {
        const bool has_next = S.next(ui + 1, nxt);
        const char* nA = has_next ? (GATHER ? S.Abase : S.a_base(nxt)) : cA; const char* nB = has_next ? S.b_base(nxt) : cB;
        if (has_next) { PG8_VOFFA(nxt, n00, n01, n10, n11); } else { n00 = c00; n01 = c01; n10 = c10; n11 = c11; }
#pragma unroll 1
        for (int t = 0; t < nt; t += 2) {
            const bool last = (t == nt - 2);
            const char* a1 = cA + (size_t)(t + 1) * kstep;
            const char* a2 = last ? nA : cA + (size_t)(t + 2) * kstep; const char* b2 = last ? nB : cB + (size_t)(t + 2) * kstep;
            const char* a3 = a2 + kstep; const char* b3 = b2 + kstep;
            const unsigned x00 = last ? n00 : c00, x01 = last ? n01 : c01, x10 = last ? n10 : c10, x11 = last ? n11 : c11;
            PG8_LDB(B0, 0, 0); PG8_LDB(B1, 0, 1); PG8_SCHED; PG8_LDA(At, 0, 0); PG8_STAGEA1(PG8_SA(1, 1), a1, c10, c11, c00, c01);
            PG8_WAIT_V(8); PG8_WAIT_L(0); PG8_BAR; PG8_MMA(0, 0, At, B0); PG8_MMA(0, 1, At, B1); PG8_BAR; PG8_SCHED;
            PG8_LDA(At, 0, 1); PG8_STAGEB(PG8_SB(0, 0), b2); PG8_STAGEB(PG8_SB(0, 1), b2 + hstep); PG8_STAGE2(PG8_SA(0, 0), a2, x00, x01);
            PG8_WAIT_V(8); PG8_WAIT_L(0); PG8_BAR; PG8_MMA(1, 0, At, B0); PG8_MMA(1, 1, At, B1); PG8_BAR; PG8_SCHED;
            PG8_LDB(B0, 1, 0); PG8_LDB(B1, 1, 1); PG8_SCHED; PG8_LDA(At, 1, 0); PG8_STAGEA1(PG8_SA(0, 1), a2, x10, x11, x00, x01);
            PG8_WAIT_V(8); PG8_WAIT_L(0); PG8_BAR; PG8_MMA(0, 0, At, B0); PG8_MMA(0, 1, At, B1); PG8_BAR; PG8_SCHED;
            PG8_LDA(At, 1, 1); PG8_STAGEB(PG8_SB(1, 0), b3); PG8_STAGEB(PG8_SB(1, 1), b3 + hstep); PG8_STAGE2(PG8_SA(1, 0), a3, x00, x01);
            PG8_WAIT_V(8); PG8_WAIT_L(0); PG8_BAR; PG8_MMA(1, 0, At, B0); PG8_MMA(1, 1, At, B1); PG8_BAR; PG8_SCHED;
        }
        if (wr == 0) PG8_BAR;
        if constexpr (F8) asm volatile("s_nop 15\n\ts_nop 15" ::: "memory");
        { int efr = fr, efq = fq; asm volatile("" : "+v"(efr), "+v"(efq));
          E(acc, cur, wr, wc, efr, efq); }
        if (!has_next) break;
#pragma unroll
        for (int a = 0; a < 2; ++a)
#pragma unroll
            for (int b = 0; b < 2; ++b)
#pragma unroll
                for (int m = 0; m < 4; ++m)
#pragma unroll
                    for (int n = 0; n < 2; ++n) acc[a][b][m][n] = (f32x4){0.f, 0.f, 0.f, 0.f};
        cur = nxt; cA = nA; cB = nB; c00 = n00; c01 = n01; c10 = n10; c11 = n11; ++ui;
        if (wr == 1) PG8_BAR;
    }
    PG8_WAIT_V(0);
    PG8_BAR;
#undef PG8_SA
#undef PG8_SB
#undef PG8_STAGE2
#undef PG8_STAGEB
#undef PG8_STAGEA1
#undef PG8_LDA
#undef PG8_LDB
#undef PG8_MMA
#undef PG8_WAIT_V
#undef PG8_WAIT_L
#undef PG8_BAR
#undef PG8_SCHED
#undef PG8_VOFFA
}

__device__ __forceinline__ float clamp448(float v) { return fminf(fmaxf(v, -448.f), 448.f); }
__device__ __forceinline__ unsigned pack_fp8x4(float a, float b, float c, float d) {
    int w = __builtin_amdgcn_cvt_pk_fp8_f32(clamp448(a), clamp448(b), 0, false);
    w = __builtin_amdgcn_cvt_pk_fp8_f32(clamp448(c), clamp448(d), w, true);
    return (unsigned)w;
}
struct EpiStoreBf16 {
    static constexpr bool PERM = true;
    bf16* C; int ldc; size_t gstride; float scale;
    __device__ __forceinline__ void operator()(const f32x4 (&acc)[2][2][4][2], const Unit& u, int wr, int wc, int fr, int fq) const {
        bf16* base = C + (size_t)u.g * gstride + (size_t)(u.pm * BM + wr * 64 + fr) * ldc + u.pn * BM + wc * 32 + 8 * fq;
#pragma unroll
        for (int ai = 0; ai < 2; ++ai)
#pragma unroll
            for (int m = 0; m < 4; ++m) { bf16* rowp = base + (size_t)(ai * HALF + m * 16) * ldc;
#pragma unroll
                for (int bj = 0; bj < 2; ++bj) { const f32x4 v0 = acc[ai][bj][m][0] * scale, v1 = acc[ai][bj][m][1] * scale;
                    u32x4 w; w.x = cvt_pk_bf16(v0[0], v0[1]); w.y = cvt_pk_bf16(v0[2], v0[3]); w.z = cvt_pk_bf16(v1[0], v1[1]); w.w = cvt_pk_bf16(v1[2], v1[3]);
                    *(u32x4*)(rowp + bj * HALF) = w; } }
    }
};
struct EpiStoreFp8 {
    static constexpr bool PERM = true;
    unsigned char* C; int ldc; size_t gstride; float scale;
    __device__ __forceinline__ void operator()(const f32x4 (&acc)[2][2][4][2], const Unit& u, int wr, int wc, int fr, int fq) const {
        unsigned char* base = C + (size_t)u.g * gstride + (size_t)(u.pm * BM + wr * 64 + fr) * ldc + u.pn * BM + wc * 32 + 8 * fq;
#pragma unroll
        for (int ai = 0; ai < 2; ++ai)
#pragma unroll
            for (int m = 0; m < 4; ++m) { unsigned char* rowp = base + (size_t)(ai * HALF + m * 16) * ldc;
#pragma unroll
                for (int bj = 0; bj < 2; ++bj) { const f32x4 v0 = acc[ai][bj][m][0] * scale, v1 = acc[ai][bj][m][1] * scale;
                    uint2 w; w.x = pack_fp8x4(v0[0], v0[1], v0[2], v0[3]); w.y = pack_fp8x4(v1[0], v1[1], v1[2], v1[3]);
                    *(uint2*)(rowp + bj * HALF) = w; } }
    }
};
struct EpiSplitBf16 {
    static constexpr bool PERM = true;
    bf16* C0; bf16* C1;
    __device__ __forceinline__ void operator()(const f32x4 (&acc)[2][2][4][2], const Unit& u, int wr, int wc, int fr, int fq) const {
        const int colt = u.pn * BM; bf16* Cb = colt < 1024 ? C0 : C1;
        bf16* base = Cb + (size_t)(u.pm * BM + wr * 64 + fr) * 1024 + (colt & 1023) + wc * 32 + 8 * fq;
#pragma unroll
        for (int ai = 0; ai < 2; ++ai)
#pragma unroll
            for (int m = 0; m < 4; ++m) { bf16* rowp = base + (size_t)(ai * HALF + m * 16) * 1024;
#pragma unroll
                for (int bj = 0; bj < 2; ++bj) { const f32x4 v0 = acc[ai][bj][m][0], v1 = acc[ai][bj][m][1];
                    u32x4 w; w.x = cvt_pk_bf16(v0[0], v0[1]); w.y = cvt_pk_bf16(v0[2], v0[3]); w.z = cvt_pk_bf16(v1[0], v1[1]); w.w = cvt_pk_bf16(v1[2], v1[3]);
                    *(u32x4*)(rowp + bj * HALF) = w; } }
    }
};
constexpr int FFP = 1536;
constexpr float W8_SCALE = 32.f, HID8_SCALE = 8.f;
struct EpiSwiGLU8 {
    static constexpr bool PERM = true;
    unsigned char* HID;
    __device__ __forceinline__ void operator()(const f32x4 (&acc)[2][2][4][2], const Unit& u, int wr, int wc, int fr, int fq) const {
        unsigned char* base = HID + ((size_t)u.g * ME + u.pm * BM + wr * 64 + fr) * FFP + u.pn * HALF + wc * 32 + 8 * fq;
        const float sg = 1.f / W8_SCALE, su = HID8_SCALE / W8_SCALE;
#pragma unroll
        for (int ai = 0; ai < 2; ++ai)
#pragma unroll
            for (int m = 0; m < 4; ++m) {
                float h[8];
#pragma unroll
                for (int n = 0; n < 2; ++n)
#pragma unroll
                    for (int j = 0; j < 4; ++j) { const float a = acc[ai][0][m][n][j] * sg, uu = acc[ai][1][m][n][j] * su; h[n * 4 + j] = a * __builtin_amdgcn_rcpf(1.f + __builtin_amdgcn_exp2f(-1.4426950408889634f * a)) * uu; }
                uint2 w; w.x = pack_fp8x4(h[0], h[1], h[2], h[3]); w.y = pack_fp8x4(h[4], h[5], h[6], h[7]);
                unsigned char* dst = base + (size_t)(ai * HALF + m * 16) * FFP;
                *(uint2*)dst = w;
                if (u.pn == 10) *(uint2*)(dst + 128) = make_uint2(0u, 0u);
            }
    }
};
struct EpiResid {
    static constexpr bool PERM = true;
    const float* x_in; const float* ctx_in; bf16* xres; const float* modv_l; bool first;
    __device__ __forceinline__ void operator()(const f32x4 (&acc)[2][2][4][2], const Unit& u, int wr, int wc, int fr, int fq) const {
        const int row0t = u.pm * BM;
        const float* rb = row0t < NL ? x_in : ctx_in - (size_t)NL * D;
        const int mr = row0t < NL ? (row0t >> 12) : 8;
        const int row0 = row0t + wr * 64 + fr, col0 = u.pn * BM + wc * 32 + 8 * fq;
        const float* gate = modv_l + (size_t)mr * 6144 + 2 * 1024 + col0;
#pragma unroll
        for (int ai = 0; ai < 2; ++ai)
#pragma unroll
            for (int m = 0; m < 4; ++m) { const size_t off = (size_t)(row0 + ai * HALF + m * 16) * D + col0;
#pragma unroll
                for (int bj = 0; bj < 2; ++bj) {
                    const f32x4 g0 = *(const f32x4*)(gate + bj * HALF), g1 = *(const f32x4*)(gate + bj * HALF + 4);
                    f32x4 r0, r1;
                    if (first) { r0 = *(const f32x4*)(rb + off + bj * HALF); r1 = *(const f32x4*)(rb + off + bj * HALF + 4); }
                    else { const u32x4 w = *(const u32x4*)(xres + off + bj * HALF);
                        r0 = (f32x4){__uint_as_float(w.x << 16), __uint_as_float(w.x & 0xffff0000u), __uint_as_float(w.y << 16), __uint_as_float(w.y & 0xffff0000u)};
                        r1 = (f32x4){__uint_as_float(w.z << 16), __uint_as_float(w.z & 0xffff0000u), __uint_as_float(w.w << 16), __uint_as_float(w.w & 0xffff0000u)}; }
                    const f32x4 v0 = r0 + g0 * acc[ai][bj][m][0], v1 = r1 + g1 * acc[ai][bj][m][1];
                    u32x4 o; o.x = cvt_pk_bf16(v0[0], v0[1]); o.y = cvt_pk_bf16(v0[2], v0[3]); o.z = cvt_pk_bf16(v1[0], v1[1]); o.w = cvt_pk_bf16(v1[2], v1[3]);
                    *(u32x4*)(xres + off + bj * HALF) = o; }
                asm volatile("" ::: "memory"); }
    }
};
}

__device__ __forceinline__ void transpose_item(const float* W, int K, int N, bf16* WT, int k0, int n0, int drow0, float* scr, int lane) {
    float tv[32];
#pragma unroll
    for (int i = 0; i < 32; ++i) tv[i] = W[(size_t)(k0 + 2 * i + (lane >> 5)) * N + n0 + (lane & 31)];
#pragma unroll
    for (int i = 0; i < 32; ++i) scr[(2 * i + (lane >> 5)) * 33 + (lane & 31)] = tv[i];
    __builtin_amdgcn_wave_barrier(); asm volatile("s_waitcnt lgkmcnt(0)" ::: "memory");
    const int c = lane & 7;
#pragma unroll
    for (int j = 0; j < 4; ++j) { const int n = (lane >> 3) + 8 * j; const float* s = scr + (8 * c) * 33 + n;
        uint4 o; o.x = pk2(s[0 * 33], s[1 * 33]); o.y = pk2(s[2 * 33], s[3 * 33]); o.z = pk2(s[4 * 33], s[5 * 33]); o.w = pk2(s[6 * 33], s[7 * 33]);
        *(uint4*)(WT + (size_t)(drow0 + n) * K + k0 + 8 * c) = o; }
    __builtin_amdgcn_wave_barrier(); asm volatile("s_waitcnt lgkmcnt(0)" ::: "memory");
}
constexpr size_t OFF_WT_EVIN = 17 * MiB, OFF_WT_EVOUT = 22 * MiB, OFF_WT_ODIN = 24 * MiB, OFF_WT_ODOUT = 28 * MiB;
constexpr size_t OFF_WGU = 491 * MiB, OFF_WDN = 536 * MiB;
constexpr size_t OFF_WGU1 = 100 * MiB, OFF_WDN1 = 144 * MiB;
constexpr size_t WGU_E = (size_t)2816 * 1024, WDN_E = (size_t)1024 * pg8::FFP;
__device__ __forceinline__ void transpose_item_f8(const float* W, int K, int N, int KP, unsigned char* WT, int k0, int n0, int drow0, float scale, float* scr, int lane) {
    if (k0 < K) {
        float tv[32];
#pragma unroll
        for (int i = 0; i < 32; ++i) tv[i] = W[(size_t)(k0 + 2 * i + (lane >> 5)) * N + n0 + (lane & 31)];
#pragma unroll
        for (int i = 0; i < 32; ++i) scr[(2 * i + (lane >> 5)) * 33 + (lane & 31)] = tv[i] * scale;
    }
    __builtin_amdgcn_wave_barrier(); asm volatile("s_waitcnt lgkmcnt(0)" ::: "memory");
    const int c = lane & 7;
#pragma unroll
    for (int j = 0; j < 4; ++j) { const int n = (lane >> 3) + 8 * j; const float* s = scr + (8 * c) * 33 + n;
        uint2 o = make_uint2(0u, 0u);
        if (k0 < K) { o.x = pg8::pack_fp8x4(s[0 * 33], s[1 * 33], s[2 * 33], s[3 * 33]); o.y = pg8::pack_fp8x4(s[4 * 33], s[5 * 33], s[6 * 33], s[7 * 33]); }
        *(uint2*)(WT + (size_t)(drow0 + n) * KP + k0 + 8 * c) = o; }
    __builtin_amdgcn_wave_barrier(); asm volatile("s_waitcnt lgkmcnt(0)" ::: "memory");
}
__device__ __forceinline__ void ph_convert_other(const P& p, float* sm) {
    const int tix = otid();
    const int lane = tix & 63, wave = tix >> 6; float* scr = sm + wave * (64 * 33);
    const int gw = blockIdx.x * 8 + wave, NGW = gridDim.x * 8;
    constexpr int I0 = 16 * 72, I1 = 16 * 32, I2 = 16 * 64, I3 = 16 * 32;
    for (int it = gw; it < I0 + I1 + I2 + I3; it += NGW) {
        int r = it; const float* W; int N; bf16* WT;
        if (r < I0) { W = p.in[I_EVWIN]; N = 2304; WT = (bf16*)(p.ws + OFF_WT_EVIN); }
        else if ((r -= I0) < I1) { W = p.in[I_EVWOUT]; N = 1024; WT = (bf16*)(p.ws + OFF_WT_EVOUT); }
        else if ((r -= I1) < I2) { W = p.in[I_ODWIN]; N = 2048; WT = (bf16*)(p.ws + OFF_WT_ODIN); }
        else { r -= I2; W = p.in[I_ODWOUT]; N = 1024; WT = (bf16*)(p.ws + OFF_WT_ODOUT); }
        const int nblk = N / 32, k0 = 64 * (r / nblk), n0 = 32 * (r % nblk);
        transpose_item(W, 1024, N, WT, k0, n0, n0, scr, lane);
    }
}
constexpr int CVT_IPE = 1408 + 24 * 32;
constexpr int CVT_ITEMS = NE * CVT_IPE;
__device__ __forceinline__ void ph_convert_moe_range(const P& p, int l, float* sm, const int it0, const int it1, const int widx0, const int nworkers) {
    const int tix = otid();
    const int lane = tix & 63, wave = tix >> 6; float* scr = sm + wave * (64 * 33);
    unsigned char* WGUl = (unsigned char*)(p.ws + (l ? OFF_WGU1 : OFF_WGU)); unsigned char* WDNl = (unsigned char*)(p.ws + (l ? OFF_WDN1 : OFF_WDN));
    for (int it = it0 + widx0 + wave; it < it1; it += nworkers) {
        const int e = it / CVT_IPE; int r = it % CVT_IPE;
        if (r < 1408) {
            const int up = r >= 704; if (up) r -= 704;
            const int k0 = 64 * (r / 44), n0 = 32 * (r % 44);
            const float* W = (up ? p.in[I_WU] : p.in[I_WG]) + (size_t)(l * NE + e) * D * FF;
            transpose_item_f8(W, 1024, FF, 1024, WGUl + (size_t)e * WGU_E, k0, n0, (n0 >> 7) * 256 + up * 128 + (n0 & 127), pg8::W8_SCALE, scr, lane);
        } else { r -= 1408;
            const int k0 = 64 * (r / 32), n0 = 32 * (r % 32);
            transpose_item_f8(p.in[I_WD] + (size_t)(l * NE + e) * FF * D, FF, 1024, pg8::FFP, WDNl + (size_t)e * WDN_E, k0, n0, n0, pg8::W8_SCALE, scr, lane);
        }
    }
}
__device__ __forceinline__ void ph_convert_moe(const P& p, int l, float* sm, const int it0 = 0) { ph_convert_moe_range(p, l, sm, it0, CVT_ITEMS, blockIdx.x * 8, gridDim.x * 8); }
__device__ __forceinline__ void ph_conv4v(const P& p) {
    const int tix = otid();
    const bf16* __restrict__ U = (const bf16*)(p.ws + OFF_H); bf16* __restrict__ UC = (bf16*)(p.ws + OFF_UC);
    const float* cw = p.in[I_ODCW]; const float* cb = p.in[I_ODCB];
    const int total = NT * 128, stride = gridDim.x * blockDim.x, i0 = blockIdx.x * blockDim.x + tix;
    const int j = (i0 & 127) * 8;
    float wv[4][8], bv[8];
    { const float4 b0 = *(const float4*)(cb + j), b1 = *(const float4*)(cb + j + 4); bv[0] = b0.x; bv[1] = b0.y; bv[2] = b0.z; bv[3] = b0.w; bv[4] = b1.x; bv[5] = b1.y; bv[6] = b1.z; bv[7] = b1.w; }
#pragma unroll
    for (int k = 0; k < 4; ++k) { const float4 w0 = *(const float4*)(cw + k * 1024 + j), w1 = *(const float4*)(cw + k * 1024 + j + 4);
        wv[k][0] = w0.x; wv[k][1] = w0.y; wv[k][2] = w0.z; wv[k][3] = w0.w; wv[k][4] = w1.x; wv[k][5] = w1.y; wv[k][6] = w1.z; wv[k][7] = w1.w; }
    for (int ib = i0; ib < total; ib += 4 * stride) {
        uint4 uu[4][4];
#pragma unroll
        for (int q = 0; q < 4; ++q) {
            const int i = ib + q * stride; const int r = min(i, total - 1) >> 7;
            int t, len; if (r < NL) { t = r & 4095; len = SEQ; } else { t = (r - NL) & 255; len = CTXL; }
#pragma unroll
            for (int k = 0; k < 4; ++k) { const int tt = t - 2 + k; uu[q][k] = (tt >= 0 && tt < len) ? *(const uint4*)(U + (size_t)(r - 2 + k) * D + j) : make_uint4(0u, 0u, 0u, 0u); }
        }
#pragma unroll
        for (int q = 0; q < 4; ++q) {
            const int i = ib + q * stride;
            float acc[8];
#pragma unroll
            for (int c = 0; c < 8; ++c) acc[c] = bv[c];
#pragma unroll
            for (int k = 0; k < 4; ++k) { float u[8]; unpack8(uu[q][k], u);
#pragma unroll
                for (int c = 0; c < 8; ++c) acc[c] += wv[k][c] * u[c]; }
            if (i < total) *(uint4*)(UC + (size_t)(i >> 7) * D + j) = pack8(acc);
        }
    }
}
__device__ __forceinline__ void ph_convert_gates(const P& p, float* sm) {
    const int tix = otid();
    const int lane = tix & 63, wave = tix >> 6; float* scr = sm + wave * (64 * 33);
    const int gw = blockIdx.x * 8 + wave, NGW = gridDim.x * 8;
    for (int it = gw; it < 256; it += NGW) {
        const int mat = it >> 3, r = it & 7, type = mat >> 4, dh = mat & 15;
        const float* W = (type ? p.in[I_ODWX] : p.in[I_ODWA]) + (size_t)dh * 16384;
        transpose_item(W, 128, 128, (bf16*)(p.ws + OFF_WT_GATES) + (size_t)mat * 16384, 64 * (r >> 2), 32 * (r & 3), 32 * (r & 3), scr, lane);
    }
}
typedef float af32x4 __attribute__((ext_vector_type(4)));
__device__ __forceinline__ float opq(float x) { asm("" : "+v"(x)); return x; }
template <bool REV>
__device__ __forceinline__ void lru_walk(const bf16* UC, bf16* HX, const int b, const int colbase  , const int ch, const abf16x8 (&wa)[4], const abf16x8 (&wx)[4], const abf16x8 (&efs)[4],
                                         const float ba_, const float bx_, const float c8l2, const int fr, const int fq, char* wl  ) {
    float hstate = 0.f;
    const char* ubase = (const char*)(UC + colbase);
    const unsigned vld = (unsigned)(fr * D + 8 * fq) * 2u;
    const int ln_ = fr + 16 * fq;
    char* sbase = (char*)HX; const unsigned vst = (unsigned)((ln_ >> 1) * D + (ch - fr) + (ln_ & 1) * 8) * 2u;
    char* wlw = wl + (4 * fq) * 48 + 2 * fr; const char* wlr = wl + (ln_ >> 1) * 48 + (ln_ & 1) * 16;
    const float NL2E = -1.4426950408889634f;
    const float nba_ = NL2E * ba_, nbx_ = NL2E * bx_;
#define LRU_ROW(q) ((q) < 16 ? (NL + b * CTXL + 16 * (REV ? 15 - (q) : (q))) : (b * SEQ + 16 * (REV ? 255 - ((q) - 16) : ((q) - 16))))
#define LRU_LOAD(buf, q) do { const char* ap_ = ubase + (size_t)LRU_ROW(q) * (D * 2); _Pragma("unroll") for (int s = 0; s < 4; ++s) buf[s] = *(const abf16x8*)(ap_ + vld + 64 * s); } while (0)
    af32x4 zr, zi, uu; float pav[4], pbv[4], pAg[4], pBg[4]; int prow0 = 0;
#define LRU_MFMA(buf, q) do { \
        zr = (af32x4){0.f, 0.f, 0.f, 0.f}; zi = zr; uu = zr; \
        _Pragma("unroll") for (int s = 0; s < 4; ++s) { zr = __builtin_amdgcn_mfma_f32_16x16x32_bf16(buf[s], wa[s], zr, 0, 0, 0); zi = __builtin_amdgcn_mfma_f32_16x16x32_bf16(buf[s], wx[s], zi, 0, 0, 0); } \
        _Pragma("unroll") for (int s = 0; s < 4; ++s) uu = __builtin_amdgcn_mfma_f32_16x16x32_bf16(buf[s], efs[s], uu, 0, 0, 0);     \
        { const int qn_ = (q) + 6 < 272 ? (q) + 6 : 271; LRU_LOAD(buf, qn_); } \
        __builtin_amdgcn_sched_barrier(0); } while (0)
#define LRU_GATES(q) do { \
        _Pragma("unroll") for (int i = 0; i < 4; ++i) {                  \
            const float d1 = 1.f + __builtin_amdgcn_exp2f(opq(NL2E * zr[i] + nba_)); \
            const float d2 = 1.f + __builtin_amdgcn_exp2f(__builtin_amdgcn_fmed3f(opq(NL2E * zi[i] + nbx_), -1e30f, 120.f)); \
            const float a = __builtin_amdgcn_exp2f(opq(c8l2 * __builtin_amdgcn_rcpf(d1))); \
            const float w = opq(1.f - a * a); \
            const float rs = __builtin_amdgcn_rsqf(opq(opq(w * d2) * d2 + 1e-30f)); \
            pav[i] = a; pbv[i] = opq(opq(w * rs) * uu[i]); } \
        float Ac, Bc; \
        if (!REV) { Ac = pav[0]; Bc = pbv[0]; _Pragma("unroll") for (int i = 1; i < 4; ++i) { Bc = pav[i] * Bc + pbv[i]; Ac *= pav[i]; } } \
        else { Ac = pav[3]; Bc = pbv[3]; _Pragma("unroll") for (int i = 2; i >= 0; --i) { Bc = pav[i] * Bc + pbv[i]; Ac *= pav[i]; } } \
        _Pragma("unroll") for (int g = 0; g < 4; ++g) { pAg[g] = __shfl(Ac, fr + 16 * g); pBg[g] = __shfl(Bc, fr + 16 * g); } \
        prow0 = LRU_ROW(q); \
        __builtin_amdgcn_sched_barrier(0); } while (0)
#define LRU_SCAN(STORE) do { \
        float c = hstate, mine = 0.f; \
        if (!REV) { _Pragma("unroll") for (int g = 0; g < 4; ++g) { if (g == fq) mine = c; c = pAg[g] * c + pBg[g]; } } \
        else { _Pragma("unroll") for (int g = 3; g >= 0; --g) { if (g == fq) mine = c; c = pAg[g] * c + pBg[g]; } } \
        hstate = c; \
        if (STORE) { float hv[4]; float run = mine; \
            if (!REV) { _Pragma("unroll") for (int i = 0; i < 4; ++i) { run = pav[i] * run + pbv[i]; hv[i] = run; } } \
            else { _Pragma("unroll") for (int i = 3; i >= 0; --i) { run = pav[i] * run + pbv[i]; hv[i] = run; } } \
            const unsigned p01 = cvtpk(hv[0], hv[1]), p23 = cvtpk(hv[2], hv[3]); \
            *(bf16*)(wlw) = (bf16)(p01 & 0xffffu); *(bf16*)(wlw + 48) = (bf16)(p01 >> 16); *(bf16*)(wlw + 96) = (bf16)(p23 & 0xffffu); *(bf16*)(wlw + 144) = (bf16)(p23 >> 16); \
            if (ln_ < 32) { const uint4 tv_ = *(const uint4*)wlr; *(uint4*)(sbase + (size_t)prow0 * (D * 2) + vst) = tv_; } } \
        __builtin_amdgcn_sched_barrier(0); } while (0)
#define LRU_STEP(buf, q, STORE) do { LRU_MFMA(buf, q); LRU_SCAN(STORE); LRU_GATES(q); } while (0)
    abf16x8 A0[4], A1[4], A2[4], A3[4], A4[4], A5[4];
    LRU_LOAD(A0, 0); LRU_LOAD(A1, 1); LRU_LOAD(A2, 2); LRU_LOAD(A3, 3); LRU_LOAD(A4, 4); LRU_LOAD(A5, 5);
    LRU_MFMA(A0, 0); LRU_GATES(0);
    for (int q = 1; q < 271; q += 6) {
        LRU_STEP(A1, q, q > 16); LRU_STEP(A2, q + 1, q + 1 > 16); LRU_STEP(A3, q + 2, q + 2 > 16); LRU_STEP(A4, q + 3, q + 3 > 16); LRU_STEP(A5, q + 4, q + 4 > 16); LRU_STEP(A0, q + 5, q + 5 > 16); }
    LRU_STEP(A1, 271, true);
    LRU_SCAN(true);
#undef LRU_ROW
#undef LRU_LOAD
#undef LRU_MFMA
#undef LRU_GATES
#undef LRU_SCAN
#undef LRU_STEP
}
__device__ __forceinline__ void ph_lru(const P& p, float* sm) {
    const bf16* UC = (const bf16*)(p.ws + OFF_UC); const bf16* WTG = (const bf16*)(p.ws + OFF_WT_GATES);
    int tid_ = threadIdx.x; asm volatile("" : "+v"(tid_));
    const int lane = tid_ & 63, fr = lane & 15, fq = lane >> 4, wave = __builtin_amdgcn_readfirstlane(tid_ >> 6);
    if (wave < 4) {
        for (int task = blockIdx.x * 4 + wave; task < 1024; task += gridDim.x * 4) {
            const int cb = task & 7, d = (task >> 3) & 1, h = (task >> 4) & 7, b = task >> 7;
            const int ch = h * 128 + cb * 16 + fr;
            const float ba_ = p.in[I_ODBA][d * 1024 + ch], bx_ = p.in[I_ODBX][d * 1024 + ch];
            const float c8l2 = -8.f * log1pf(expf(-p.in[I_ODLAM][d * 1024 + ch])) * 1.4426950408889634f;
            abf16x8 wa[4], wx[4];
            const bf16* wpa = WTG + ((size_t)((0 * 2 + d) * 8 + h) * 128 + cb * 16 + fr) * 128 + 8 * fq;
            const bf16* wpx = WTG + ((size_t)((1 * 2 + d) * 8 + h) * 128 + cb * 16 + fr) * 128 + 8 * fq;
#pragma unroll
            for (int s = 0; s < 4; ++s) { wa[s] = *(const abf16x8*)(wpa + 32 * s); wx[s] = *(const abf16x8*)(wpx + 32 * s); }
            const int kl = (cb & 1) * 16 + fr; abf16x8 efs[4];
#pragma unroll
            for (int s = 0; s < 4; ++s)
#pragma unroll
                for (int j = 0; j < 8; ++j) efs[s][j] = (s == (cb >> 1) && (kl >> 3) == fq && (kl & 7) == j) ? (short)0x3F80 : (short)0;
            bf16* HX = (bf16*)(p.ws + (d ? OFF_HB : OFF_HF));
            char* wl = (char*)sm + wave * 768;
            if (d == 0) lru_walk<false>(UC, HX, b, h * 128, ch, wa, wx, efs, ba_, bx_, c8l2, fr, fq, wl);
            else lru_walk<true>(UC, HX, b, h * 128, ch, wa, wx, efs, ba_, bx_, c8l2, fr, fq, wl);
        }
    }
}
__device__ __forceinline__ void ph_lru_out(const P& p) {
    const int tix = otid();
    bf16* G = (bf16*)(p.ws + OFF_MIX); const bf16* __restrict__ HF = (const bf16*)(p.ws + OFF_HF); const bf16* __restrict__ HB = (const bf16*)(p.ws + OFF_HB);
    const int total = NL * 128, stride = gridDim.x * blockDim.x;
    for (int ib = blockIdx.x * blockDim.x + tix; ib < total; ib += 4 * stride) {
        uint4 gv[4], av[4], cv[4];
#pragma unroll
        for (int q = 0; q < 4; ++q) { const size_t off = (size_t)min(ib + q * stride, total - 1) * 8; gv[q] = *(const uint4*)(G + off); av[q] = *(const uint4*)(HF + off); cv[q] = *(const uint4*)(HB + off); }
#pragma unroll
        for (int q = 0; q < 4; ++q) {
            const int i = ib + q * stride;
            float g[8], a[8], c[8]; unpack8(gv[q], g); unpack8(av[q], a); unpack8(cv[q], c);
#pragma unroll
            for (int z = 0; z < 8; ++z) g[z] = gelu_tanh(g[z]) * (a[z] + c[z]);
            if (i < total) *(uint4*)(G + (size_t)i * 8) = pack8(g);
        }
    }
}

#define LAS __attribute__((address_space(3)))
#define XB_TMO      128
#define XB_XCNT(j)  (256  + 64 * (j))
#define XB_XSUB(j)  (1280 + 64 * (j))
#define XB_XGEN(j)  (2304 + 64 * (j))
#define XB_TOP      3328
#define XB_TOPGEN   3392
#define XCD_BAR_WORDS 3456
#define XB_SPIN_CAP (1u << 18)

__device__ __forceinline__ unsigned xb_ld(unsigned* p)              { return __hip_atomic_load(p, __ATOMIC_RELAXED, __HIP_MEMORY_SCOPE_AGENT); }
__device__ __forceinline__ unsigned xb_add(unsigned* p, unsigned v) { return __hip_atomic_fetch_add(p, v, __ATOMIC_RELAXED, __HIP_MEMORY_SCOPE_AGENT); }
__device__ __forceinline__ unsigned xb_xcc_id() { return (unsigned)__builtin_amdgcn_s_getreg((3 << 11) | 20) & 0xFu; }
#define XB_SPIN(cond, bar) do { unsigned _sp = 0; while (cond) { __builtin_amdgcn_s_sleep(1); \
    if ((++_sp & 255u) == 0u) { if (xb_ld(&(bar)[XB_TMO])) break; if (_sp > XB_SPIN_CAP) { atomicAdd(&(bar)[XB_TMO], 1u); break; } } } } while (0)

struct XcdBarrier {
    unsigned* bar; unsigned x;
    volatile LAS unsigned* st;
};

__device__ __forceinline__ XcdBarrier xcd_barrier_post(unsigned* bar, volatile LAS unsigned* st) {
    XcdBarrier b; b.bar = bar; b.x = xb_xcc_id(); b.st = st;
    if (threadIdx.x == 0) (void)xb_add(&bar[XB_XCNT(b.x)], 1u);
    return b;
}
__device__ __forceinline__ void xcd_barrier_complete(unsigned* bar, unsigned x, unsigned& nloc, unsigned& nx) {
    const unsigned G = gridDim.x * gridDim.y * gridDim.z;
    unsigned sum, cnt, mine, sp = 0u;
    for (;;) {
        sum = 0u; cnt = 0u; mine = 0u;
#pragma unroll
        for (unsigned j = 0; j < 16; ++j) { const unsigned c = xb_ld(&bar[XB_XCNT(j)]); sum += c; cnt += (c > 0u) ? 1u : 0u; mine = (j == x) ? c : mine; }
        if (sum == G) break;
        __builtin_amdgcn_s_sleep(1);
        if ((++sp & 255u) == 0u) { if (xb_ld(&bar[XB_TMO])) break; if (sp > XB_SPIN_CAP) { atomicAdd(&bar[XB_TMO], 1u); break; } }
    }
    nloc = mine > 0u ? mine : 1u; nx = cnt > 0u ? cnt : 1u;
}

__device__ __forceinline__ void xcd_barrier(const XcdBarrier& b) {
    asm volatile("s_waitcnt vmcnt(0)" ::: "memory");
    __syncthreads();
    if (threadIdx.x == 0) {
        unsigned* bar = b.bar;
        __builtin_amdgcn_s_waitcnt(0);
        unsigned nloc = b.st[0], nx = b.st[1];
        if (nloc == 0u) { xcd_barrier_complete(bar, b.x, nloc, nx); b.st[0] = nloc; b.st[1] = nx; }
        const unsigned old = xb_add(&bar[XB_XSUB(b.x)], 1u);
        const unsigned gen = old / nloc;
        if (old + 1u == (gen + 1u) * nloc) {
            __builtin_amdgcn_fence(__ATOMIC_RELEASE, "agent");
            asm volatile("s_waitcnt vmcnt(0)" ::: "memory");
            const unsigned og = xb_add(&bar[XB_TOP], 1u);
            const unsigned tg = og / nx;
            if (og + 1u == (tg + 1u) * nx) xb_add(&bar[XB_TOPGEN], 1u);
            else XB_SPIN(xb_ld(&bar[XB_TOPGEN]) == tg, bar);
            __builtin_amdgcn_fence(__ATOMIC_ACQUIRE, "agent");
            xb_add(&bar[XB_XGEN(b.x)], 1u);
            asm volatile("s_waitcnt vmcnt(0)" ::: "memory");
        } else {
            XB_SPIN(xb_ld(&bar[XB_XGEN(b.x)]) == gen, bar);
            __builtin_amdgcn_fence(__ATOMIC_ACQUIRE, "agent");
            asm volatile("s_waitcnt vmcnt(0)" ::: "memory");
        }
    }
    __syncthreads();
}

typedef float nf32x4 __attribute__((ext_vector_type(4)));
__device__ __forceinline__ void ph_normF(const P& p, const int l, const bool with_ctx, float* sm) {
    const float* modv = (const float*)(p.ws + OFF_MODV);
    const bf16* xres = (const bf16*)(p.ws + OFF_XRES);
    unsigned char* h8 = (unsigned char*)(p.ws + OFF_H);
    const float* rw = p.in[I_RW] + (size_t)l * 1024 * 16;
    const float* gvec = p.in[I_NFFN] + l * 1024;
    int tid_ = threadIdx.x; asm volatile("" : "+v"(tid_));
    const int tid = tid_, lane = tid & 63, fr = lane & 15, fq = lane >> 4, wave = __builtin_amdgcn_readfirstlane(tid >> 6);
    float* RWm = sm; float* biasv = sm + 18432; float* gm = sm + 18448; float* shv = sm + 19472;
    const int nitems = 256;
    for (int item = blockIdx.x; item < nitems; item += gridDim.x) {
        const bool isc = false;
        const int mr = isc ? 8 : (item >> 5);
        const float* mv = modv + (size_t)(l * 9 + mr) * 6144;
        __syncthreads();
        {
#pragma unroll
            for (int q = 0; q < 2; ++q) {
                const int k = 2 * tid + q; const float gmk = gvec[k] * (1.f + mv[4 * 1024 + k]);
                gm[k] = gmk; shv[k] = mv[3 * 1024 + k];
                const float4* w4 = (const float4*)(rw + (size_t)k * 16); float* dst = RWm + (k >> 3) * 144 + (k & 7) * 16;
#pragma unroll
                for (int c = 0; c < 4; ++c) { const float4 w = w4[c]; dst[4 * c] = gmk * w.x; dst[4 * c + 1] = gmk * w.y; dst[4 * c + 2] = gmk * w.z; dst[4 * c + 3] = gmk * w.w; }
            }
            float b0 = 0.f, b1 = 0.f;
            for (int k = lane; k < 1024; k += 64) { const float s = mv[3 * 1024 + k]; b0 += s * rw[(size_t)k * 16 + 2 * wave]; b1 += s * rw[(size_t)k * 16 + 2 * wave + 1]; }
            b0 = wave_sum(b0); b1 = wave_sum(b1);
            if (lane == 0) { biasv[2 * wave] = b0; biasv[2 * wave + 1] = b1; }
        }
        __syncthreads();
        const int tile = isc ? (item - 256) * 8 + wave : item * 8 + wave;
        const int row0 = isc ? NL + tile * 16 : tile * 16;
        const uint4* xq = (const uint4*)(xres + (size_t)(row0 + fr) * D + 8 * fq);
        const float* bq = RWm + fq * 144 + fr;
        nf32x4 acc0 = {0.f, 0.f, 0.f, 0.f}, acc1 = {0.f, 0.f, 0.f, 0.f}; float ss = 0.f;
#pragma unroll 1
        for (int s0 = 0; s0 < 32; s0 += 8) {
            uint4 xw[8];
#pragma unroll
            for (int u = 0; u < 8; ++u) xw[u] = xq[4 * (s0 + u)];
#pragma unroll
            for (int u = 0; u < 8; ++u) {
                float xf[8]; unpack8(xw[u], xf);
                const float* bb = bq + (s0 + u) * 576;
#pragma unroll
                for (int i = 0; i < 8; i += 2) {
                    ss += xf[i] * xf[i] + xf[i + 1] * xf[i + 1];
                    acc0 = __builtin_amdgcn_mfma_f32_16x16x4f32(xf[i], bb[i * 16], acc0, 0, 0, 0);
                    acc1 = __builtin_amdgcn_mfma_f32_16x16x4f32(xf[i + 1], bb[(i + 1) * 16], acc1, 0, 0, 0);
                }
            }
        }
        ss += __shfl_xor(ss, 16); ss += __shfl_xor(ss, 32);
        const float rstd = 1.f / sqrtf(ss * (1.f / D) + EPS);
        const float be = biasv[fr];
#pragma unroll
        for (int reg = 0; reg < 4; ++reg) {
            const float rs = __shfl(rstd, 4 * fq + reg);
            const float lg = (acc0[reg] + acc1[reg]) * rs + be;
            float mx = lg;
#pragma unroll
            for (int o = 1; o < 16; o <<= 1) mx = fmaxf(mx, __shfl_xor(mx, o));
            const float ex = expf(lg - mx); float den = ex;
#pragma unroll
            for (int o = 1; o < 16; o <<= 1) den += __shfl_xor(den, o);
            const float a = ex / den; const int rr = row0 + 4 * fq + reg;
            if (!isc) { const int b = rr >> 12, t = rr & 4095; ((float*)(p.ws + OFF_AFFL))[(size_t)(b * 16 + fr) * SEQ + t] = a; }
            else { const int rc = rr - NL, b = rc >> 8, t = rc & 255; ((float*)(p.ws + OFF_AFFC))[(size_t)(b * 16 + fr) * CTXL + t] = a; }
        }
#pragma unroll 2
        for (int r = 0; r < 16; ++r) {
            const float rs = __shfl(rstd, r);
            const uint2* xr = (const uint2*)(xres + (size_t)(row0 + r) * D);
#pragma unroll
            for (int j = 0; j < 4; ++j) {
                const uint2 xw = xr[lane + 64 * j]; float4 xv; xv.x = bf2f(xw.x & 0xffffu); xv.y = bf2f(xw.x >> 16); xv.z = bf2f(xw.y & 0xffffu); xv.w = bf2f(xw.y >> 16);
                const float4 g = ((const float4*)gm)[lane + 64 * j], sh = ((const float4*)shv)[lane + 64 * j];
                *(unsigned*)(h8 + (size_t)(row0 + r) * D + (lane + 64 * j) * 4) = pg8::pack_fp8x4(xv.x * rs * g.x + sh.x, xv.y * rs * g.y + sh.y, xv.z * rs * g.z + sh.z, xv.w * rs * g.w + sh.w);
            }
        }
    }
}

__device__ __forceinline__ void ph_normF_ctx(const P& p, const int l) {
    const int tix = otid();
    const float* mv = (const float*)(p.ws + OFF_MODV) + (size_t)(l * 9 + 8) * 6144;
    const bf16* xres = (const bf16*)(p.ws + OFF_XRES); unsigned char* h8 = (unsigned char*)(p.ws + OFF_H);
    const float* rw = p.in[I_RW] + (size_t)l * 1024 * 16; const float* gvec = p.in[I_NFFN] + l * 1024;
    const int lane = tix & 63, wave = tix >> 6;
    for (int rc = blockIdx.x * 8 + wave; rc < NC; rc += gridDim.x * 8) {
        const int r = NL + rc;
        const uint2* xr = (const uint2*)(xres + (size_t)r * D);
        float xv[16]; float ss = 0.f;
#pragma unroll
        for (int j = 0; j < 4; ++j) { const uint2 w = xr[lane + 64 * j]; xv[4 * j] = bf2f(w.x & 0xffffu); xv[4 * j + 1] = bf2f(w.x >> 16); xv[4 * j + 2] = bf2f(w.y & 0xffffu); xv[4 * j + 3] = bf2f(w.y >> 16);
            ss += xv[4 * j] * xv[4 * j] + xv[4 * j + 1] * xv[4 * j + 1] + xv[4 * j + 2] * xv[4 * j + 2] + xv[4 * j + 3] * xv[4 * j + 3]; }
        ss = wave_sum(ss);
        const float rstd = 1.f / sqrtf(ss * (1.f / D) + EPS);
        float part[16];
#pragma unroll
        for (int e = 0; e < 16; ++e) part[e] = 0.f;
#pragma unroll
        for (int j = 0; j < 4; ++j) {
            const float4 g = ((const float4*)gvec)[lane + 64 * j], sc = ((const float4*)(mv + 4 * 1024))[lane + 64 * j], sh = ((const float4*)(mv + 3 * 1024))[lane + 64 * j];
            float hh[4];
            hh[0] = xv[4 * j] * rstd * g.x * (1.f + sc.x) + sh.x; hh[1] = xv[4 * j + 1] * rstd * g.y * (1.f + sc.y) + sh.y;
            hh[2] = xv[4 * j + 2] * rstd * g.z * (1.f + sc.z) + sh.z; hh[3] = xv[4 * j + 3] * rstd * g.w * (1.f + sc.w) + sh.w;
            *(unsigned*)(h8 + (size_t)r * D + (lane + 64 * j) * 4) = pg8::pack_fp8x4(hh[0], hh[1], hh[2], hh[3]);
#pragma unroll
            for (int i = 0; i < 4; ++i) {
                const float4* w4 = (const float4*)(rw + (size_t)((lane + 64 * j) * 4 + i) * 16);
#pragma unroll
                for (int q = 0; q < 4; ++q) { const float4 w = w4[q]; part[q * 4 + 0] += hh[i] * w.x; part[q * 4 + 1] += hh[i] * w.y; part[q * 4 + 2] += hh[i] * w.z; part[q * 4 + 3] += hh[i] * w.w; }
            }
        }
        float mx = -1e30f;
#pragma unroll
        for (int e = 0; e < 16; ++e) { part[e] = wave_sum(part[e]); mx = fmaxf(mx, part[e]); }
        float den = 0.f, mine = 0.f;
#pragma unroll
        for (int e = 0; e < 16; ++e) { const float ex = expf(part[e] - mx); den += ex; if (lane == e) mine = ex; }
        if (lane < 16) { const int b = rc >> 8, t = rc & 255; ((float*)(p.ws + OFF_AFFC))[(size_t)(b * 16 + lane) * CTXL + t] = mine / den; }
    }
}

__device__ __forceinline__ void ph_norm0(const P& p) {
    const int tix = otid();
    const float* modv = (const float*)(p.ws + OFF_MODV); bf16* hout = (bf16*)(p.ws + OFF_H);
    const float4* g4 = (const float4*)p.in[I_NMIX];
    const int lane = tix & 63, wave = tix >> 6, stride = gridDim.x * 8;
    for (int rb = blockIdx.x * 8 + wave; rb < NT; rb += 4 * stride) {
        float4 v[4][4]; float ss[4];
#pragma unroll
        for (int q = 0; q < 4; ++q) { const int r = min(rb + q * stride, NT - 1); const float4* xr = (const float4*)in_row(p, r);
#pragma unroll
            for (int j = 0; j < 4; ++j) v[q][j] = xr[lane + 64 * j]; }
#pragma unroll
        for (int q = 0; q < 4; ++q) { float s = 0.f;
#pragma unroll
            for (int j = 0; j < 4; ++j) s += v[q][j].x * v[q][j].x + v[q][j].y * v[q][j].y + v[q][j].z * v[q][j].z + v[q][j].w * v[q][j].w;
            ss[q] = s; }
#pragma unroll
        for (int o = 1; o < 64; o <<= 1) {
#pragma unroll
            for (int q = 0; q < 4; ++q) ss[q] += __shfl_xor(ss[q], o); }
#pragma unroll
        for (int q = 0; q < 4; ++q) {
            const int r = rb + q * stride;
            if (r < NT) {
                const float rstd = 1.f / sqrtf(ss[q] * (1.f / D) + EPS);
                const float* mv = modv + (size_t)mod_row(r) * 6144;
#pragma unroll
                for (int j = 0; j < 4; ++j) {
                    const float4 g = g4[lane + 64 * j], sh = ((const float4*)mv)[lane + 64 * j], sc = ((const float4*)(mv + 1024))[lane + 64 * j];
                    uint2 o; o.x = pk2(v[q][j].x * rstd * g.x * (1.f + sc.x) + sh.x, v[q][j].y * rstd * g.y * (1.f + sc.y) + sh.y);
                    o.y = pk2(v[q][j].z * rstd * g.z * (1.f + sc.z) + sh.z, v[q][j].w * rstd * g.w * (1.f + sc.w) + sh.w);
                    *(uint2*)(hout + (size_t)r * D + (lane + 64 * j) * 4) = o;
                }
            }
        }
    }
}

#define LDSP ((__attribute__((address_space(3))) unsigned char*)lds)
__device__ __forceinline__ pg8::Sched mk_sched(int ng, int M, int N) { pg8::Sched S{}; S.ng = ng; S.nM = M / 256; S.nN = N / 256; S.nwg = ng * S.nM * S.nN; S.G = gridDim.x; S.c = blockIdx.x; return S; }
__device__ __forceinline__ void tail_convert(const P& p, const pg8::Sched& S, unsigned char* lds, const int it0, const int it1) {
    const int R = (S.nwg + S.G - 1) / S.G, T = S.nwg - (R - 1) * S.G;
    if (S.c >= T) ph_convert_moe_range(p, 1, (float*)lds, it0, it1, (S.c - T) * 8, (S.G - T) * 8);
}
constexpr int CVT_Q1 = 1344, CVT_Q2 = CVT_Q1 + 7168, CVT_Q3 = CVT_Q2 + 640, CVT_Q4 = CVT_Q3 + 1536, CVT_Q5 = CVT_Q4 + 4608;
__device__ __forceinline__ void fg_inproj_even(const P& p, unsigned char* lds) {
    pg8::Sched S = mk_sched(1, NT, EVIN);
    S.Abase = p.ws + OFF_H; S.a_tstride = (size_t)256 * D * 2; S.Bbase = p.ws + OFF_WT_EVIN; S.b_tstride = (size_t)256 * D * 2;
    pg8::EpiStoreBf16 E{(bf16*)(p.ws + OFF_PROJ), EVIN, 0, 1.f};
    pg8::gemm_phase<pg8::EpiStoreBf16, false>(LDSP, D * 2, S, E);
    tail_convert(p, S, lds, 0, CVT_Q1);
}
__device__ __forceinline__ void fg_outproj(const P& p, int l, bool first, size_t off_wt, int M, unsigned char* lds) {
    pg8::Sched S = mk_sched(1, M, D);
    S.Abase = p.ws + OFF_MIX; S.a_tstride = (size_t)256 * D * 2; S.Bbase = p.ws + off_wt; S.b_tstride = (size_t)256 * D * 2;
    pg8::EpiResid E{p.in[I_X], p.in[I_CTX], (bf16*)(p.ws + OFF_XRES), (const float*)(p.ws + OFF_MODV) + (size_t)l * 9 * 6144, first};
    pg8::gemm_phase<pg8::EpiResid, false>(LDSP, D * 2, S, E);
    if (l == 0) tail_convert(p, S, lds, CVT_Q1, CVT_Q2);
}
__device__ __forceinline__ void fg_inproj_odd(const P& p, unsigned char* lds) {
    pg8::Sched S = mk_sched(1, NT, 2048);
    S.Abase = p.ws + OFF_H1; S.a_tstride = (size_t)256 * D * 2; S.Bbase = p.ws + OFF_WT_ODIN; S.b_tstride = (size_t)256 * D * 2;
    pg8::EpiSplitBf16 E{(bf16*)(p.ws + OFF_MIX), (bf16*)(p.ws + OFF_H)};
    pg8::gemm_phase<pg8::EpiSplitBf16, false>(LDSP, D * 2, S, E);
    tail_convert(p, S, lds, CVT_Q4, CVT_Q5);
}
__device__ __forceinline__ void fg_moe_up(const P& p, int l, int Me, unsigned char* lds) {
    pg8::Sched S = mk_sched(NE, Me, 2816);
    S.Abase = p.ws + OFF_H; S.rowidx = (const int*)(p.ws + OFF_ROWL); S.idx_gstride = ME;
    S.Bbase = p.ws + (l ? OFF_WGU1 : OFF_WGU); S.b_gstride = WGU_E; S.b_tstride = (size_t)256 * D;
    pg8::EpiSwiGLU8 E{(unsigned char*)(p.ws + OFF_HID)};
    pg8::gemm_phase<pg8::EpiSwiGLU8, true, true>(LDSP, D, S, E);
    if (l == 0) tail_convert(p, S, lds, CVT_Q2, CVT_Q3);
}
__device__ __forceinline__ void fg_moe_down(const P& p, int l, int Me, unsigned char* lds) {
    pg8::Sched S = mk_sched(NE, Me, D);
    S.Abase = p.ws + OFF_HID; S.a_gstride = (size_t)ME * pg8::FFP; S.a_tstride = (size_t)256 * pg8::FFP;
    S.Bbase = p.ws + (l ? OFF_WDN1 : OFF_WDN); S.b_gstride = WDN_E; S.b_tstride = (size_t)256 * pg8::FFP;
    pg8::EpiStoreFp8 E{(unsigned char*)(p.ws + OFF_Y), D, (size_t)ME * D, Y8_SCALE / (pg8::W8_SCALE * pg8::HID8_SCALE)};
    pg8::gemm_phase<pg8::EpiStoreFp8, false, true>(LDSP, pg8::FFP, S, E);
    if (l == 0) tail_convert(p, S, lds, CVT_Q3, CVT_Q4);
}

constexpr int LDS_BYTES = 131072 + 4096;
constexpr size_t OFF_BAR = 640 * MiB;
__global__ void __launch_bounds__(512) k_all(P p) {
    cooperative_groups::grid_group grid = cooperative_groups::this_grid();
    extern __shared__ __attribute__((aligned(16))) unsigned char lds[];
    float* sm = (float*)lds;
    volatile LAS unsigned* st = (volatile LAS unsigned*)((LAS unsigned char*)lds + 131072 + 64);
    if (threadIdx.x < 4) st[threadIdx.x] = 0u;
    __syncthreads();
    XcdBarrier bar = xcd_barrier_post((unsigned*)(p.ws + OFF_BAR), st);
#define GSYNC() xcd_barrier(bar)
    ph_mod(p, sm); __syncthreads(); ph_convert_other(p, sm); ph_convert_gates(p, sm); ph_convert_moe(p, 0, sm); GSYNC();
    if (gridDim.x == 0x7fffffffu) grid.sync();
    ph_norm0(p); GSYNC();
    fg_inproj_even(p, lds); GSYNC();
    ph_prep_attn(p, sm); ph_conv3v(p); GSYNC();
    ph_attn_mfma(p, lds); GSYNC();
    fg_outproj(p, 0, true, OFF_WT_EVOUT, NT, lds); GSYNC();
    ph_normF(p, 0, true, sm); ph_normF_ctx(p, 0); GSYNC();
    ph_topk(p, true, sm); GSYNC();
    fg_moe_up(p, 0, ME, lds); GSYNC();
    fg_moe_down(p, 0, ME, lds); GSYNC();
    ph_combine(p, 0, false, NT); GSYNC();
    fg_inproj_odd(p, lds); GSYNC();
    ph_conv4v(p); GSYNC();
    ph_lru(p, sm); GSYNC();
    ph_lru_out(p); GSYNC();
    fg_outproj(p, 1, false, OFF_WT_ODOUT, NL, lds); GSYNC();
    ph_normF(p, 1, false, sm); GSYNC();
    ph_topk(p, false, sm); __syncthreads(); ph_convert_moe(p, 1, sm, CVT_Q5); GSYNC();
    fg_moe_up(p, 1, NB * CAPL, lds); GSYNC();
    fg_moe_down(p, 1, NB * CAPL, lds); GSYNC();
    ph_combine(p, 1, true, NL);
}
}

extern "C" void kernel_launch(void* const* d_in, const int* in_sizes, int n_in, void* d_out, int out_size, void* d_ws, size_t ws_size, hipStream_t stream) {
    if (n_in != N_IN || ws_size < 644 * MiB) { fprintf(stderr, "kernel_launch: unexpected n_in %d or ws_size %zu\n", n_in, ws_size); return; }
    static int grid_blocks = 0;
    if (!grid_blocks) {
        int dev = 0, cus = 0, per_cu = 0;
        (void)hipGetDevice(&dev);
        (void)hipDeviceGetAttribute(&cus, hipDeviceAttributeMultiprocessorCount, dev);
        (void)hipFuncSetAttribute((const void*)k_all, hipFuncAttributeMaxDynamicSharedMemorySize, LDS_BYTES);
        (void)hipOccupancyMaxActiveBlocksPerMultiprocessor(&per_cu, k_all, 512, LDS_BYTES);
        if (per_cu < 1) per_cu = 1;
        grid_blocks = cus * per_cu;
        fprintf(stderr, "kernel_launch: cus %d per_cu %d grid %d ws %zu\n", cus, per_cu, grid_blocks, ws_size);
    }
    P p{};
    for (int i = 0; i < N_IN; ++i) p.in[i] = (const float*)d_in[i];
    p.out = (float*)d_out; p.ws = (char*)d_ws;
    (void)hipMemsetAsync((char*)d_ws + OFF_BAR, 0, 16384, stream);
    void* args[] = {&p};
    hipError_t e = hipLaunchCooperativeKernel((void*)k_all, dim3(grid_blocks), dim3(512), args, LDS_BYTES, stream);
    if (e != hipSuccess) fprintf(stderr, "cooperative launch failed: %s (grid %d)\n", hipGetErrorString(e), grid_blocks);
}
```

```cpp
#include <hip/hip_runtime.h>
#include <hip/hip_cooperative_groups.h>
#include <cstdio>
#include <cstdint>

namespace {
typedef unsigned short bf16;
constexpr int D = 1024, NB = 8, SEQ = 4096, CTXL = 256;
constexpr int NL = NB * SEQ, NC = NB * CTXL, NT = NL + NC;
constexpr int NE = 16, FF = 1408, CAPL = 512, CAPC = 32;
constexpr int ME = NB * CAPL + NB * CAPC;
constexpr int EVIN = 2304;
constexpr float EPS = 1e-6f;
constexpr float MIX8_SCALE = 4.f;
constexpr float Y8_SCALE = 16.f;

enum { I_X = 0, I_C, I_CTX, I_CCTX, I_ADAW, I_ADAB, I_NMIX, I_NFFN, I_EVWIN, I_EVWOUT, I_EVSINK, I_EVCW, I_EVCB,
       I_ODWIN, I_ODWOUT, I_ODCW, I_ODCB, I_ODWA, I_ODBA, I_ODWX, I_ODBX, I_ODLAM, I_RW, I_WG, I_WU, I_WD, I_FG, N_IN };

constexpr size_t MiB = 1u << 20;
constexpr size_t OFF_MODV = 0;
constexpr size_t OFF_ROPE = 512 * 1024;
constexpr size_t OFF_AFFL = 1 * MiB;
constexpr size_t OFF_AFFC = 3 * MiB;
constexpr size_t OFF_ROWL = 4 * MiB;
constexpr size_t OFF_GATEV = 5 * MiB;
constexpr size_t OFF_SLOT = 6 * MiB;
constexpr size_t OFF_VTL = 8 * MiB + 512 * 1024;
constexpr size_t OFF_KFL = 624 * MiB;
constexpr size_t OFF_KFC = 632 * MiB;
constexpr size_t OFF_WT_GATES = 30 * MiB;
constexpr size_t OFF_VTC = 31 * MiB;
constexpr size_t OFF_XRES = 32 * MiB;
constexpr size_t OFF_H = 168 * MiB;
constexpr size_t OFF_MIX = 236 * MiB;
constexpr size_t OFF_XE = OFF_MIX;
constexpr size_t OFF_Y = OFF_H;
constexpr size_t OFF_PROJ = 304 * MiB;
constexpr size_t OFF_HID = OFF_PROJ;
constexpr size_t OFF_H1 = OFF_PROJ;
constexpr size_t OFF_UC = OFF_PROJ;
constexpr size_t OFF_HF = 372 * MiB;
constexpr size_t OFF_HB = 304 * MiB;
constexpr size_t OFF_Z = 372 * MiB;

struct P { const float* in[N_IN]; float* out; char* ws; };

__device__ __forceinline__ float bf2f(unsigned v) { return __uint_as_float(v << 16); }
__device__ __forceinline__ unsigned f2bf(float f) { unsigned u = __float_as_uint(f); return (u + 0x7fffu + ((u >> 16) & 1u)) >> 16; }
__device__ __forceinline__ unsigned pk2(float lo, float hi) { unsigned r; asm("v_cvt_pk_bf16_f32 %0, %1, %2" : "=v"(r) : "v"(lo), "v"(hi)); return r; }
__device__ __forceinline__ float wave_sum(float v) {
#pragma unroll
    for (int o = 1; o < 64; o <<= 1) v += __shfl_xor(v, o);
    return v;
}
__device__ __forceinline__ float wave_max(float v) {
#pragma unroll
    for (int o = 1; o < 64; o <<= 1) v = fmaxf(v, __shfl_xor(v, o));
    return v;
}
__device__ __forceinline__ int otid() { int t = threadIdx.x; asm volatile("" : "+v"(t)); return t; }
__device__ __forceinline__ int mod_row(int r) { return r < NL ? (r >> 12) : 8; }
__device__ __forceinline__ const float* in_row(const P& p, int r) { return r < NL ? p.in[I_X] + (size_t)r * D : p.in[I_CTX] + (size_t)(r - NL) * D; }

__device__ __forceinline__ void ph_mod(const P& p, float* sm) {
    const int tix = otid();
    float* modv = (float*)(p.ws + OFF_MODV);
    float* red = sm + 9216;
    if (blockIdx.x < 192) {
        for (int i = tix; i < 9 * 1024; i += blockDim.x) {
            int r = i >> 10, k = i & 1023; float v = (r < 8) ? p.in[I_C][r * 1024 + k] : p.in[I_CCTX][k];
            sm[i] = v / (1.f + expf(-v));
        }
        __syncthreads();
    }
    for (int item = blockIdx.x; item < 192; item += gridDim.x) {
        const int l = item / 96, j0 = (item % 96) * 64, kc = tix >> 6, col = tix & 63;
        const float* w = p.in[I_ADAW] + (size_t)l * 1024 * 6144 + (size_t)(kc * 128) * 6144 + j0 + col;
        const float* sv = sm + kc * 128;
        float acc[9];
#pragma unroll
        for (int r = 0; r < 9; ++r) acc[r] = 0.f;
#pragma unroll 16
        for (int k = 0; k < 128; ++k) {
            const float wv = w[(size_t)k * 6144];
#pragma unroll
            for (int r = 0; r < 9; ++r) acc[r] += sv[r * 1024 + k] * wv;
        }
#pragma unroll
        for (int r = 0; r < 9; ++r) red[(r * 8 + kc) * 64 + col] = acc[r];
        __syncthreads();
        for (int i = tix; i < 576; i += blockDim.x) {
            const int r = i >> 6, c = i & 63; float s = 0.f;
#pragma unroll
            for (int q = 0; q < 8; ++q) s += red[(r * 8 + q) * 64 + c];
            modv[(l * 9 + r) * 6144 + j0 + c] = s + p.in[I_ADAB][l * 6144 + j0 + c];
        }
        __syncthreads();
    }
    if (blockIdx.x == gridDim.x - 1) {
        float* tab = (float*)(p.ws + OFF_ROPE);
        for (int i = tix; i < 1024; i += blockDim.x) {
            const int pos = i >> 4, f = i & 15;
            const float inv = powf(10000.f, -(float)f / 16.f);
            const float ang = (float)pos * inv;
            tab[i * 2] = cosf(ang); tab[i * 2 + 1] = sinf(ang);
        }
    }
}


__device__ __forceinline__ void ph_topk(const P& p, bool with_ctx, float* sm) {
    const int tix = otid();
    int* rowl = (int*)(p.ws + OFF_ROWL); float* gatev = (float*)(p.ws + OFF_GATEV); int* slot = (int*)(p.ws + OFF_SLOT);
    int* hist = (int*)sm; int* misc = hist + 256; int* wtot = hist + 272;
    const int lane = tix & 63, wave = tix >> 6;
    const int nitems = with_ctx ? 256 : 128;
    for (int it = blockIdx.x; it < nitems; it += gridDim.x) {
        const bool isc = it >= 128; const int be = it & 127, b = be >> 4, e = be & 15;
        const int n = isc ? CTXL : SEQ, cap = isc ? CAPC : CAPL;
        const float* aff = isc ? (const float*)(p.ws + OFF_AFFC) + (size_t)be * CTXL : (const float*)(p.ws + OFF_AFFL) + (size_t)be * SEQ;
        const bool have = tix * 8 < n;
        unsigned u[8];
        { float4 a = make_float4(0.f, 0.f, 0.f, 0.f), c = a; if (have) { a = *(const float4*)(aff + tix * 8); c = *(const float4*)(aff + tix * 8 + 4); }
          u[0] = __float_as_uint(a.x); u[1] = __float_as_uint(a.y); u[2] = __float_as_uint(a.z); u[3] = __float_as_uint(a.w);
          u[4] = __float_as_uint(c.x); u[5] = __float_as_uint(c.y); u[6] = __float_as_uint(c.z); u[7] = __float_as_uint(c.w); }
        unsigned prefix = 0u, pmask = 0u; int kk = cap;
#pragma unroll 1
        for (int shift = 24; shift >= 0; shift -= 8) {
            __syncthreads();
            if (tix < 256) hist[tix] = 0;
            __syncthreads();
            if (have) {
#pragma unroll
                for (int j = 0; j < 8; ++j) if ((u[j] & pmask) == prefix) atomicAdd(&hist[(u[j] >> shift) & 255u], 1);
            }
            __syncthreads();
            if (wave == 0) {
                const int h0 = hist[4 * lane], h1 = hist[4 * lane + 1], h2 = hist[4 * lane + 2], h3 = hist[4 * lane + 3];
                int tot = h0 + h1 + h2 + h3, suf = tot;
#pragma unroll
                for (int o = 1; o < 64; o <<= 1) { const int t = __shfl_down(suf, o); if (lane + o < 64) suf += t; }
                const int above = suf - tot;
                const int a3 = above, a2 = above + h3, a1 = a2 + h2, a0 = a1 + h1;
                int dsel = -1, kn = 0;
                if (a3 < kk && kk <= a3 + h3) { dsel = 4 * lane + 3; kn = kk - a3; }
                else if (a2 < kk && kk <= a2 + h2) { dsel = 4 * lane + 2; kn = kk - a2; }
                else if (a1 < kk && kk <= a1 + h1) { dsel = 4 * lane + 1; kn = kk - a1; }
                else if (a0 < kk && kk <= a0 + h0) { dsel = 4 * lane; kn = kk - a0; }
                if (dsel >= 0) { misc[0] = dsel; misc[1] = kn; }
            }
            __syncthreads();
            prefix |= (unsigned)misc[0] << shift; pmask |= 255u << shift; kk = misc[1];
        }
        int cg = 0, ce = 0;
        if (have) {
#pragma unroll
            for (int j = 0; j < 8; ++j) { cg += u[j] > prefix ? 1 : 0; ce += u[j] == prefix ? 1 : 0; }
        }
        int packed = cg | (ce << 16), inc = packed;
#pragma unroll
        for (int o = 1; o < 64; o <<= 1) { const int t = __shfl_up(inc, o); if (lane >= o) inc += t; }
        if (lane == 63) wtot[wave] = inc;
        __syncthreads();
        int before = inc - packed;
#pragma unroll
        for (int w = 0; w < 8; ++w) if (w < wave) before += wtot[w];
        int gb = before & 0xffff, eb = before >> 16;
        const int base = isc ? (NB * CAPL + b * CAPC) : b * CAPL;
        const int rowbase = isc ? (NL + b * CTXL) : b * SEQ;
        if (have) {
#pragma unroll
            for (int j = 0; j < 8; ++j) {
                const bool g = u[j] > prefix, q = u[j] == prefix, sel = g || (q && eb < kk);
                const int row = rowbase + tix * 8 + j;
                if (sel) { const int pos = base + gb + min(eb, kk); rowl[e * ME + pos] = row; gatev[e * ME + pos] = __uint_as_float(u[j]); slot[(size_t)e * NT + row] = pos; }
                else slot[(size_t)e * NT + row] = -1;
                gb += g ? 1 : 0; eb += q ? 1 : 0;
            }
        }
    }
}
__device__ __forceinline__ void ph_combine(const P& p, int l, bool last, int nrows) {
    const int tix = otid();
    const float* modv = (const float*)(p.ws + OFF_MODV); bf16* xres = (bf16*)(p.ws + OFF_XRES);
    const unsigned char* Y = (const unsigned char*)(p.ws + OFF_Y); const float* gatev = (const float*)(p.ws + OFF_GATEV); const int* slot = (const int*)(p.ws + OFF_SLOT);
    bf16* H1 = (bf16*)(p.ws + OFF_H1);
    const int lane = tix & 63, wave = tix >> 6;
    const int rstride = gridDim.x * 8;
    int r = blockIdx.x * 8 + wave;
    int s_l = (lane < NE && r < nrows) ? slot[(size_t)lane * NT + r] : -1;
    float g_l = s_l >= 0 ? gatev[lane * ME + s_l] : 0.f;
    for (; r < nrows; r += rstride) {
        float4 acc[4];
#pragma unroll
        for (int j = 0; j < 4; ++j) acc[j] = make_float4(0.f, 0.f, 0.f, 0.f);
        const int rn = r + rstride;
        const int s_n = (lane < NE && rn < nrows) ? slot[(size_t)lane * NT + rn] : -1;
        uint2* xr = (uint2*)(xres + (size_t)r * D);
        uint2 xwv[4];
#pragma unroll
        for (int j = 0; j < 4; ++j) xwv[j] = xr[lane + 64 * j];
        unsigned mask = (unsigned)(__ballot(s_l >= 0) & 0xFFFFull);
        while (mask) {
            unsigned yv[4][4]; float gq[4];
#pragma unroll
            for (int q = 0; q < 4; ++q) {
                int e = 0, s = 0; float g = 0.f;
                if (mask) { e = __builtin_ctz(mask); mask &= mask - 1; s = __builtin_amdgcn_readlane(s_l, e); g = __uint_as_float(__builtin_amdgcn_readlane(__float_as_uint(g_l), e)); }
                gq[q] = g * (1.f / Y8_SCALE);
                const unsigned* yr = (const unsigned*)(Y + ((size_t)e * ME + s) * D);
#pragma unroll
                for (int j = 0; j < 4; ++j) yv[q][j] = yr[lane + 64 * j];
            }
#pragma unroll
            for (int q = 0; q < 4; ++q)
#pragma unroll
                for (int j = 0; j < 4; ++j) { const unsigned w = yv[q][j]; const float g = gq[q];
                    typedef float v2f_ __attribute__((ext_vector_type(2)));
                    const v2f_ lo = __builtin_amdgcn_cvt_pk_f32_fp8((int)w, false), hi2 = __builtin_amdgcn_cvt_pk_f32_fp8((int)w, true);
                    acc[j].x += g * lo[0]; acc[j].y += g * lo[1]; acc[j].z += g * hi2[0]; acc[j].w += g * hi2[1]; }
        }
        const float g_n = s_n >= 0 ? gatev[lane * ME + s_n] : 0.f;
        const float* mv = modv + (size_t)(l * 9 + mod_row(r)) * 6144;
        float4 v[4]; float ss = 0.f;
#pragma unroll
        for (int j = 0; j < 4; ++j) {
            const uint2 xw = xwv[j]; float4 x; x.x = bf2f(xw.x & 0xffffu); x.y = bf2f(xw.x >> 16); x.z = bf2f(xw.y & 0xffffu); x.w = bf2f(xw.y >> 16);
            const float4 g5 = ((const float4*)(mv + 5 * 1024))[lane + 64 * j];
            v[j].x = x.x + g5.x * acc[j].x; v[j].y = x.y + g5.y * acc[j].y; v[j].z = x.z + g5.z * acc[j].z; v[j].w = x.w + g5.w * acc[j].w;
            ss += v[j].x * v[j].x + v[j].y * v[j].y + v[j].z * v[j].z + v[j].w * v[j].w;
        }
        ss = wave_sum(ss);
        const float rstd = 1.f / sqrtf(ss * (1.f / D) + EPS);
        if (last) {
            float4* o = (float4*)(p.out + (size_t)r * D); const float4* g4 = (const float4*)p.in[I_FG];
#pragma unroll
            for (int j = 0; j < 4; ++j) { const float4 g = g4[lane + 64 * j]; float4 w; w.x = v[j].x * rstd * g.x; w.y = v[j].y * rstd * g.y; w.z = v[j].z * rstd * g.z; w.w = v[j].w * rstd * g.w; o[lane + 64 * j] = w; }
        } else {
            const float* mv1 = modv + (size_t)((l + 1) * 9 + mod_row(r)) * 6144;
            const float4* g4 = (const float4*)(p.in[I_NMIX] + (l + 1) * 1024);
#pragma unroll
            for (int j = 0; j < 4; ++j) {
                { uint2 xo; xo.x = pk2(v[j].x, v[j].y); xo.y = pk2(v[j].z, v[j].w); xr[lane + 64 * j] = xo; }
                const float4 g = g4[lane + 64 * j], sh = ((const float4*)mv1)[lane + 64 * j], sc = ((const float4*)(mv1 + 1024))[lane + 64 * j];
                uint2 o; o.x = pk2(v[j].x * rstd * g.x * (1.f + sc.x) + sh.x, v[j].y * rstd * g.y * (1.f + sc.y) + sh.y);
                o.y = pk2(v[j].z * rstd * g.z * (1.f + sc.z) + sh.z, v[j].w * rstd * g.w * (1.f + sc.w) + sh.w);
                *(uint2*)(H1 + (size_t)r * D + (lane + 64 * j) * 4) = o;
            }
        }
        s_l = s_n; g_l = g_n;
    }
}
__device__ __forceinline__ float gelu_tanh(float x) {
    const float u = 0.7978845608028654f * (x + 0.044715f * x * x * x);
    return x * __builtin_amdgcn_rcpf(1.f + __builtin_amdgcn_exp2f(-2.f * 1.4426950408889634f * u)); }

__device__ __forceinline__ void unpack8(const uint4& v, float* f) {
    f[0] = bf2f(v.x & 0xffffu); f[1] = bf2f(v.x >> 16); f[2] = bf2f(v.y & 0xffffu); f[3] = bf2f(v.y >> 16);
    f[4] = bf2f(v.z & 0xffffu); f[5] = bf2f(v.z >> 16); f[6] = bf2f(v.w & 0xffffu); f[7] = bf2f(v.w >> 16);
}
__device__ __forceinline__ uint4 pack8(const float* f) { uint4 o; o.x = pk2(f[0], f[1]); o.y = pk2(f[2], f[3]); o.z = pk2(f[4], f[5]); o.w = pk2(f[6], f[7]); return o; }
__device__ __forceinline__ void ph_prep_attn(const P& p, float* sm) {
    const int tix = otid();
    bf16* PROJ = (bf16*)(p.ws + OFF_PROJ); const float* tab = (const float*)(p.ws + OFF_ROPE);
    bf16* KFL = (bf16*)(p.ws + OFF_KFL); bf16* KFC = (bf16*)(p.ws + OFF_KFC);
    const int total = NL * 40, stride_ = gridDim.x * blockDim.x;
    for (int i0 = blockIdx.x * blockDim.x + tix; i0 < total; i0 += 4 * stride_) {
        uint4 av[4], bv[4]; float4 csv[4][4]; bf16* basev[4]; bool okv[4];
#pragma unroll
        for (int q = 0; q < 4; ++q) {
            const int i = min(i0 + q * stride_, total - 1); okv[q] = i0 + q * stride_ < total;
            const int r = i / 40, rem = i % 40, hh = rem >> 2, part = (rem >> 1) & 1, hf = rem & 1, t = r & 4095;
            const int pos = part == 0 ? (t >> 6) : (t & 63);
            basev[q] = PROJ + (size_t)r * EVIN + (hh < 8 ? hh * 64 : 512 + (hh - 8) * 64) + part * 32 + hf * 8;
            av[q] = *(const uint4*)basev[q]; bv[q] = *(const uint4*)(basev[q] + 16);
            const float4* cs = (const float4*)(tab + (size_t)(pos * 16 + hf * 8) * 2);
#pragma unroll
            for (int z = 0; z < 4; ++z) csv[q][z] = cs[z];
        }
#pragma unroll
        for (int q = 0; q < 4; ++q) {
            const int i = min(i0 + q * stride_, total - 1);
            const int r = i / 40, rem = i % 40, hh = rem >> 2, part = (rem >> 1) & 1, hf = rem & 1, t = r & 4095;
            float x1[8], x2[8], o1[8], o2[8]; unpack8(av[q], x1); unpack8(bv[q], x2);
#pragma unroll
            for (int z = 0; z < 4; ++z) { const float4 w = csv[q][z];
                o1[2 * z] = x1[2 * z] * w.x - x2[2 * z] * w.y; o2[2 * z] = x2[2 * z] * w.x + x1[2 * z] * w.y;
                o1[2 * z + 1] = x1[2 * z + 1] * w.z - x2[2 * z + 1] * w.w; o2[2 * z + 1] = x2[2 * z + 1] * w.z + x1[2 * z + 1] * w.w; }
            if (okv[q]) {
                if (hh < 8) { *(uint4*)basev[q] = pack8(o1); *(uint4*)(basev[q] + 16) = pack8(o2); }
                else {
                    const int b = r >> 12, hk = hh - 8;
                    bf16* kf = KFL + ((((size_t)(b * 2 + hk) * 128 + (t >> 5)) * 4 + 2 * part) * 64 + hf * 32 + (t & 31)) * 8;
                    *(uint4*)kf = pack8(o1); *(uint4*)(kf + 512) = pack8(o2);
                }
            }
        }
    }
    for (int i = blockIdx.x * blockDim.x + tix; i < NC * 16; i += gridDim.x * blockDim.x) {
        const int rc = i >> 4, hk = (i >> 3) & 1, s = (i >> 1) & 3, hf = i & 1, b = rc >> 8, t = rc & 255;
        const uint4 v = *(const uint4*)(PROJ + (size_t)(NL + rc) * EVIN + 512 + hk * 64 + 16 * s + 8 * hf);
        *(uint4*)(KFC + ((((size_t)(b * 2 + hk) * 8 + (t >> 5)) * 4 + s) * 64 + hf * 32 + (t & 31)) * 8) = v;
    }
    bf16* tile = (bf16*)sm;
#define PV_SRC(it_) ((it_) < 1024 ? ((it_) >> 7) * SEQ + ((it_) & 63) * 64 : NL + (((it_) - 1024) >> 3) * CTXL + (((it_) - 1024) & 3) * 64)
#define PV_HK(it_) ((it_) < 1024 ? ((it_) >> 6) & 1 : (((it_) - 1024) >> 2) & 1)
    const int vtok = tix >> 3, vc = tix & 7;
    int it = blockIdx.x;
    uint4 cur = make_uint4(0u, 0u, 0u, 0u);
    if (it < 1024 + 64) cur = *(const uint4*)(PROJ + (size_t)(PV_SRC(it) + vtok) * EVIN + 640 + PV_HK(it) * 64 + 8 * vc);
    for (; it < 1024 + 64; it += gridDim.x) {
        int b, hk, t0; bf16* vf;
        if (it < 1024) { b = it >> 7; hk = (it >> 6) & 1; t0 = (it & 63) * 64; vf = (bf16*)(p.ws + OFF_VTL) + (size_t)(b * 2 + hk) * 128 * 2048; }
        else { const int j = it - 1024; b = j >> 3; hk = (j >> 2) & 1; t0 = (j & 3) * 64; vf = (bf16*)(p.ws + OFF_VTC) + (size_t)(b * 2 + hk) * 8 * 2048; }
        __syncthreads();
        *(uint4*)(tile + vtok * 72 + 8 * vc) = cur;
        const int nit = it + gridDim.x;
        if (nit < 1024 + 64) cur = *(const uint4*)(PROJ + (size_t)(PV_SRC(nit) + vtok) * EVIN + 640 + PV_HK(nit) * 64 + 8 * vc);
        __syncthreads();
        {
            const int frag = tix >> 6, ln = tix & 63, T = frag >> 2, dt = (frag >> 1) & 1, s = frag & 1, rr = ln & 31, hi = ln >> 5;
            unsigned w[4];
#pragma unroll
            for (int jj = 0; jj < 4; ++jj) {
                const int j0 = 2 * jj, j1 = 2 * jj + 1;
                const unsigned lo = tile[(32 * T + 16 * s + 8 * (j0 >> 2) + 4 * hi + (j0 & 3)) * 72 + 32 * dt + rr];
                const unsigned hi16 = tile[(32 * T + 16 * s + 8 * (j1 >> 2) + 4 * hi + (j1 & 3)) * 72 + 32 * dt + rr];
                w[jj] = lo | (hi16 << 16);
            }
            uint4 o; o.x = w[0]; o.y = w[1]; o.z = w[2]; o.w = w[3];
            *(uint4*)(vf + ((((size_t)((t0 >> 5) + T) * 2 + dt) * 2 + s) * 64 + ln) * 8) = o;
        }
    }
#undef PV_SRC
#undef PV_HK
}
typedef short abf16x8 __attribute__((ext_vector_type(8)));
typedef short abf16x4 __attribute__((ext_vector_type(4)));
typedef float af32x16 __attribute__((ext_vector_type(16)));
__device__ __forceinline__ unsigned cvtpk(float lo, float hi) { unsigned r; asm volatile("v_cvt_pk_bf16_f32 %0, %1, %2" : "=v"(r) : "v"(lo), "v"(hi)); return r; }
__device__ __forceinline__ unsigned pk_fp8x4(float a, float b, float c, float d) {
    int w = __builtin_amdgcn_cvt_pk_fp8_f32(__builtin_amdgcn_fmed3f(a, -448.f, 448.f), __builtin_amdgcn_fmed3f(b, -448.f, 448.f), 0, false);
    w = __builtin_amdgcn_cvt_pk_fp8_f32(__builtin_amdgcn_fmed3f(c, -448.f, 448.f), __builtin_amdgcn_fmed3f(d, -448.f, 448.f), w, true);
    return (unsigned)w; }
struct AttnK { abf16x8 k[8]; };
struct AttnV { abf16x8 v[8]; };
__device__ __forceinline__ void attn_load_k(AttnK& f, const char* ub, const unsigned vo) {
#pragma unroll
    for (int s = 0; s < 4; ++s) { f.k[2 * s] = *(const abf16x8*)(ub + vo + s * 1024); f.k[2 * s + 1] = *(const abf16x8*)(ub + vo + (4 + s) * 1024); }
}
__device__ __forceinline__ void attn_load_v(AttnV& f, const char* ub, const unsigned vo) {
#pragma unroll
    for (int dt = 0; dt < 2; ++dt)
#pragma unroll
        for (int T = 0; T < 2; ++T)
#pragma unroll
            for (int s = 0; s < 2; ++s) f.v[(dt * 2 + T) * 2 + s] = *(const abf16x8*)(ub + vo + ((T * 2 + dt) * 2 + s) * 1024);
}
__device__ __forceinline__ void attn_tile(AttnK& f, AttnV& fv, const bool has_next, const char* nkp, const char* nvp, const unsigned vo, const abf16x8* ql, const bool partial, const int kq0  , const int kmax  ,
                                          const int hi, float& m, float& l, af32x16& o0, af32x16& o1) {
    const float CS = 0.125f * 1.4426950408889634f;
    const int kqh = kq0 + 4 * hi;
    af32x16 s0, s1;
#pragma unroll
    for (int i = 0; i < 16; ++i) { s0[i] = 0.f; s1[i] = 0.f; }
    abf16x8 qf[4];
#pragma unroll
    for (int s = 0; s < 4; ++s) qf[s] = ql[s * 64];
#pragma unroll
    for (int s = 0; s < 4; ++s) {
        s0 = __builtin_amdgcn_mfma_f32_32x32x16_bf16(f.k[2 * s], qf[s], s0, 0, 0, 0);
        s1 = __builtin_amdgcn_mfma_f32_32x32x16_bf16(f.k[2 * s + 1], qf[s], s1, 0, 0, 0);
    }
    if (has_next) attn_load_k(f, nkp, vo);
    float tmax = -1e30f;
    if (partial) {
        asm volatile("" ::: "memory");
#pragma unroll
        for (int i = 0; i < 16; ++i) {
            const int c = (i & 3) + 8 * (i >> 2);
            if (kqh > 128 - c || kqh < -128 - c) s0[i] = -1e30f;
            if (kqh > 96 - c || kqh < -160 - c) s1[i] = -1e30f;
        }
    }
#pragma unroll
    for (int i = 0; i < 16; ++i) asm("v_max3_f32 %0, %0, %1, %2" : "+v"(tmax) : "v"(s0[i]), "v"(s1[i]));
    tmax = fmaxf(tmax, __shfl_xor(tmax, 32));
    const float mn = fmaxf(m, tmax * CS), alpha = __builtin_amdgcn_exp2f(m - mn), nmn = -mn; m = mn;
    float sum = 0.f;
#pragma unroll
    for (int i = 0; i < 16; ++i) { s0[i] = __builtin_amdgcn_exp2f(__builtin_fmaf(s0[i], CS, nmn)); s1[i] = __builtin_amdgcn_exp2f(__builtin_fmaf(s1[i], CS, nmn)); sum += s0[i] + s1[i]; }
    l = l * alpha + sum;
    if (__builtin_amdgcn_ballot_w64(alpha != 1.f) != 0ull) {
#pragma unroll
        for (int i = 0; i < 16; ++i) { float t0 = o0[i] * alpha, t1 = o1[i] * alpha; asm("" : "+v"(t0), "+v"(t1)); o0[i] = t0; o1[i] = t1; }
    }
    typedef unsigned u32x4_ __attribute__((ext_vector_type(4)));
    abf16x8 pf[2][2];
#pragma unroll
    for (int s = 0; s < 2; ++s) {
        u32x4_ w0, w1;
        w0.x = cvtpk(s0[8 * s + 0], s0[8 * s + 1]); w0.y = cvtpk(s0[8 * s + 2], s0[8 * s + 3]); w0.z = cvtpk(s0[8 * s + 4], s0[8 * s + 5]); w0.w = cvtpk(s0[8 * s + 6], s0[8 * s + 7]);
        w1.x = cvtpk(s1[8 * s + 0], s1[8 * s + 1]); w1.y = cvtpk(s1[8 * s + 2], s1[8 * s + 3]); w1.z = cvtpk(s1[8 * s + 4], s1[8 * s + 5]); w1.w = cvtpk(s1[8 * s + 6], s1[8 * s + 7]);
        pf[0][s] = __builtin_bit_cast(abf16x8, w0); pf[1][s] = __builtin_bit_cast(abf16x8, w1);
    }
#pragma unroll
    for (int T = 0; T < 2; ++T)
#pragma unroll
        for (int s = 0; s < 2; ++s) {
            o0 = __builtin_amdgcn_mfma_f32_32x32x16_bf16(fv.v[(0 * 2 + T) * 2 + s], pf[T][s], o0, 0, 0, 0);
            o1 = __builtin_amdgcn_mfma_f32_32x32x16_bf16(fv.v[(1 * 2 + T) * 2 + s], pf[T][s], o1, 0, 0, 0);
        }
    if (has_next) attn_load_v(fv, nvp, vo);
}
__device__ __forceinline__ void ph_attn_mfma(const P& p, unsigned char* lds) {
    const bf16* PROJ = (const bf16*)(p.ws + OFF_PROJ); bf16* MIX = (bf16*)(p.ws + OFF_MIX);
    const bf16* VTL = (const bf16*)(p.ws + OFF_VTL); const bf16* VTC = (const bf16*)(p.ws + OFF_VTC);
    const bf16* KFL = (const bf16*)(p.ws + OFF_KFL); const bf16* KFC = (const bf16*)(p.ws + OFF_KFC);
    int tid_ = threadIdx.x; asm volatile("" : "+v"(tid_));
    const int lane = tid_ & 63, r = lane & 31, hi = lane >> 5, wave = __builtin_amdgcn_readfirstlane(tid_ >> 6);
    const int gw = blockIdx.x * 8 + wave, NGW = gridDim.x * 8;
    int task = gw; bool isctx = false;
    while (true) {
        if (!isctx && task >= 4096) { isctx = true; task = wave == 0 ? (int)blockIdx.x : (1 << 30); }
        if (isctx && task >= 256) break;
        int b, h, q0, rowq;
        if (!isctx) { h = task & 7; q0 = ((task >> 3) & 63) * 64; b = task >> 9; rowq = b * SEQ + q0; }
        else { h = task & 7; q0 = ((task >> 3) & 3) * 64; b = task >> 5; rowq = NL + b * CTXL + q0; }
        const int hk = h >> 2;
        const bf16* qp = PROJ + (size_t)(rowq + r) * EVIN + h * 64 + 8 * hi;
        {
            abf16x8* qw = (abf16x8*)(lds + wave * 8192) + lane;
#pragma unroll
            for (int s = 0; s < 4; ++s) { qw[s * 64] = *(const abf16x8*)(qp + 16 * s); qw[(4 + s) * 64] = *(const abf16x8*)(qp + (size_t)32 * EVIN + 16 * s); }
        }
        const float m0 = p.in[I_EVSINK][h] * 1.4426950408889634f;
        float ma = m0, mb = m0, la = hi ? 0.f : 1.f, lb = la;
        af32x16 oa0, oa1, ob0, ob1;
#pragma unroll
        for (int i = 0; i < 16; ++i) { oa0[i] = 0.f; oa1[i] = 0.f; ob0[i] = 0.f; ob1[i] = 0.f; }
        int kbeg = 0, nloc = 0;
        if (!isctx) { const int lo = max(0, q0 - 128), hik = min(SEQ - 1, q0 + 63 + 128); kbeg = lo & ~63; nloc = ((hik - kbeg) >> 6) + 1; }
        const int ntile = nloc + 4;
        const char* kloc = (const char*)(KFL + (size_t)(b * 2 + hk) * 128 * 2048);
        const char* vloc = (const char*)(VTL + (size_t)(b * 2 + hk) * 128 * 2048);
        const char* kctx = (const char*)(KFC + (size_t)(b * 2 + hk) * 8 * 2048);
        const char* vctx = (const char*)(VTC + (size_t)(b * 2 + hk) * 8 * 2048);
        const unsigned vo = lane * 16;
        AttnK ka; AttnV fv;
        {   const bool loc0 = nloc > 0; const size_t o0_ = loc0 ? (size_t)(kbeg >> 5) * 4096 : 0;
            attn_load_k(ka, (loc0 ? kloc : kctx) + o0_, vo); attn_load_v(fv, (loc0 ? vloc : vctx) + o0_, vo); }
        for (int ti = 0; ti < ntile; ++ti) {
            const int tn = ti + 1; const bool has_next = tn < ntile, nloc_ = tn < nloc;
            const size_t on_ = (size_t)(nloc_ ? ((kbeg >> 5) + 2 * tn) : 2 * (tn - nloc)) * 4096;
            const char* nkp = (nloc_ ? kloc : kctx) + on_; const char* nvp = (nloc_ ? vloc : vctx) + on_;
            unsigned qo_ = wave * 8192 + lane * 16; asm volatile("" : "+v"(qo_));
            const abf16x8* qa = (const abf16x8*)(lds + qo_); const abf16x8* qb = qa + 256;
            const bool loc_ = ti < nloc; const int k0_ = kbeg + 64 * ti;
            const bool pa_ = loc_ && !(k0_ >= q0 + 31 - 128 && k0_ + 63 <= q0 + 128 && k0_ + 63 < SEQ);
            const bool pb_ = loc_ && !(k0_ >= q0 + 63 - 128 && k0_ + 63 <= q0 + 32 + 128 && k0_ + 63 < SEQ);
            attn_tile(ka, fv, false, nkp, nvp, vo, qa, pa_, k0_ - q0 - r, SEQ - k0_, hi, ma, la, oa0, oa1);
            __builtin_amdgcn_sched_barrier(0);
            attn_tile(ka, fv, has_next, nkp, nvp, vo, qb, pb_, k0_ - q0 - 32 - r, SEQ - k0_, hi, mb, lb, ob0, ob1);
        }
        la += __shfl_xor(la, 32); lb += __shfl_xor(lb, 32);
        const float ia = 1.f / la, ib = 1.f / lb;
        {   unsigned char* ot = lds + 65536 + wave * 4608;
            unsigned char* ow = ot + r * 80 + 4 * hi;
            const unsigned char* orr = ot + (lane >> 2) * 80 + (lane & 3) * 16;
            unsigned char* og = (unsigned char*)MIX + (size_t)(rowq + (lane >> 2)) * D + h * 64 + (lane & 3) * 16;
            const float sa = ia * MIX8_SCALE, sb = ib * MIX8_SCALE;
#pragma unroll
            for (int g = 0; g < 4; ++g) {
                *(unsigned*)(ow + 8 * g) = pk_fp8x4(oa0[4 * g] * sa, oa0[4 * g + 1] * sa, oa0[4 * g + 2] * sa, oa0[4 * g + 3] * sa);
                *(unsigned*)(ow + 32 + 8 * g) = pk_fp8x4(oa1[4 * g] * sa, oa1[4 * g + 1] * sa, oa1[4 * g + 2] * sa, oa1[4 * g + 3] * sa);
            }
#pragma unroll
            for (int it = 0; it < 2; ++it) { const uint4 v = *(const uint4*)(orr + it * 16 * 80); *(uint4*)(og + (size_t)(16 * it) * D) = v; }
#pragma unroll
            for (int g = 0; g < 4; ++g) {
                *(unsigned*)(ow + 8 * g) = pk_fp8x4(ob0[4 * g] * sb, ob0[4 * g + 1] * sb, ob0[4 * g + 2] * sb, ob0[4 * g + 3] * sb);
                *(unsigned*)(ow + 32 + 8 * g) = pk_fp8x4(ob1[4 * g] * sb, ob1[4 * g + 1] * sb, ob1[4 * g + 2] * sb, ob1[4 * g + 3] * sb);
            }
#pragma unroll
            for (int it = 0; it < 2; ++it) { const uint4 v = *(const uint4*)(orr + it * 16 * 80); *(uint4*)(og + (size_t)(32 + 16 * it) * D) = v; }
        }
        task += isctx ? (int)gridDim.x : NGW;
    }
}
__device__ __forceinline__ void ph_conv3v(const P& p) {
    const int tix = otid();
    const bf16* __restrict__ PROJ = (const bf16*)(p.ws + OFF_PROJ); bf16* __restrict__ MIX = (bf16*)(p.ws + OFF_MIX);
    const float* cw = p.in[I_EVCW]; const float* cb = p.in[I_EVCB];
    const int total = NT * 64, stride = gridDim.x * blockDim.x, i0 = blockIdx.x * blockDim.x + tix;
    const int j = (i0 & 63) * 8;
    float wv[3][8], bv[8];
    { const float4 b0 = *(const float4*)(cb + j), b1 = *(const float4*)(cb + j + 4); bv[0] = b0.x; bv[1] = b0.y; bv[2] = b0.z; bv[3] = b0.w; bv[4] = b1.x; bv[5] = b1.y; bv[6] = b1.z; bv[7] = b1.w; }
#pragma unroll
    for (int k = 0; k < 3; ++k) { const float4 w0 = *(const float4*)(cw + k * 512 + j), w1 = *(const float4*)(cw + k * 512 + j + 4);
        wv[k][0] = w0.x; wv[k][1] = w0.y; wv[k][2] = w0.z; wv[k][3] = w0.w; wv[k][4] = w1.x; wv[k][5] = w1.y; wv[k][6] = w1.z; wv[k][7] = w1.w; }
    for (int ib = i0; ib < total; ib += 2 * stride) {
        uint4 gcv[2][3], uv[2][3], gbv[2];
#pragma unroll
        for (int q = 0; q < 2; ++q) {
            const int i = ib + q * stride; const int r = min(i, total - 1) >> 6;
            int t, len; if (r < NL) { t = r & 4095; len = SEQ; } else { t = (r - NL) & 255; len = CTXL; }
#pragma unroll
            for (int k = 0; k < 3; ++k) { const int tt = t - 1 + k; const bool ok = tt >= 0 && tt < len; const bf16* row = PROJ + (size_t)(r - 1 + k) * EVIN;
                gcv[q][k] = ok ? *(const uint4*)(row + 1280 + j) : make_uint4(0u, 0u, 0u, 0u); uv[q][k] = ok ? *(const uint4*)(row + 1792 + j) : make_uint4(0u, 0u, 0u, 0u); }
            gbv[q] = *(const uint4*)(PROJ + (size_t)r * EVIN + 768 + j);
        }
#pragma unroll
        for (int q = 0; q < 2; ++q) {
            const int i = ib + q * stride;
            float acc[8];
#pragma unroll
            for (int c = 0; c < 8; ++c) acc[c] = bv[c];
#pragma unroll
            for (int k = 0; k < 3; ++k) { float gc[8], u[8]; unpack8(gcv[q][k], gc); unpack8(uv[q][k], u);
#pragma unroll
                for (int c = 0; c < 8; ++c) acc[c] += wv[k][c] * (gc[c] * u[c]); }
            float gb[8]; unpack8(gbv[q], gb);
#pragma unroll
            for (int c = 0; c < 8; ++c) acc[c] *= gb[c];
            if (i < total) { uint2 o8; o8.x = pk_fp8x4(acc[0] * MIX8_SCALE, acc[1] * MIX8_SCALE, acc[2] * MIX8_SCALE, acc[3] * MIX8_SCALE); o8.y = pk_fp8x4(acc[4] * MIX8_SCALE, acc[5] * MIX8_SCALE, acc[6] * MIX8_SCALE, acc[7] * MIX8_SCALE);
                *(uint2*)((unsigned char*)MIX + (size_t)(i >> 6) * D + 512 + j) = o8; }
        }
    }
}

namespace pg8 {
#define PG8_LAS __attribute__((address_space(3)))
typedef short bf16x8 __attribute__((ext_vector_type(8)));
typedef float f32x4 __attribute__((ext_vector_type(4)));
typedef unsigned u32x4 __attribute__((ext_vector_type(4)));
constexpr int BM = 256, BK = 64, HALF = 128, HTB = HALF * BK * 2, STAGE_BYTES = 8 * HTB, NXCD = 8, WGM = 8;
__device__ __forceinline__ int lds_byte(int r, int c) { const int st = (r >> 4) * 2 + (c >> 5), rr = r & 15, cc = c & 31, ob = rr * 64 + cc * 2; return st * 1024 + (ob ^ (((ob >> 9) & 1) << 5)); }
__device__ __forceinline__ void stage_rc(int b, int& R, int& C) { const int st = b / 1024, sb = b % 1024, swz = sb ^ (((sb >> 9) & 1) << 5); R = (st >> 1) * 16 + swz / 64; C = (st & 1) * 32 + (swz % 64) / 2; }
__device__ __forceinline__ int perm32(int rho) { const int n = rho >> 4, i = rho & 15; return 8 * (i >> 2) + 4 * n + (i & 3); }
__device__ __forceinline__ unsigned cvt_pk_bf16(float lo, float hi) { unsigned r; asm volatile("v_cvt_pk_bf16_f32 %0, %1, %2" : "=v"(r) : "v"(lo), "v"(hi)); return r; }

struct Unit { int g, pm, pn; };
struct Sched {
    int ng, nM, nN, nwg, G, c;
    const char* Abase; size_t a_gstride, a_tstride;
    const char* Bbase; size_t b_gstride, b_tstride;
    const int* rowidx; int idx_gstride;
    __device__ __forceinline__ bool next(int i, Unit& u) const {
        const long L = (long)i * G + c; if (L >= nwg) return false;
        int wgid = (int)L; { const int q = nwg / NXCD, r = nwg % NXCD, xcd = wgid % NXCD, off = wgid / NXCD; wgid = (xcd < r ? xcd * (q + 1) : r * (q + 1) + (xcd - r) * q) + off; }
        const int tpg = nM * nN; u.g = wgid / tpg; const int w = wgid % tpg;
        const int nig = WGM * nN, gid = w / nig, fm = gid * WGM, gsz = (nM - fm) < WGM ? (nM - fm) : WGM;
        u.pm = fm + ((w % nig) % gsz); u.pn = (w % nig) / gsz; return true;
    }
    __device__ __forceinline__ const char* a_base(const Unit& u) const { return Abase + (size_t)u.g * a_gstride + (size_t)u.pm * a_tstride; }
    __device__ __forceinline__ const char* b_base(const Unit& u) const { return Bbase + (size_t)u.g * b_gstride + (size_t)u.pn * b_tstride; }
};

template <class Epi, bool GATHER, bool F8 = false, bool PHK = false>
__device__ __forceinline__ void gemm_phase(PG8_LAS unsigned char* lds, const int KB  , const Sched& S, const Epi& E) {
    int tid_ = threadIdx.x; asm volatile("" : "+v"(tid_));
    const int tid = tid_, wid = __builtin_amdgcn_readfirstlane(tid >> 6), lane = tid & 63, wr = wid >> 2, wc = wid & 3, fr = lane & 15, fq = lane >> 4;
    const int nt = KB / (BK * 2);
    int Rr[2], Cc[2]; unsigned voffB[2];
#pragma unroll
    for (int i = 0; i < 2; ++i) { stage_rc(tid * 16 + i * 8192, Rr[i], Cc[i]); const int Rb = Epi::PERM ? ((Rr[i] & ~31) + perm32(Rr[i] & 31)) : Rr[i]; voffB[i] = (unsigned)(Rb * KB + Cc[i] * 2); }
    const size_t kstep = (size_t)(BK * 2);
    const size_t hstep = (size_t)HALF * KB;
    const unsigned ldsw = (unsigned)wid * 1024u;
    const int aoff = lds_byte(wr * 64 + fr, fq * 8), boff = lds_byte(wc * 32 + fr, fq * 8);
#define PG8_SA(b, h) (((b) * 2 + (h)) * HTB)
#define PG8_SB(b, h) ((4 + (b) * 2 + (h)) * HTB)
#define PG8_STAGE2(bufoff, gbase, v0, v1) do { unsigned o0_ = (v0), o1_ = (v1); asm volatile("" : "+v"(o0_), "+v"(o1_));     \
        __builtin_amdgcn_global_load_lds((const unsigned*)((const char*)(gbase) + o0_), (PG8_LAS unsigned*)(lds + (bufoff) + ldsw), 16, 0, 0); \
        __builtin_amdgcn_global_load_lds((const unsigned*)((const char*)(gbase) + o1_), (PG8_LAS unsigned*)(lds + (bufoff) + ldsw + 8192), 16, 0, 0); } while (0)
#define PG8_STAGEB(bufoff, gbase) PG8_STAGE2(bufoff, gbase, voffB[0], voffB[1])
#define PG8_STAGEA1(bufoff, gbase, v10, v11, v00, v01) do { if constexpr (GATHER) PG8_STAGE2(bufoff, gbase, v10, v11); else PG8_STAGE2(bufoff, (gbase) + hstep, v00, v01); } while (0)
#define PG8_LDA(dst, b, h) do { _Pragma("unroll") for (int m = 0; m < 4; ++m) { if constexpr (F8) dst##8[m] = __builtin_shufflevector(*(const PG8_LAS v4i_*)(lds + PG8_SA(b, h) + aoff + m * 2048), *(const PG8_LAS v4i_*)(lds + PG8_SA(b, h) + aoff + m * 2048 + 1024), 0, 1, 2, 3, 4, 5, 6, 7); \
        else { _Pragma("unroll") for (int k = 0; k < 2; ++k) dst[m][k] = *(const PG8_LAS bf16x8*)(lds + PG8_SA(b, h) + aoff + m * 2048 + k * 1024); } } } while (0)
#define PG8_LDB(dst, b, h) do { _Pragma("unroll") for (int n = 0; n < 2; ++n) { if constexpr (F8) dst##8[n] = __builtin_shufflevector(*(const PG8_LAS v4i_*)(lds + PG8_SB(b, h) + boff + n * 2048), *(const PG8_LAS v4i_*)(lds + PG8_SB(b, h) + boff + n * 2048 + 1024), 0, 1, 2, 3, 4, 5, 6, 7); \
        else { _Pragma("unroll") for (int k = 0; k < 2; ++k) dst[n][k] = *(const PG8_LAS bf16x8*)(lds + PG8_SB(b, h) + boff + n * 2048 + k * 1024); } } } while (0)
#define PG8_MMA(ai, bj, At, Bt) do { __builtin_amdgcn_s_setprio(1); _Pragma("unroll") for (int m = 0; m < 4; ++m) _Pragma("unroll") for (int n = 0; n < 2; ++n) { \
        if constexpr (F8) asm volatile("v_mfma_scale_f32_16x16x128_f8f6f4 %0, %1, %2, %0, %3, %3 op_sel_hi:[0,0,0]" : "+v"(acc[ai][bj][m][n]) : "v"(Bt##8[n]), "v"(At##8[m]), "v"(scl8));   \
        else { _Pragma("unroll") for (int k = 0; k < 2; ++k) acc[ai][bj][m][n] = __builtin_amdgcn_mfma_f32_16x16x32_bf16(Bt[n][k], At[m][k], acc[ai][bj][m][n], 0, 0, 0); } } \
        __builtin_amdgcn_s_setprio(0); } while (0)
#define PG8_WAIT_V(n) asm volatile("s_waitcnt vmcnt(" #n ")" ::: "memory")
#define PG8_WAIT_L(n) asm volatile("s_waitcnt lgkmcnt(" #n ")" ::: "memory")
#define PG8_BAR __builtin_amdgcn_s_barrier()
#define PG8_SCHED __builtin_amdgcn_sched_barrier(0)
    Unit cur, nxt; int ui = 0;
    if (!S.next(0, cur)) return;
    f32x4 acc[2][2][4][2];
#pragma unroll
    for (int a = 0; a < 2; ++a)
#pragma unroll
        for (int b = 0; b < 2; ++b)
#pragma unroll
            for (int m = 0; m < 4; ++m)
#pragma unroll
                for (int n = 0; n < 2; ++n) acc[a][b][m][n] = (f32x4){0.f, 0.f, 0.f, 0.f};
    typedef int v8i_ __attribute__((ext_vector_type(8))); typedef int v4i_ __attribute__((ext_vector_type(4)));
    unsigned scl8 = 0x7F7F7F7Fu; asm volatile("" : "+v"(scl8));
    bf16x8 At[4][2], B0[2][2], B1[2][2]; v8i_ At8[4], B08[2], B18[2];
    unsigned c00, c01, c10, c11, n00, n01, n10, n11;
#define PG8_VOFFA(u, v00, v01, v10, v11) do { \
        if constexpr (GATHER) { const int* ix = S.rowidx + (size_t)(u).g * S.idx_gstride + (u).pm * BM; \
            int t2_ = tid; asm volatile("" : "+v"(t2_)); int R0_, C0_, R1_, C1_; stage_rc(t2_ * 16, R0_, C0_); stage_rc(t2_ * 16 + 8192, R1_, C1_);     \
            v00 = (unsigned)(ix[R0_] * KB + C0_ * 2); v01 = (unsigned)(ix[R1_] * KB + C1_ * 2); \
            v10 = (unsigned)(ix[HALF + R0_] * KB + C0_ * 2); v11 = (unsigned)(ix[HALF + R1_] * KB + C1_ * 2); } \
        else { v00 = (unsigned)(Rr[0] * KB + Cc[0] * 2); v01 = (unsigned)(Rr[1] * KB + Cc[1] * 2); \
            v10 = (unsigned)((HALF + Rr[0]) * KB + Cc[0] * 2); v11 = (unsigned)((HALF + Rr[1]) * KB + Cc[1] * 2); } } while (0)
    PG8_VOFFA(cur, c00, c01, c10, c11);
    const char* cA = GATHER ? S.Abase : S.a_base(cur); const char* cB = S.b_base(cur);
    PG8_STAGEB(PG8_SB(0, 0), cB); PG8_STAGEB(PG8_SB(0, 1), cB + hstep); PG8_STAGE2(PG8_SA(0, 0), cA, c00, c01); PG8_STAGEA1(PG8_SA(0, 1), cA, c10, c11, c00, c01);
    if (wr == 1) PG8_BAR;
    PG8_WAIT_V(2); PG8_BAR;
    PG8_STAGEB(PG8_SB(1, 0), cB + kstep); PG8_STAGE2(PG8_SA(1, 0), cA + kstep, c00, c01); PG8_STAGEB(PG8_SB(1, 1), cB + hstep + kstep);
    PG8_WAIT_V(6); PG8_BAR;
    for (;;) {
        const bool has_next = S.next(ui + 1, nxt);
        const char* nA = has_next ? (GATHER ? S.Abase : S.a_base(nxt)) : cA; const char* nB = has_next ? S.b_base(nxt) : cB;
        if (has_next) { PG8_VOFFA(nxt, n00, n01, n10, n11); } else { n00 = c00; n01 = c01; n10 = c10; n11 = c11; }
#pragma unroll 1
        for (int t = 0; t < nt; t += 2) {
            const bool last = (t == nt - 2);
            const char* a1 = cA + (size_t)(t + 1) * kstep;
            const char* a2 = last ? nA : cA + (size_t)(t + 2) * kstep; const char* b2 = last ? nB : cB + (size_t)(t + 2) * kstep;
            const char* a3 = a2 + kstep; const char* b3 = b2 + kstep;
            const unsigned x00 = last ? n00 : c00, x01 = last ? n01 : c01, x10 = last ? n10 : c10, x11 = last ? n11 : c11;
            PG8_LDB(B0, 0, 0); PG8_LDB(B1, 0, 1); PG8_SCHED; PG8_LDA(At, 0, 0); PG8_STAGEA1(PG8_SA(1, 1), a1, c10, c11, c00, c01);
            PG8_WAIT_V(8); PG8_WAIT_L(0); PG8_BAR; PG8_MMA(0, 0, At, B0); PG8_MMA(0, 1, At, B1); PG8_BAR; PG8_SCHED;
            PG8_LDA(At, 0, 1); PG8_STAGEB(PG8_SB(0, 0), b2); PG8_STAGEB(PG8_SB(0, 1), b2 + hstep); PG8_STAGE2(PG8_SA(0, 0), a2, x00, x01);
            PG8_WAIT_V(8); PG8_WAIT_L(0); PG8_BAR; PG8_MMA(1, 0, At, B0); PG8_MMA(1, 1, At, B1); PG8_BAR; PG8_SCHED;
            const bool ph = PHK && last;
            if (!ph) { PG8_LDB(B0, 1, 0); PG8_LDB(B1, 1, 1); PG8_SCHED; PG8_LDA(At, 1, 0); } PG8_STAGEA1(PG8_SA(0, 1), a2, x10, x11, x00, x01);
            PG8_WAIT_V(8); PG8_WAIT_L(0); PG8_BAR; if (!ph) { PG8_MMA(0, 0, At, B0); PG8_MMA(0, 1, At, B1); } PG8_BAR; PG8_SCHED;
            if (!ph) { PG8_LDA(At, 1, 1); } PG8_STAGEB(PG8_SB(1, 0), b3); PG8_STAGEB(PG8_SB(1, 1), b3 + hstep); PG8_STAGE2(PG8_SA(1, 0), a3, x00, x01);
            PG8_WAIT_V(8); PG8_WAIT_L(0); PG8_BAR; if (!ph) { PG8_MMA(1, 0, At, B0); PG8_MMA(1, 1, At, B1); } PG8_BAR; PG8_SCHED;
        }
        if (wr == 0) PG8_BAR;
        if constexpr (F8) asm volatile("s_nop 15\n\ts_nop 15" ::: "memory");
        { int efr = fr, efq = fq; asm volatile("" : "+v"(efr), "+v"(efq));
          E(acc, cur, wr, wc, efr, efq); }
        if (!has_next) break;
#pragma unroll
        for (int a = 0; a < 2; ++a)
#pragma unroll
            for (int b = 0; b < 2; ++b)
#pragma unroll
                for (int m = 0; m < 4; ++m)
#pragma unroll
                    for (int n = 0; n < 2; ++n) acc[a][b][m][n] = (f32x4){0.f, 0.f, 0.f, 0.f};
        cur = nxt; cA = nA; cB = nB; c00 = n00; c01 = n01; c10 = n10; c11 = n11; ++ui;
        if (wr == 1) PG8_BAR;
    }
    PG8_WAIT_V(0);
    PG8_BAR;
#undef PG8_SA
#undef PG8_SB
#undef PG8_STAGE2
#undef PG8_STAGEB
#undef PG8_STAGEA1
#undef PG8_LDA
#undef PG8_LDB
#undef PG8_MMA
#undef PG8_WAIT_V
#undef PG8_WAIT_L
#undef PG8_BAR
#undef PG8_SCHED
#undef PG8_VOFFA
}

__device__ __forceinline__ float clamp448(float v) { return __builtin_amdgcn_fmed3f(v, -448.f, 448.f); }
__device__ __forceinline__ unsigned pack_fp8x4(float a, float b, float c, float d) {
    int w = __builtin_amdgcn_cvt_pk_fp8_f32(clamp448(a), clamp448(b), 0, false);
    w = __builtin_amdgcn_cvt_pk_fp8_f32(clamp448(c), clamp448(d), w, true);
    return (unsigned)w;
}
struct EpiStoreBf16 {
    static constexpr bool PERM = true;
    bf16* C; int ldc; size_t gstride; float scale;
    __device__ __forceinline__ void operator()(const f32x4 (&acc)[2][2][4][2], const Unit& u, int wr, int wc, int fr, int fq) const {
        bf16* base = C + (size_t)u.g * gstride + (size_t)(u.pm * BM + wr * 64 + fr) * ldc + u.pn * BM + wc * 32 + 8 * fq;
#pragma unroll
        for (int ai = 0; ai < 2; ++ai)
#pragma unroll
            for (int m = 0; m < 4; ++m) { bf16* rowp = base + (size_t)(ai * HALF + m * 16) * ldc;
#pragma unroll
                for (int bj = 0; bj < 2; ++bj) { const f32x4 v0 = acc[ai][bj][m][0] * scale, v1 = acc[ai][bj][m][1] * scale;
                    u32x4 w; w.x = cvt_pk_bf16(v0[0], v0[1]); w.y = cvt_pk_bf16(v0[2], v0[3]); w.z = cvt_pk_bf16(v1[0], v1[1]); w.w = cvt_pk_bf16(v1[2], v1[3]);
                    *(u32x4*)(rowp + bj * HALF) = w; } }
    }
};
struct EpiStoreFp8 {
    static constexpr bool PERM = true;
    unsigned char* C; int ldc; size_t gstride; float scale;
    __device__ __forceinline__ void operator()(const f32x4 (&acc)[2][2][4][2], const Unit& u, int wr, int wc, int fr, int fq) const {
        unsigned char* base = C + (size_t)u.g * gstride + (size_t)(u.pm * BM + wr * 64 + fr) * ldc + u.pn * BM + wc * 32 + 8 * fq;
#pragma unroll
        for (int ai = 0; ai < 2; ++ai)
#pragma unroll
            for (int m = 0; m < 4; ++m) { unsigned char* rowp = base + (size_t)(ai * HALF + m * 16) * ldc;
#pragma unroll
                for (int bj = 0; bj < 2; ++bj) { const f32x4 v0 = acc[ai][bj][m][0] * scale, v1 = acc[ai][bj][m][1] * scale;
                    uint2 w; w.x = pack_fp8x4(v0[0], v0[1], v0[2], v0[3]); w.y = pack_fp8x4(v1[0], v1[1], v1[2], v1[3]);
                    *(uint2*)(rowp + bj * HALF) = w; } }
    }
};
struct EpiSplitBf16 {
    static constexpr bool PERM = true;
    bf16* C0; bf16* C1;
    __device__ __forceinline__ void operator()(const f32x4 (&acc)[2][2][4][2], const Unit& u, int wr, int wc, int fr, int fq) const {
        const int colt = u.pn * BM; bf16* Cb = colt < 1024 ? C0 : C1;
        bf16* base = Cb + (size_t)(u.pm * BM + wr * 64 + fr) * 1024 + (colt & 1023) + wc * 32 + 8 * fq;
#pragma unroll
        for (int ai = 0; ai < 2; ++ai)
#pragma unroll
            for (int m = 0; m < 4; ++m) { bf16* rowp = base + (size_t)(ai * HALF + m * 16) * 1024;
#pragma unroll
                for (int bj = 0; bj < 2; ++bj) { const f32x4 v0 = acc[ai][bj][m][0], v1 = acc[ai][bj][m][1];
                    u32x4 w; w.x = cvt_pk_bf16(v0[0], v0[1]); w.y = cvt_pk_bf16(v0[2], v0[3]); w.z = cvt_pk_bf16(v1[0], v1[1]); w.w = cvt_pk_bf16(v1[2], v1[3]);
                    *(u32x4*)(rowp + bj * HALF) = w; } }
    }
};
constexpr int FFP = 1536;
constexpr float W8_SCALE = 32.f, HID8_SCALE = 8.f;
struct EpiSwiGLU8 {
    static constexpr bool PERM = true;
    unsigned char* HID;
    __device__ __forceinline__ void operator()(const f32x4 (&acc)[2][2][4][2], const Unit& u, int wr, int wc, int fr, int fq) const {
        unsigned char* base = HID + ((size_t)u.g * ME + u.pm * BM + wr * 64 + fr) * FFP + u.pn * HALF + wc * 32 + 8 * fq;
        const float ke = -1.4426950408889634f / W8_SCALE, ik = (W8_SCALE * W8_SCALE) / HID8_SCALE;
#pragma unroll
        for (int ai = 0; ai < 2; ++ai)
#pragma unroll
            for (int m = 0; m < 4; ++m) {
                float h[8];
#pragma unroll
                for (int n = 0; n < 2; ++n)
#pragma unroll
                    for (int j = 0; j < 4; ++j) { const float g = acc[ai][0][m][n][j], uu = acc[ai][1][m][n][j];
                        h[n * 4 + j] = (g * uu) * __builtin_amdgcn_rcpf(__builtin_fmaf(__builtin_amdgcn_exp2f(ke * g), ik, ik)); }
                uint2 w; w.x = pack_fp8x4(h[0], h[1], h[2], h[3]); w.y = pack_fp8x4(h[4], h[5], h[6], h[7]);
                unsigned char* dst = base + (size_t)(ai * HALF + m * 16) * FFP;
                *(uint2*)dst = w;
            }
    }
};
struct EpiResid {
    static constexpr bool PERM = true;
    const float* x_in; const float* ctx_in; bf16* xres; const float* modv_l; bool first; float ascale;
    __device__ __forceinline__ void operator()(const f32x4 (&acc)[2][2][4][2], const Unit& u, int wr, int wc, int fr, int fq) const {
        const int row0t = u.pm * BM;
        const float* rb = row0t < NL ? x_in : ctx_in - (size_t)NL * D;
        const int mr = row0t < NL ? (row0t >> 12) : 8;
        const int row0 = row0t + wr * 64 + fr, col0 = u.pn * BM + wc * 32 + 8 * fq;
        const float* gate = modv_l + (size_t)mr * 6144 + 2 * 1024 + col0;
        f32x4 gt[2][2];
#pragma unroll
        for (int bj = 0; bj < 2; ++bj) { gt[bj][0] = *(const f32x4*)(gate + bj * HALF) * ascale; gt[bj][1] = *(const f32x4*)(gate + bj * HALF + 4) * ascale; }
#pragma unroll
        for (int ai = 0; ai < 2; ++ai) {
            if (first) {
#pragma unroll
                for (int mg = 0; mg < 4; mg += 2) {
                    f32x4 rr[2][2][2];
#pragma unroll
                    for (int m = 0; m < 2; ++m)
#pragma unroll
                        for (int bj = 0; bj < 2; ++bj) { const size_t off = (size_t)(row0 + ai * HALF + (mg + m) * 16) * D + col0 + bj * HALF;
                            rr[m][bj][0] = *(const f32x4*)(rb + off); rr[m][bj][1] = *(const f32x4*)(rb + off + 4); }
#pragma unroll
                    for (int m = 0; m < 2; ++m)
#pragma unroll
                        for (int bj = 0; bj < 2; ++bj) { const size_t off = (size_t)(row0 + ai * HALF + (mg + m) * 16) * D + col0 + bj * HALF;
                            const f32x4 v0 = rr[m][bj][0] + gt[bj][0] * acc[ai][bj][mg + m][0], v1 = rr[m][bj][1] + gt[bj][1] * acc[ai][bj][mg + m][1];
                            u32x4 o; o.x = cvt_pk_bf16(v0[0], v0[1]); o.y = cvt_pk_bf16(v0[2], v0[3]); o.z = cvt_pk_bf16(v1[0], v1[1]); o.w = cvt_pk_bf16(v1[2], v1[3]);
                            *(u32x4*)(xres + off) = o; }
                    asm volatile("" ::: "memory");
                }
            } else {
                u32x4 wv[4][2];
#pragma unroll
                for (int m = 0; m < 4; ++m)
#pragma unroll
                    for (int bj = 0; bj < 2; ++bj) wv[m][bj] = *(const u32x4*)(xres + (size_t)(row0 + ai * HALF + m * 16) * D + col0 + bj * HALF);
#pragma unroll
                for (int m = 0; m < 4; ++m)
#pragma unroll
                    for (int bj = 0; bj < 2; ++bj) { const u32x4 w = wv[m][bj];
                        const f32x4 r0 = (f32x4){__uint_as_float(w.x << 16), __uint_as_float(w.x & 0xffff0000u), __uint_as_float(w.y << 16), __uint_as_float(w.y & 0xffff0000u)};
                        const f32x4 r1 = (f32x4){__uint_as_float(w.z << 16), __uint_as_float(w.z & 0xffff0000u), __uint_as_float(w.w << 16), __uint_as_float(w.w & 0xffff0000u)};
                        const f32x4 v0 = r0 + gt[bj][0] * acc[ai][bj][m][0], v1 = r1 + gt[bj][1] * acc[ai][bj][m][1];
                        u32x4 o; o.x = cvt_pk_bf16(v0[0], v0[1]); o.y = cvt_pk_bf16(v0[2], v0[3]); o.z = cvt_pk_bf16(v1[0], v1[1]); o.w = cvt_pk_bf16(v1[2], v1[3]);
                        *(u32x4*)(xres + (size_t)(row0 + ai * HALF + m * 16) * D + col0 + bj * HALF) = o; }
                asm volatile("" ::: "memory");
            }
        }
    }
};
}

__device__ __forceinline__ void transpose_item(const float* W, int K, int N, bf16* WT, int k0, int n0, int drow0, float* scr, int lane) {
    float tv[32];
#pragma unroll
    for (int i = 0; i < 32; ++i) tv[i] = W[(size_t)(k0 + 2 * i + (lane >> 5)) * N + n0 + (lane & 31)];
#pragma unroll
    for (int i = 0; i < 32; ++i) scr[(2 * i + (lane >> 5)) * 33 + (lane & 31)] = tv[i];
    __builtin_amdgcn_wave_barrier(); asm volatile("s_waitcnt lgkmcnt(0)" ::: "memory");
    const int c = lane & 7;
#pragma unroll
    for (int j = 0; j < 4; ++j) { const int n = (lane >> 3) + 8 * j; const float* s = scr + (8 * c) * 33 + n;
        uint4 o; o.x = pk2(s[0 * 33], s[1 * 33]); o.y = pk2(s[2 * 33], s[3 * 33]); o.z = pk2(s[4 * 33], s[5 * 33]); o.w = pk2(s[6 * 33], s[7 * 33]);
        *(uint4*)(WT + (size_t)(drow0 + n) * K + k0 + 8 * c) = o; }
    __builtin_amdgcn_wave_barrier(); asm volatile("s_waitcnt lgkmcnt(0)" ::: "memory");
}
constexpr size_t OFF_WT_EVIN = 17 * MiB, OFF_WT_EVOUT = 22 * MiB, OFF_WT_ODIN = 24 * MiB, OFF_WT_ODOUT = 28 * MiB;
constexpr size_t OFF_WGU = 491 * MiB, OFF_WDN = 536 * MiB;
constexpr size_t OFF_WGU1 = 100 * MiB, OFF_WDN1 = 144 * MiB;
constexpr size_t WGU_E = (size_t)2816 * 1024, WDN_E = (size_t)1024 * pg8::FFP;
__device__ __forceinline__ void transpose_item_f8(const float* W, int K, int N, int KP, unsigned char* WT, int k0, int n0, int drow0, float scale, float* scr, int lane) {
    if (k0 < K) {
        float tv[32];
#pragma unroll
        for (int i = 0; i < 32; ++i) tv[i] = W[(size_t)(k0 + 2 * i + (lane >> 5)) * N + n0 + (lane & 31)];
#pragma unroll
        for (int i = 0; i < 32; ++i) scr[(2 * i + (lane >> 5)) * 33 + (lane & 31)] = tv[i] * scale;
    }
    __builtin_amdgcn_wave_barrier(); asm volatile("s_waitcnt lgkmcnt(0)" ::: "memory");
    const int c = lane & 7;
#pragma unroll
    for (int j = 0; j < 4; ++j) { const int n = (lane >> 3) + 8 * j; const float* s = scr + (8 * c) * 33 + n;
        uint2 o = make_uint2(0u, 0u);
        if (k0 < K) { o.x = pg8::pack_fp8x4(s[0 * 33], s[1 * 33], s[2 * 33], s[3 * 33]); o.y = pg8::pack_fp8x4(s[4 * 33], s[5 * 33], s[6 * 33], s[7 * 33]); }
        *(uint2*)(WT + (size_t)(drow0 + n) * KP + k0 + 8 * c) = o; }
    __builtin_amdgcn_wave_barrier(); asm volatile("s_waitcnt lgkmcnt(0)" ::: "memory");
}
__device__ __forceinline__ void ph_convert_other(const P& p, float* sm) {
    const int tix = otid();
    const int lane = tix & 63, wave = tix >> 6; float* scr = sm + wave * (64 * 33);
    const int gw = blockIdx.x * 8 + wave, NGW = gridDim.x * 8;
    constexpr int I0 = 16 * 72, I1 = 16 * 32, I2 = 16 * 64, I3 = 16 * 32;
    for (int it = gw; it < I0 + I1 + I2 + I3; it += NGW) {
        int r = it; const float* W; int N; bf16* WT;
        if (r < I0) { W = p.in[I_EVWIN]; N = 2304; WT = (bf16*)(p.ws + OFF_WT_EVIN); }
        else if ((r -= I0) < I1) { W = p.in[I_EVWOUT]; N = 1024; WT = (bf16*)(p.ws + OFF_WT_EVOUT); }
        else if ((r -= I1) < I2) { W = p.in[I_ODWIN]; N = 2048; WT = (bf16*)(p.ws + OFF_WT_ODIN); }
        else { r -= I2; W = p.in[I_ODWOUT]; N = 1024; WT = (bf16*)(p.ws + OFF_WT_ODOUT); }
        const int nblk = N / 32, k0 = 64 * (r / nblk), n0 = 32 * (r % nblk);
        if (it >= I0 && it < I0 + I1) transpose_item_f8(W, 1024, N, 1024, (unsigned char*)(p.ws + OFF_WT_EVOUT), k0, n0, n0, pg8::W8_SCALE, scr, lane);
        else transpose_item(W, 1024, N, WT, k0, n0, n0, scr, lane);
    }
}
constexpr int CVT_IPE = 1408 + 22 * 32;
constexpr int CVT_ITEMS = NE * CVT_IPE;
__device__ __forceinline__ void ph_convert_moe_range(const P& p, int l, float* sm, const int it0, const int it1, const int widx0, const int nworkers) {
    const int tix = otid();
    const int lane = tix & 63, wave = tix >> 6; float* scr = sm + wave * (64 * 33);
    unsigned char* WGUl = (unsigned char*)(p.ws + (l ? OFF_WGU1 : OFF_WGU)); unsigned char* WDNl = (unsigned char*)(p.ws + (l ? OFF_WDN1 : OFF_WDN));
    for (int it = it0 + widx0 + wave; it < it1; it += nworkers) {
        const int e = it / CVT_IPE; int r = it % CVT_IPE;
        if (r < 1408) {
            const int up = r >= 704; if (up) r -= 704;
            const int k0 = 64 * (r / 44), n0 = 32 * (r % 44);
            const float* W = (up ? p.in[I_WU] : p.in[I_WG]) + (size_t)(l * NE + e) * D * FF;
            transpose_item_f8(W, 1024, FF, 1024, WGUl + (size_t)e * WGU_E, k0, n0, (n0 >> 7) * 256 + up * 128 + (n0 & 127), pg8::W8_SCALE, scr, lane);
        } else { r -= 1408;
            const int k0 = 64 * (r / 32), n0 = 32 * (r % 32);
            transpose_item_f8(p.in[I_WD] + (size_t)(l * NE + e) * FF * D, FF, 1024, pg8::FFP, WDNl + (size_t)e * WDN_E, k0, n0, n0, pg8::W8_SCALE, scr, lane);
        }
    }
}
__device__ __forceinline__ void ph_convert_moe(const P& p, int l, float* sm, const int it0 = 0) { ph_convert_moe_range(p, l, sm, it0, CVT_ITEMS, blockIdx.x * 8, gridDim.x * 8); }
__device__ __forceinline__ void ph_conv4v(const P& p) {
    const int tix = otid();
    const bf16* __restrict__ U = (const bf16*)(p.ws + OFF_H); bf16* __restrict__ UC = (bf16*)(p.ws + OFF_UC);
    const float* cw = p.in[I_ODCW]; const float* cb = p.in[I_ODCB];
    const int total = NT * 128, stride = gridDim.x * blockDim.x, i0 = blockIdx.x * blockDim.x + tix;
    const int j = (i0 & 127) * 8;
    float wv[4][8], bv[8];
    { const float4 b0 = *(const float4*)(cb + j), b1 = *(const float4*)(cb + j + 4); bv[0] = b0.x; bv[1] = b0.y; bv[2] = b0.z; bv[3] = b0.w; bv[4] = b1.x; bv[5] = b1.y; bv[6] = b1.z; bv[7] = b1.w; }
#pragma unroll
    for (int k = 0; k < 4; ++k) { const float4 w0 = *(const float4*)(cw + k * 1024 + j), w1 = *(const float4*)(cw + k * 1024 + j + 4);
        wv[k][0] = w0.x; wv[k][1] = w0.y; wv[k][2] = w0.z; wv[k][3] = w0.w; wv[k][4] = w1.x; wv[k][5] = w1.y; wv[k][6] = w1.z; wv[k][7] = w1.w; }
    for (int ib = i0; ib < total; ib += 4 * stride) {
        uint4 uu[4][4];
#pragma unroll
        for (int q = 0; q < 4; ++q) {
            const int i = ib + q * stride; const int r = min(i, total - 1) >> 7;
            int t, len; if (r < NL) { t = r & 4095; len = SEQ; } else { t = (r - NL) & 255; len = CTXL; }
#pragma unroll
            for (int k = 0; k < 4; ++k) { const int tt = t - 2 + k; uu[q][k] = (tt >= 0 && tt < len) ? *(const uint4*)(U + (size_t)(r - 2 + k) * D + j) : make_uint4(0u, 0u, 0u, 0u); }
        }
#pragma unroll
        for (int q = 0; q < 4; ++q) {
            const int i = ib + q * stride;
            float acc[8];
#pragma unroll
            for (int c = 0; c < 8; ++c) acc[c] = bv[c];
#pragma unroll
            for (int k = 0; k < 4; ++k) { float u[8]; unpack8(uu[q][k], u);
#pragma unroll
                for (int c = 0; c < 8; ++c) acc[c] += wv[k][c] * u[c]; }
            if (i < total) *(uint4*)(UC + (size_t)(i >> 7) * D + j) = pack8(acc);
        }
    }
}
__device__ __forceinline__ void ph_convert_gates(const P& p, float* sm) {
    const int tix = otid();
    const int lane = tix & 63, wave = tix >> 6; float* scr = sm + wave * (64 * 33);
    const int gw = blockIdx.x * 8 + wave, NGW = gridDim.x * 8;
    for (int it = gw; it < 256; it += NGW) {
        const int mat = it >> 3, r = it & 7, type = mat >> 4, dh = mat & 15;
        const float* W = (type ? p.in[I_ODWX] : p.in[I_ODWA]) + (size_t)dh * 16384;
        transpose_item(W, 128, 128, (bf16*)(p.ws + OFF_WT_GATES) + (size_t)mat * 16384, 64 * (r >> 2), 32 * (r & 3), 32 * (r & 3), scr, lane);
    }
}
typedef float af32x4 __attribute__((ext_vector_type(4)));
__device__ __forceinline__ float opq(float x) { asm("" : "+v"(x)); return x; }
#define LRU_LAS __attribute__((address_space(3)))
constexpr int LRU_CTR = 8192;
__device__ __forceinline__ void lru_wait4(volatile __attribute__((address_space(3))) int* c, const int target) {
    for (;;) { const int a = c[0], b = c[4], d = c[8], e = c[12]; if (min(min(a, b), min(d, e)) >= target) break; __builtin_amdgcn_s_sleep(1); } }
constexpr int LRU_RING = 16384;
template <bool REV>
__device__ __forceinline__ void lru_walk(const bf16* UC, bf16* HX, const int b, const int colbase  , const int ch, const abf16x8 (&wa)[4], const abf16x8 (&wx)[4], const abf16x8 (&efs)[4],
                                         const float ba_, const float bx_, const float c8l2, const int fr, const int fq, char* wl  ,
                                         LRU_LAS unsigned char* lds, const int wave) {
    float hstate = 0.f;
    const char* ubase = (const char*)(UC + colbase);
    const unsigned vld = (unsigned)(fr * D + 8 * fq) * 2u + 64u * wave;
    const int ln_ = fr + 16 * fq;
    char* sbase = (char*)HX; const unsigned vst = (unsigned)((ln_ >> 1) * D + (ch - fr) + (ln_ & 1) * 8) * 2u;
    char* wlw = wl + (4 * fq) * 48 + 2 * fr; const char* wlr = wl + (ln_ >> 1) * 48 + (ln_ & 1) * 16;
    const float NL2E = -1.4426950408889634f;
    const float nba_ = NL2E * ba_, nbx_ = NL2E * bx_;
#define LRU_ROW(q) ((q) < 16 ? (NL + b * CTXL + 16 * (REV ? 15 - (q) : (q))) : (b * SEQ + 16 * (REV ? 255 - ((q) - 16) : ((q) - 16))))
#define LRU_FETCH(g) do { _Pragma("unroll") for (int j = 0; j < 8; ++j) { \
        __builtin_amdgcn_global_load_lds((const unsigned*)(ubase + (size_t)LRU_ROW(8 * (g) + j) * (D * 2) + vld), \
            (LRU_LAS unsigned*)(lds + LRU_RING + ((((g) & 1) * 8 + j) * 4 + wave) * 1024), 16, 0, 0); } } while (0)
#define LRU_TAKE(buf, q) do { const LRU_LAS unsigned char* rp_ = lds + LRU_RING + (((((q) >> 3) & 1) * 8 + ((q) & 7)) * 4) * 1024 + ln_ * 16; \
        _Pragma("unroll") for (int s = 0; s < 4; ++s) buf[s] = *(const LRU_LAS abf16x8*)(rp_ + s * 1024); } while (0)
    af32x4 zr, zi, uu; float pav[4], pbv[4], pAg[4], pBg[4]; int prow0 = 0;
#define LRU_MFMA(buf, nbuf, q) do { \
        zr = (af32x4){0.f, 0.f, 0.f, 0.f}; zi = zr; uu = zr; \
        _Pragma("unroll") for (int s = 0; s < 4; ++s) { zr = __builtin_amdgcn_mfma_f32_16x16x32_bf16(buf[s], wa[s], zr, 0, 0, 0); zi = __builtin_amdgcn_mfma_f32_16x16x32_bf16(buf[s], wx[s], zi, 0, 0, 0); } \
        _Pragma("unroll") for (int s = 0; s < 4; ++s) uu = __builtin_amdgcn_mfma_f32_16x16x32_bf16(buf[s], efs[s], uu, 0, 0, 0);     \
        if ((q) + 1 < 272) LRU_TAKE(nbuf, (q) + 1); \
        __builtin_amdgcn_sched_barrier(0); } while (0)
#define LRU_GATES(q) do { \
        _Pragma("unroll") for (int i = 0; i < 4; ++i) {                  \
            const float d1 = 1.f + __builtin_amdgcn_exp2f(opq(NL2E * zr[i] + nba_)); \
            const float d2 = 1.f + __builtin_amdgcn_exp2f(__builtin_amdgcn_fmed3f(opq(NL2E * zi[i] + nbx_), -1e30f, 120.f)); \
            const float a = __builtin_amdgcn_exp2f(opq(c8l2 * __builtin_amdgcn_rcpf(d1))); \
            const float w = opq(1.f - a * a); \
            const float rs = __builtin_amdgcn_rsqf(opq(opq(w * d2) * d2 + 1e-30f)); \
            pav[i] = a; pbv[i] = opq(opq(w * rs) * uu[i]); } \
        float Ac, Bc; \
        if (!REV) { Ac = pav[0]; Bc = pbv[0]; _Pragma("unroll") for (int i = 1; i < 4; ++i) { Bc = pav[i] * Bc + pbv[i]; Ac *= pav[i]; } } \
        else { Ac = pav[3]; Bc = pbv[3]; _Pragma("unroll") for (int i = 2; i >= 0; --i) { Bc = pav[i] * Bc + pbv[i]; Ac *= pav[i]; } } \
        _Pragma("unroll") for (int g = 0; g < 4; ++g) { pAg[g] = __shfl(Ac, fr + 16 * g); pBg[g] = __shfl(Bc, fr + 16 * g); } \
        prow0 = LRU_ROW(q); \
        __builtin_amdgcn_sched_barrier(0); } while (0)
#define LRU_SCAN(STORE) do { \
        float c = hstate, mine = 0.f; \
        if (!REV) { _Pragma("unroll") for (int g = 0; g < 4; ++g) { if (g == fq) mine = c; c = pAg[g] * c + pBg[g]; } } \
        else { _Pragma("unroll") for (int g = 3; g >= 0; --g) { if (g == fq) mine = c; c = pAg[g] * c + pBg[g]; } } \
        hstate = c; \
        if (STORE) { float hv[4]; float run = mine; \
            if (!REV) { _Pragma("unroll") for (int i = 0; i < 4; ++i) { run = pav[i] * run + pbv[i]; hv[i] = run; } } \
            else { _Pragma("unroll") for (int i = 3; i >= 0; --i) { run = pav[i] * run + pbv[i]; hv[i] = run; } } \
            const unsigned p01 = cvtpk(hv[0], hv[1]), p23 = cvtpk(hv[2], hv[3]); \
            *(bf16*)(wlw) = (bf16)(p01 & 0xffffu); *(bf16*)(wlw + 48) = (bf16)(p01 >> 16); *(bf16*)(wlw + 96) = (bf16)(p23 & 0xffffu); *(bf16*)(wlw + 144) = (bf16)(p23 >> 16); \
            if (ln_ < 32) { const uint4 tv_ = *(const uint4*)wlr; *(uint4*)(sbase + (size_t)prow0 * (D * 2) + vst) = tv_; } } \
        __builtin_amdgcn_sched_barrier(0); } while (0)
#define LRU_STEP(buf, nbuf, q, STORE) do { LRU_MFMA(buf, nbuf, q); LRU_SCAN(STORE); LRU_GATES(q); } while (0)
#define LRU_SEAM(g) do { asm volatile("s_waitcnt lgkmcnt(0)" ::: "memory"); ctr[16 + 4 * wave] = (g) + 1; lru_wait4(ctr, (g) + 2 < 34 ? (g) + 2 : 34); } while (0)
    abf16x8 A0[4], A1[4];
    volatile LRU_LAS int* ctr = (volatile LRU_LAS int*)(lds + LRU_CTR);
    lru_wait4(ctr, 2);
    LRU_TAKE(A0, 0);
    LRU_MFMA(A0, A1, 0); LRU_GATES(0);
    LRU_STEP(A1, A0, 1, false); LRU_STEP(A0, A1, 2, false); LRU_STEP(A1, A0, 3, false); LRU_STEP(A0, A1, 4, false); LRU_STEP(A1, A0, 5, false); LRU_STEP(A0, A1, 6, false);
    LRU_SEAM(0); LRU_STEP(A1, A0, 7, false);
#pragma unroll 1
    for (int g = 1; g < 34; ++g) {
        const int q = 8 * g; const bool st = q > 16;
        LRU_STEP(A0, A1, q, st); LRU_STEP(A1, A0, q + 1, q + 1 > 16); LRU_STEP(A0, A1, q + 2, q + 2 > 16); LRU_STEP(A1, A0, q + 3, q + 3 > 16);
        LRU_STEP(A0, A1, q + 4, q + 4 > 16); LRU_STEP(A1, A0, q + 5, q + 5 > 16); LRU_STEP(A0, A1, q + 6, q + 6 > 16);
        LRU_SEAM(g); LRU_STEP(A1, A0, q + 7, q + 7 > 16);
    }
    LRU_SCAN(true);
#undef LRU_ROW
#undef LRU_FETCH
#undef LRU_TAKE
#undef LRU_MFMA
#undef LRU_GATES
#undef LRU_SCAN
#undef LRU_STEP
#undef LRU_SEAM
}
template <bool REV>
__device__ __forceinline__ void lru_produce(const P& p, const int b, const int h, const int pw, const int fr, const int fq, LRU_LAS unsigned char* lds) {
    const bf16* __restrict__ U = (const bf16*)(p.ws + OFF_H);
    const int ch0 = h * 128 + 32 * pw + 8 * fq, lane = fr + 16 * fq;
    const unsigned voff = (unsigned)(fr * D + ch0) * 2u;
    const float* cw = p.in[I_ODCW]; const float* cb = p.in[I_ODCB];
    float wv[4][8], bv[8];
    { const float4 b0 = *(const float4*)(cb + ch0), b1 = *(const float4*)(cb + ch0 + 4); bv[0] = b0.x; bv[1] = b0.y; bv[2] = b0.z; bv[3] = b0.w; bv[4] = b1.x; bv[5] = b1.y; bv[6] = b1.z; bv[7] = b1.w; }
#pragma unroll
    for (int k = 0; k < 4; ++k) { const float4 w0 = *(const float4*)(cw + k * 1024 + ch0), w1 = *(const float4*)(cw + k * 1024 + ch0 + 4);
        wv[k][0] = w0.x; wv[k][1] = w0.y; wv[k][2] = w0.z; wv[k][3] = w0.w; wv[k][4] = w1.x; wv[k][5] = w1.y; wv[k][6] = w1.z; wv[k][7] = w1.w; }
#define LRU_ROW(q) ((q) < 16 ? (NL + b * CTXL + 16 * (REV ? 15 - (q) : (q))) : (b * SEQ + 16 * (REV ? 255 - ((q) - 16) : ((q) - 16))))
    const bool hl_ = fr < 2 || fr == 15;
    const int hrow_ = fr < 2 ? fr - 2 : 16;
    const unsigned vhal = (unsigned)(ch0) * 2u;
#define LRU_PLOAD(g) do { \
        _Pragma("unroll") for (int jj = 0; jj < 8; ++jj) { const int q_ = 8 * (g) + jj; const int r0_ = LRU_ROW(q_); \
            const char* rp_ = (const char*)U + (size_t)r0_ * (D * 2); \
            own[jj] = *(const uint4*)(rp_ + voff); \
            hal[jj] = make_uint4(0u, 0u, 0u, 0u); if (hl_) hal[jj] = *(const uint4*)(rp_ + (long)hrow_ * (D * 2) + vhal); } } while (0)
#define LRU_DPP4(dst, srcv, ctrl) do { dst.x = (unsigned)__builtin_amdgcn_update_dpp(0, (int)srcv.x, ctrl, 0xf, 0xf, true); dst.y = (unsigned)__builtin_amdgcn_update_dpp(0, (int)srcv.y, ctrl, 0xf, 0xf, true); \
        dst.z = (unsigned)__builtin_amdgcn_update_dpp(0, (int)srcv.z, ctrl, 0xf, 0xf, true); dst.w = (unsigned)__builtin_amdgcn_update_dpp(0, (int)srcv.w, ctrl, 0xf, 0xf, true); } while (0)
#define LRU_SEL4(dst, c, a, bq) do { dst.x = (c) ? a.x : bq.x; dst.y = (c) ? a.y : bq.y; dst.z = (c) ? a.z : bq.z; dst.w = (c) ? a.w : bq.w; } while (0)
#define LRU_PCOMP(g) do { \
        _Pragma("unroll") for (int jj = 0; jj < 8; ++jj) { const int q_ = 8 * (g) + jj; const int r0_ = LRU_ROW(q_); \
            const int t0_ = q_ < 16 ? r0_ - (NL + b * CTXL) : r0_ - b * SEQ, len_ = q_ < 16 ? CTXL : SEQ; \
            uint4 tp[4], s2_, s1_, l1_, hl1_; \
            LRU_DPP4(s2_, own[jj], 0x112); LRU_DPP4(s1_, own[jj], 0x111); LRU_DPP4(l1_, own[jj], 0x101); LRU_DPP4(hl1_, hal[jj], 0x101); \
            LRU_SEL4(tp[0], fr >= 2, s2_, hal[jj]); LRU_SEL4(tp[1], fr >= 1, s1_, hl1_); tp[2] = own[jj]; LRU_SEL4(tp[3], fr <= 14, l1_, hal[jj]); \
            if (!(t0_ >= 2 && t0_ + 17 <= len_)) {                                         \
                _Pragma("unroll") for (int k = 0; k < 4; ++k) { const int tt_ = t0_ + fr - 2 + k; if (!(tt_ >= 0 && tt_ < len_)) tp[k] = make_uint4(0u, 0u, 0u, 0u); } } \
            float acc_[8]; \
            _Pragma("unroll") for (int c = 0; c < 8; ++c) acc_[c] = bv[c]; \
            _Pragma("unroll") for (int k = 0; k < 4; ++k) { float u_[8]; unpack8(tp[k], u_); _Pragma("unroll") for (int c = 0; c < 8; ++c) acc_[c] += wv[k][c] * u_[c]; } \
            const uint4 o_ = pack8(acc_); typedef unsigned lu4_ __attribute__((ext_vector_type(4))); \
            *(LRU_LAS lu4_*)(lds + LRU_RING + (((((g) & 1) * 8 + jj) * 4 + pw) * 64 + lane) * 16) = (lu4_){o_.x, o_.y, o_.z, o_.w}; } } while (0)
    uint4 own[8], hal[8];
    LRU_PLOAD(0); LRU_PCOMP(0); LRU_PLOAD(1); LRU_PCOMP(1); LRU_PLOAD(2);
    volatile LRU_LAS int* ctr = (volatile LRU_LAS int*)(lds + LRU_CTR);
    asm volatile("s_waitcnt lgkmcnt(0)" ::: "memory"); ctr[4 * pw] = 2;
#pragma unroll 1
    for (int g = 0; g < 34; ++g) {
        if (g + 2 < 34) {
            lru_wait4(ctr + 16, g + 1);
            LRU_PCOMP(g + 2);
            asm volatile("s_waitcnt lgkmcnt(0)" ::: "memory"); ctr[4 * pw] = g + 3;
            const int gn = g + 3 < 34 ? g + 3 : 33; LRU_PLOAD(gn);
        }
    }
#undef LRU_ROW
#undef LRU_PLOAD
#undef LRU_PCOMP
#undef LRU_DPP4
#undef LRU_SEL4
}
__device__ __forceinline__ void ph_lru(const P& p, float* sm) {
    const bf16* UC = (const bf16*)(p.ws + OFF_UC); const bf16* WTG = (const bf16*)(p.ws + OFF_WT_GATES);
    int tid_ = threadIdx.x; asm volatile("" : "+v"(tid_));
    const int lane = tid_ & 63, fr = lane & 15, fq = lane >> 4, wave = __builtin_amdgcn_readfirstlane(tid_ >> 6);
    LRU_LAS unsigned char* ldsb = (LRU_LAS unsigned char*)sm;
    for (int task0 = blockIdx.x * 4; task0 < 1024; task0 += gridDim.x * 4) {
        __builtin_amdgcn_s_barrier();
        if (tid_ < 8) ((volatile LRU_LAS int*)(ldsb + LRU_CTR))[4 * tid_] = 0;
        asm volatile("s_waitcnt lgkmcnt(0)" ::: "memory"); __builtin_amdgcn_s_barrier();
        if (wave < 4) {
            const int task = task0 + wave;
            const int cb = task & 7, d = (task >> 3) & 1, h = (task >> 4) & 7, b = task >> 7;
            const int ch = h * 128 + cb * 16 + fr;
            const float ba_ = p.in[I_ODBA][d * 1024 + ch], bx_ = p.in[I_ODBX][d * 1024 + ch];
            const float c8l2 = -8.f * log1pf(expf(-p.in[I_ODLAM][d * 1024 + ch])) * 1.4426950408889634f;
            abf16x8 wa[4], wx[4];
            const bf16* wpa = WTG + ((size_t)((0 * 2 + d) * 8 + h) * 128 + cb * 16 + fr) * 128 + 8 * fq;
            const bf16* wpx = WTG + ((size_t)((1 * 2 + d) * 8 + h) * 128 + cb * 16 + fr) * 128 + 8 * fq;
#pragma unroll
            for (int s = 0; s < 4; ++s) { wa[s] = *(const abf16x8*)(wpa + 32 * s); wx[s] = *(const abf16x8*)(wpx + 32 * s); }
            const int kl = (cb & 1) * 16 + fr; abf16x8 efs[4];
#pragma unroll
            for (int s = 0; s < 4; ++s)
#pragma unroll
                for (int j = 0; j < 8; ++j) efs[s][j] = (s == (cb >> 1) && (kl >> 3) == fq && (kl & 7) == j) ? (short)0x3F80 : (short)0;
            bf16* HX = (bf16*)(p.ws + (d ? OFF_HB : OFF_HF));
            char* wl = (char*)sm + wave * 768;
            if (d == 0) lru_walk<false>(UC, HX, b, h * 128, ch, wa, wx, efs, ba_, bx_, c8l2, fr, fq, wl, ldsb, wave);
            else lru_walk<true>(UC, HX, b, h * 128, ch, wa, wx, efs, ba_, bx_, c8l2, fr, fq, wl, ldsb, wave);
        } else {
            const int task = task0, d = (task >> 3) & 1, h = (task >> 4) & 7, b = task >> 7;
            if (d == 0) lru_produce<false>(p, b, h, wave - 4, fr, fq, ldsb); else lru_produce<true>(p, b, h, wave - 4, fr, fq, ldsb);
        }
    }
}
__device__ __forceinline__ void ph_lru_out(const P& p) {
    const int tix = otid();
    bf16* G = (bf16*)(p.ws + OFF_MIX); const bf16* __restrict__ HF = (const bf16*)(p.ws + OFF_HF); const bf16* __restrict__ HB = (const bf16*)(p.ws + OFF_HB);
    const int total = NL * 128, stride = gridDim.x * blockDim.x;
    for (int ib = blockIdx.x * blockDim.x + tix; ib < total; ib += 4 * stride) {
        uint4 gv[4], av[4], cv[4];
#pragma unroll
        for (int q = 0; q < 4; ++q) { const size_t off = (size_t)min(ib + q * stride, total - 1) * 8; gv[q] = *(const uint4*)(G + off); av[q] = *(const uint4*)(HF + off); cv[q] = *(const uint4*)(HB + off); }
#pragma unroll
        for (int q = 0; q < 4; ++q) {
            const int i = ib + q * stride;
            float g[8], a[8], c[8]; unpack8(gv[q], g); unpack8(av[q], a); unpack8(cv[q], c);
#pragma unroll
            for (int z = 0; z < 8; ++z) g[z] = gelu_tanh(g[z]) * (a[z] + c[z]);
            if (i < total) *(uint4*)(G + (size_t)i * 8) = pack8(g);
        }
    }
}

#define LAS __attribute__((address_space(3)))
#define XB_TMO      128
#define XB_XCNT(j)  (256  + 64 * (j))
#define XB_XSUB(j)  (1280 + 64 * (j))
#define XB_XGEN(j)  (2304 + 64 * (j))
#define XB_TOP      3328
#define XB_TOPGEN   3392
#define XCD_BAR_WORDS 3456
#define XB_SPIN_CAP (1u << 18)

__device__ __forceinline__ unsigned xb_ld(unsigned* p)              { return __hip_atomic_load(p, __ATOMIC_RELAXED, __HIP_MEMORY_SCOPE_AGENT); }
__device__ __forceinline__ unsigned xb_add(unsigned* p, unsigned v) { return __hip_atomic_fetch_add(p, v, __ATOMIC_RELAXED, __HIP_MEMORY_SCOPE_AGENT); }
__device__ __forceinline__ unsigned xb_xcc_id() { return (unsigned)__builtin_amdgcn_s_getreg((3 << 11) | 20) & 0xFu; }
#define XB_SPIN(cond, bar) do { unsigned _sp = 0; while (cond) { __builtin_amdgcn_s_sleep(1); \
    if ((++_sp & 255u) == 0u) { if (xb_ld(&(bar)[XB_TMO])) break; if (_sp > XB_SPIN_CAP) { atomicAdd(&(bar)[XB_TMO], 1u); break; } } } } while (0)

struct XcdBarrier {
    unsigned* bar; unsigned x;
    volatile LAS unsigned* st;
};

__device__ __forceinline__ XcdBarrier xcd_barrier_post(unsigned* bar, volatile LAS unsigned* st) {
    XcdBarrier b; b.bar = bar; b.x = xb_xcc_id(); b.st = st;
    if (threadIdx.x == 0) (void)xb_add(&bar[XB_XCNT(b.x)], 1u);
    return b;
}
__device__ __forceinline__ void xcd_barrier_complete(unsigned* bar, unsigned x, unsigned& nloc, unsigned& nx) {
    const unsigned G = gridDim.x * gridDim.y * gridDim.z;
    unsigned sum, cnt, mine, sp = 0u;
    for (;;) {
        sum = 0u; cnt = 0u; mine = 0u;
#pragma unroll
        for (unsigned j = 0; j < 16; ++j) { const unsigned c = xb_ld(&bar[XB_XCNT(j)]); sum += c; cnt += (c > 0u) ? 1u : 0u; mine = (j == x) ? c : mine; }
        if (sum == G) break;
        __builtin_amdgcn_s_sleep(1);
        if ((++sp & 255u) == 0u) { if (xb_ld(&bar[XB_TMO])) break; if (sp > XB_SPIN_CAP) { atomicAdd(&bar[XB_TMO], 1u); break; } }
    }
    nloc = mine > 0u ? mine : 1u; nx = cnt > 0u ? cnt : 1u;
}

__device__ __forceinline__ void xcd_barrier(const XcdBarrier& b) {
    asm volatile("s_waitcnt vmcnt(0)" ::: "memory");
    __syncthreads();
    if (threadIdx.x == 0) {
        unsigned* bar = b.bar;
        __builtin_amdgcn_s_waitcnt(0);
        unsigned nloc = b.st[0], nx = b.st[1];
        if (nloc == 0u) { xcd_barrier_complete(bar, b.x, nloc, nx); b.st[0] = nloc; b.st[1] = nx; }
        const unsigned old = xb_add(&bar[XB_XSUB(b.x)], 1u);
        const unsigned gen = old / nloc;
        if (old + 1u == (gen + 1u) * nloc) {
            __builtin_amdgcn_fence(__ATOMIC_RELEASE, "agent");
            asm volatile("s_waitcnt vmcnt(0)" ::: "memory");
            const unsigned og = xb_add(&bar[XB_TOP], 1u);
            const unsigned tg = og / nx;
            if (og + 1u == (tg + 1u) * nx) xb_add(&bar[XB_TOPGEN], 1u);
            else XB_SPIN(xb_ld(&bar[XB_TOPGEN]) == tg, bar);
            __builtin_amdgcn_fence(__ATOMIC_ACQUIRE, "agent");
            xb_add(&bar[XB_XGEN(b.x)], 1u);
            asm volatile("s_waitcnt vmcnt(0)" ::: "memory");
        } else {
            XB_SPIN(xb_ld(&bar[XB_XGEN(b.x)]) == gen, bar);
            __builtin_amdgcn_fence(__ATOMIC_ACQUIRE, "agent");
            asm volatile("s_waitcnt vmcnt(0)" ::: "memory");
        }
    }
    __syncthreads();
}

constexpr size_t OFF_RT = 560 * MiB, OFF_RB = 563 * MiB;
__device__ __forceinline__ void ph_router_tables(const P& p) {
    const int tix = otid();
    const float* modv = (const float*)(p.ws + OFF_MODV);
    const int per_blk = (18 * 2048 + (int)gridDim.x - 1) / (int)gridDim.x;
    for (int i_ = tix; i_ < per_blk; i_ += (int)blockDim.x) {
        const int it = (int)blockIdx.x * per_blk + i_; if (it >= 18 * 2048) break;
        const int lm = it >> 11, c = it & 2047, l = lm / 9, s = c >> 6, ln = c & 63, e = ln & 15, k0 = 32 * s + 8 * (ln >> 4);
        const float* mv = modv + (size_t)lm * 6144; const float* rw = p.in[I_RW] + (size_t)l * 1024 * 16; const float* gvec = p.in[I_NFFN] + l * 1024;
        unsigned h1[8], h2[8], h3[8];
#pragma unroll
        for (int j = 0; j < 8; ++j) {
            const int k = k0 + j; const float w = gvec[k] * (1.f + mv[4 * 1024 + k]) * rw[(size_t)k * 16 + e];
            const unsigned b1 = f2bf(w); const float r1 = w - __uint_as_float(b1 << 16);
            const unsigned b2 = f2bf(r1); const float r2 = r1 - __uint_as_float(b2 << 16);
            h1[j] = b1; h2[j] = b2; h3[j] = f2bf(r2);
        }
        uint4 o1, o2, o3;
        o1.x = h1[0] | (h1[1] << 16); o1.y = h1[2] | (h1[3] << 16); o1.z = h1[4] | (h1[5] << 16); o1.w = h1[6] | (h1[7] << 16);
        o2.x = h2[0] | (h2[1] << 16); o2.y = h2[2] | (h2[3] << 16); o2.z = h2[4] | (h2[5] << 16); o2.w = h2[6] | (h2[7] << 16);
        o3.x = h3[0] | (h3[1] << 16); o3.y = h3[2] | (h3[3] << 16); o3.z = h3[4] | (h3[5] << 16); o3.w = h3[6] | (h3[7] << 16);
        unsigned char* rt = (unsigned char*)(p.ws + OFF_RT) + (size_t)lm * 98304;
        *(uint4*)(rt + ((size_t)(0 * 32 + s) * 64 + ln) * 16) = o1; *(uint4*)(rt + ((size_t)(1 * 32 + s) * 64 + ln) * 16) = o2; *(uint4*)(rt + ((size_t)(2 * 32 + s) * 64 + ln) * 16) = o3;
    }
    const int lane = tix & 63;
    for (int it = (tix >> 6) == 7 ? (int)blockIdx.x : 18 * 8; it < 18 * 8; it += gridDim.x) {
        const int lm = it >> 3, ep = it & 7, l = lm / 9;
        const float* mv = modv + (size_t)lm * 6144; const float* rw = p.in[I_RW] + (size_t)l * 1024 * 16;
        float b0 = 0.f, b1 = 0.f;
        for (int k = lane; k < 1024; k += 64) { const float s = mv[3 * 1024 + k]; b0 += s * rw[(size_t)k * 16 + 2 * ep]; b1 += s * rw[(size_t)k * 16 + 2 * ep + 1]; }
        b0 = wave_sum(b0); b1 = wave_sum(b1);
        if (lane == 0) { float* rb = (float*)(p.ws + OFF_RB) + lm * 16; rb[2 * ep] = b0; rb[2 * ep + 1] = b1; }
    }
}
typedef float nf32x4 __attribute__((ext_vector_type(4)));
__device__ __forceinline__ void ph_normF(const P& p, const int l, const bool with_ctx, float* sm) {
    const float* modv = (const float*)(p.ws + OFF_MODV);
    const bf16* xres = (const bf16*)(p.ws + OFF_XRES);
    unsigned char* h8 = (unsigned char*)(p.ws + OFF_H);
    const float* rw = p.in[I_RW] + (size_t)l * 1024 * 16;
    const float* gvec = p.in[I_NFFN] + l * 1024;
    int tid_ = threadIdx.x; asm volatile("" : "+v"(tid_));
    const int tid = tid_, lane = tid & 63, fr = lane & 15, fq = lane >> 4, wave = __builtin_amdgcn_readfirstlane(tid >> 6);
    unsigned char* Wt = (unsigned char*)sm; float* biasv = sm + 24576; float* gm = sm + 24592; float* shv = sm + 25616;
    const int nitems = 256;
    for (int item = blockIdx.x; item < nitems; item += gridDim.x) {
        const bool isc = false;
        const int mr = isc ? 8 : (item >> 5);
        const float* mv = modv + (size_t)(l * 9 + mr) * 6144;
        const int tile = isc ? (item - 256) * 8 + wave : item * 8 + wave;
        const int row0 = isc ? NL + tile * 16 : tile * 16;
        const uint4* xq = (const uint4*)(xres + (size_t)(row0 + fr) * D + 8 * fq);
        uint4 xa[8], xb[8];
#pragma unroll
        for (int u = 0; u < 8; ++u) { xa[u] = xq[4 * u]; xb[u] = xq[4 * (8 + u)]; }
        __syncthreads();
        {
#pragma unroll
            for (int q = 0; q < 2; ++q) { const int k = 2 * tid + q; gm[k] = gvec[k] * (1.f + mv[4 * 1024 + k]); shv[k] = mv[3 * 1024 + k]; }
            if (tid < 16) biasv[tid] = ((const float*)(p.ws + OFF_RB))[(l * 9 + mr) * 16 + tid];
            const uint4* rt = (const uint4*)(p.ws + OFF_RT + (size_t)(l * 9 + mr) * 98304);
            uint4 tv[12];
#pragma unroll
            for (int i = 0; i < 12; ++i) tv[i] = rt[tid + 512 * i];
#pragma unroll
            for (int i = 0; i < 12; ++i) ((uint4*)Wt)[tid + 512 * i] = tv[i];
        }
        __syncthreads();
        const unsigned char* bq = Wt + lane * 16;
        nf32x4 acc0 = {0.f, 0.f, 0.f, 0.f}, acc1 = {0.f, 0.f, 0.f, 0.f}, acc2 = {0.f, 0.f, 0.f, 0.f}; float ss = 0.f;
#define NF_LOAD(buf, s0) do { _Pragma("unroll") for (int u = 0; u < 8; ++u) buf[u] = xq[4 * ((s0) + u)]; } while (0)
#define NF_COMP(buf, s0) do { _Pragma("unroll") for (int u = 0; u < 8; ++u) { \
                float xf[8]; unpack8(buf[u], xf); \
                _Pragma("unroll") for (int i = 0; i < 8; ++i) ss += xf[i] * xf[i]; \
                const abf16x8 av_ = __builtin_bit_cast(abf16x8, buf[u]); \
                const unsigned char* bb = bq + ((s0) + u) * 1024; \
                acc0 = __builtin_amdgcn_mfma_f32_16x16x32_bf16(av_, *(const abf16x8*)(bb), acc0, 0, 0, 0); \
                acc1 = __builtin_amdgcn_mfma_f32_16x16x32_bf16(av_, *(const abf16x8*)(bb + 32768), acc1, 0, 0, 0); \
                acc2 = __builtin_amdgcn_mfma_f32_16x16x32_bf16(av_, *(const abf16x8*)(bb + 65536), acc2, 0, 0, 0); } } while (0)
        {
            NF_COMP(xa, 0); __builtin_amdgcn_sched_barrier(0); NF_LOAD(xa, 16);
            NF_COMP(xb, 8); __builtin_amdgcn_sched_barrier(0); NF_LOAD(xb, 24);
            NF_COMP(xa, 16); __builtin_amdgcn_sched_barrier(0);
            NF_COMP(xb, 24);
        }
#undef NF_LOAD
#undef NF_COMP
        acc1 = acc1 + acc2; acc0 = acc0 + acc1; acc1 = (nf32x4){0.f, 0.f, 0.f, 0.f};
        ss += __shfl_xor(ss, 16); ss += __shfl_xor(ss, 32);
        const float rstd = 1.f / sqrtf(ss * (1.f / D) + EPS);
        const float be = biasv[fr];
#pragma unroll
        for (int reg = 0; reg < 4; ++reg) {
            const float rs = __shfl(rstd, 4 * fq + reg);
            const float lg = (acc0[reg] + acc1[reg]) * rs + be;
            float mx = lg;
#pragma unroll
            for (int o = 1; o < 16; o <<= 1) mx = fmaxf(mx, __shfl_xor(mx, o));
            const float ex = expf(lg - mx); float den = ex;
#pragma unroll
            for (int o = 1; o < 16; o <<= 1) den += __shfl_xor(den, o);
            const float a = ex / den; const int rr = row0 + 4 * fq + reg;
            if (!isc) { const int b = rr >> 12, t = rr & 4095; ((float*)(p.ws + OFF_AFFL))[(size_t)(b * 16 + fr) * SEQ + t] = a; }
            else { const int rc = rr - NL, b = rc >> 8, t = rc & 255; ((float*)(p.ws + OFF_AFFC))[(size_t)(b * 16 + fr) * CTXL + t] = a; }
        }
#pragma unroll 1
        for (int r0 = 0; r0 < 16; r0 += 8) {
            uint2 xw[8][4];
#pragma unroll
            for (int r = 0; r < 8; ++r) { const uint2* xr = (const uint2*)(xres + (size_t)(row0 + r0 + r) * D);
#pragma unroll
                for (int j = 0; j < 4; ++j) xw[r][j] = xr[lane + 64 * j]; }
#pragma unroll
            for (int r = 0; r < 8; ++r) {
                const float rs = __shfl(rstd, r0 + r);
#pragma unroll
                for (int j = 0; j < 4; ++j) {
                    float4 xv; xv.x = bf2f(xw[r][j].x & 0xffffu); xv.y = bf2f(xw[r][j].x >> 16); xv.z = bf2f(xw[r][j].y & 0xffffu); xv.w = bf2f(xw[r][j].y >> 16);
                    const float4 g = ((const float4*)gm)[lane + 64 * j], sh = ((const float4*)shv)[lane + 64 * j];
                    *(unsigned*)(h8 + (size_t)(row0 + r0 + r) * D + (lane + 64 * j) * 4) = pg8::pack_fp8x4(xv.x * rs * g.x + sh.x, xv.y * rs * g.y + sh.y, xv.z * rs * g.z + sh.z, xv.w * rs * g.w + sh.w);
                }
            }
        }
    }
}

__device__ __forceinline__ void ph_normF_ctx(const P& p, const int l) {
    int tid_ = threadIdx.x; asm volatile("" : "+v"(tid_));
    const int lane = tid_ & 63, fr = lane & 15, fq = lane >> 4, wave = __builtin_amdgcn_readfirstlane(tid_ >> 6);
    if (wave != 0) return;
    const float* mv = (const float*)(p.ws + OFF_MODV) + (size_t)(l * 9 + 8) * 6144;
    const bf16* xres = (const bf16*)(p.ws + OFF_XRES); unsigned char* h8 = (unsigned char*)(p.ws + OFF_H);
    const float* gvec = p.in[I_NFFN] + l * 1024;
    const unsigned char* rt = (const unsigned char*)(p.ws + OFF_RT) + (size_t)(l * 9 + 8) * 98304 + lane * 16;
    const float be = ((const float*)(p.ws + OFF_RB))[(l * 9 + 8) * 16 + fr];
    for (int wt = blockIdx.x; wt < NC / 16; wt += gridDim.x) {
        const int row0 = NL + wt * 16;
        const uint4* xq = (const uint4*)(xres + (size_t)(row0 + fr) * D + 8 * fq);
        nf32x4 acc0 = {0.f, 0.f, 0.f, 0.f}, acc1 = {0.f, 0.f, 0.f, 0.f}, acc2 = {0.f, 0.f, 0.f, 0.f}; float ss = 0.f;
#pragma unroll 1
        for (int s0 = 0; s0 < 32; s0 += 8) {
            uint4 xw[8]; abf16x8 b0[8], b1[8], b2[8];
#pragma unroll
            for (int u = 0; u < 8; ++u) { xw[u] = xq[4 * (s0 + u)]; const unsigned char* bb = rt + (s0 + u) * 1024;
                b0[u] = *(const abf16x8*)(bb); b1[u] = *(const abf16x8*)(bb + 32768); b2[u] = *(const abf16x8*)(bb + 65536); }
#pragma unroll
            for (int u = 0; u < 8; ++u) {
                float xf[8]; unpack8(xw[u], xf);
#pragma unroll
                for (int i = 0; i < 8; ++i) ss += xf[i] * xf[i];
                const abf16x8 av_ = __builtin_bit_cast(abf16x8, xw[u]);
                acc0 = __builtin_amdgcn_mfma_f32_16x16x32_bf16(av_, b0[u], acc0, 0, 0, 0);
                acc1 = __builtin_amdgcn_mfma_f32_16x16x32_bf16(av_, b1[u], acc1, 0, 0, 0);
                acc2 = __builtin_amdgcn_mfma_f32_16x16x32_bf16(av_, b2[u], acc2, 0, 0, 0);
            }
        }
        acc1 = acc1 + acc2; acc0 = acc0 + acc1;
        ss += __shfl_xor(ss, 16); ss += __shfl_xor(ss, 32);
        const float rstd = 1.f / sqrtf(ss * (1.f / D) + EPS);
#pragma unroll
        for (int reg = 0; reg < 4; ++reg) {
            const float rs = __shfl(rstd, 4 * fq + reg);
            const float lg = acc0[reg] * rs + be;
            float mx = lg;
#pragma unroll
            for (int o = 1; o < 16; o <<= 1) mx = fmaxf(mx, __shfl_xor(mx, o));
            const float ex = expf(lg - mx); float den = ex;
#pragma unroll
            for (int o = 1; o < 16; o <<= 1) den += __shfl_xor(den, o);
            const int rc = wt * 16 + 4 * fq + reg, b = rc >> 8, t = rc & 255;
            ((float*)(p.ws + OFF_AFFC))[(size_t)(b * 16 + fr) * CTXL + t] = ex / den;
        }
        float4 gmv[4], shq[4];
#pragma unroll
        for (int j = 0; j < 4; ++j) { const float4 g = ((const float4*)gvec)[lane + 64 * j], sc = ((const float4*)(mv + 4 * 1024))[lane + 64 * j]; shq[j] = ((const float4*)(mv + 3 * 1024))[lane + 64 * j];
            gmv[j] = make_float4(g.x * (1.f + sc.x), g.y * (1.f + sc.y), g.z * (1.f + sc.z), g.w * (1.f + sc.w)); }
#pragma unroll 1
        for (int r0 = 0; r0 < 16; r0 += 8) {
            uint2 xw[8][4];
#pragma unroll
            for (int r = 0; r < 8; ++r) { const uint2* xr = (const uint2*)(xres + (size_t)(row0 + r0 + r) * D);
#pragma unroll
                for (int j = 0; j < 4; ++j) xw[r][j] = xr[lane + 64 * j]; }
#pragma unroll
            for (int r = 0; r < 8; ++r) {
                const float rs = __shfl(rstd, r0 + r);
#pragma unroll
                for (int j = 0; j < 4; ++j) {
                    float4 xv; xv.x = bf2f(xw[r][j].x & 0xffffu); xv.y = bf2f(xw[r][j].x >> 16); xv.z = bf2f(xw[r][j].y & 0xffffu); xv.w = bf2f(xw[r][j].y >> 16);
                    *(unsigned*)(h8 + (size_t)(row0 + r0 + r) * D + (lane + 64 * j) * 4) = pg8::pack_fp8x4(xv.x * rs * gmv[j].x + shq[j].x, xv.y * rs * gmv[j].y + shq[j].y, xv.z * rs * gmv[j].z + shq[j].z, xv.w * rs * gmv[j].w + shq[j].w);
                }
            }
        }
    }
}

__device__ __forceinline__ void ph_norm0(const P& p) {
    const int tix = otid();
    const float* modv = (const float*)(p.ws + OFF_MODV); bf16* hout = (bf16*)(p.ws + OFF_H);
    const float4* g4 = (const float4*)p.in[I_NMIX];
    const int lane = tix & 63, wave = tix >> 6, stride = gridDim.x * 8;
    for (int rb = blockIdx.x * 8 + wave; rb < NT; rb += 4 * stride) {
        float4 v[4][4]; float ss[4];
#pragma unroll
        for (int q = 0; q < 4; ++q) { const int r = min(rb + q * stride, NT - 1); const float4* xr = (const float4*)in_row(p, r);
#pragma unroll
            for (int j = 0; j < 4; ++j) v[q][j] = xr[lane + 64 * j]; }
#pragma unroll
        for (int q = 0; q < 4; ++q) { float s = 0.f;
#pragma unroll
            for (int j = 0; j < 4; ++j) s += v[q][j].x * v[q][j].x + v[q][j].y * v[q][j].y + v[q][j].z * v[q][j].z + v[q][j].w * v[q][j].w;
            ss[q] = s; }
#pragma unroll
        for (int o = 1; o < 64; o <<= 1) {
#pragma unroll
            for (int q = 0; q < 4; ++q) ss[q] += __shfl_xor(ss[q], o); }
#pragma unroll
        for (int q = 0; q < 4; ++q) {
            const int r = rb + q * stride;
            if (r < NT) {
                const float rstd = 1.f / sqrtf(ss[q] * (1.f / D) + EPS);
                const float* mv = modv + (size_t)mod_row(r) * 6144;
#pragma unroll
                for (int j = 0; j < 4; ++j) {
                    const float4 g = g4[lane + 64 * j], sh = ((const float4*)mv)[lane + 64 * j], sc = ((const float4*)(mv + 1024))[lane + 64 * j];
                    uint2 o; o.x = pk2(v[q][j].x * rstd * g.x * (1.f + sc.x) + sh.x, v[q][j].y * rstd * g.y * (1.f + sc.y) + sh.y);
                    o.y = pk2(v[q][j].z * rstd * g.z * (1.f + sc.z) + sh.z, v[q][j].w * rstd * g.w * (1.f + sc.w) + sh.w);
                    *(uint2*)(hout + (size_t)r * D + (lane + 64 * j) * 4) = o;
                }
            }
        }
    }
}

#define LDSP ((__attribute__((address_space(3))) unsigned char*)lds)
__device__ __forceinline__ pg8::Sched mk_sched(int ng, int M, int N) { pg8::Sched S{}; S.ng = ng; S.nM = M / 256; S.nN = N / 256; S.nwg = ng * S.nM * S.nN; S.G = gridDim.x; S.c = blockIdx.x; return S; }
__device__ __forceinline__ void tail_convert(const P& p, const pg8::Sched& S, unsigned char* lds, const int it0, const int it1) {
    const int R = (S.nwg + S.G - 1) / S.G, T = S.nwg - (R - 1) * S.G;
    if (S.c >= T) ph_convert_moe_range(p, 1, (float*)lds, it0, it1, (S.c - T) * 8, (S.G - T) * 8);
}
constexpr int CVT_Q1 = 0, CVT_Q2 = 0, CVT_Q3 = 0, CVT_Q4 = 0, CVT_Q5 = 0;
__device__ __forceinline__ void fg_inproj_even(const P& p, unsigned char* lds) {
    pg8::Sched S = mk_sched(1, NT, EVIN);
    S.Abase = p.ws + OFF_H; S.a_tstride = (size_t)256 * D * 2; S.Bbase = p.ws + OFF_WT_EVIN; S.b_tstride = (size_t)256 * D * 2;
    pg8::EpiStoreBf16 E{(bf16*)(p.ws + OFF_PROJ), EVIN, 0, 1.f};
    pg8::gemm_phase<pg8::EpiStoreBf16, false>(LDSP, D * 2, S, E);
    tail_convert(p, S, lds, 0, CVT_Q1);
}
__device__ __forceinline__ void fg_outproj(const P& p, int l, bool first, size_t off_wt, int M, unsigned char* lds) {
    pg8::Sched S = mk_sched(1, M, D);
    if (l == 0) {
        S.Abase = p.ws + OFF_MIX; S.a_tstride = (size_t)256 * D; S.Bbase = p.ws + off_wt; S.b_tstride = (size_t)256 * D;
        pg8::EpiResid E{p.in[I_X], p.in[I_CTX], (bf16*)(p.ws + OFF_XRES), (const float*)(p.ws + OFF_MODV) + (size_t)l * 9 * 6144, first, 1.f / (MIX8_SCALE * pg8::W8_SCALE)};
        pg8::gemm_phase<pg8::EpiResid, false, true>(LDSP, D, S, E);
        tail_convert(p, S, lds, CVT_Q1, CVT_Q2);
        return;
    }
    S.Abase = p.ws + OFF_MIX; S.a_tstride = (size_t)256 * D * 2; S.Bbase = p.ws + off_wt; S.b_tstride = (size_t)256 * D * 2;
    pg8::EpiResid E{p.in[I_X], p.in[I_CTX], (bf16*)(p.ws + OFF_XRES), (const float*)(p.ws + OFF_MODV) + (size_t)l * 9 * 6144, first, 1.f};
    pg8::gemm_phase<pg8::EpiResid, false>(LDSP, D * 2, S, E);
    if (l == 0) tail_convert(p, S, lds, CVT_Q1, CVT_Q2);
}
__device__ __forceinline__ void fg_inproj_odd(const P& p, unsigned char* lds) {
    pg8::Sched S = mk_sched(1, NT, 2048);
    S.Abase = p.ws + OFF_H1; S.a_tstride = (size_t)256 * D * 2; S.Bbase = p.ws + OFF_WT_ODIN; S.b_tstride = (size_t)256 * D * 2;
    pg8::EpiSplitBf16 E{(bf16*)(p.ws + OFF_MIX), (bf16*)(p.ws + OFF_H)};
    pg8::gemm_phase<pg8::EpiSplitBf16, false>(LDSP, D * 2, S, E);
    tail_convert(p, S, lds, CVT_Q4, CVT_Q5);
}
__device__ __forceinline__ void fg_moe_up(const P& p, int l, int Me, unsigned char* lds) {
    pg8::Sched S = mk_sched(NE, Me, 2816);
    S.Abase = p.ws + OFF_H; S.rowidx = (const int*)(p.ws + OFF_ROWL); S.idx_gstride = ME;
    S.Bbase = p.ws + (l ? OFF_WGU1 : OFF_WGU); S.b_gstride = WGU_E; S.b_tstride = (size_t)256 * D;
    pg8::EpiSwiGLU8 E{(unsigned char*)(p.ws + OFF_HID)};
    pg8::gemm_phase<pg8::EpiSwiGLU8, true, true>(LDSP, D, S, E);
    if (l == 0) tail_convert(p, S, lds, CVT_Q2, CVT_Q3);
}
__device__ __forceinline__ void fg_moe_down(const P& p, int l, int Me, unsigned char* lds) {
    pg8::Sched S = mk_sched(NE, Me, D);
    S.Abase = p.ws + OFF_HID; S.a_gstride = (size_t)ME * pg8::FFP; S.a_tstride = (size_t)256 * pg8::FFP;
    S.Bbase = p.ws + (l ? OFF_WDN1 : OFF_WDN); S.b_gstride = WDN_E; S.b_tstride = (size_t)256 * pg8::FFP;
    pg8::EpiStoreFp8 E{(unsigned char*)(p.ws + OFF_Y), D, (size_t)ME * D, Y8_SCALE / (pg8::W8_SCALE * pg8::HID8_SCALE)};
    pg8::gemm_phase<pg8::EpiStoreFp8, false, true, true>(LDSP, pg8::FFP, S, E);
    if (l == 0) tail_convert(p, S, lds, CVT_Q3, CVT_Q4);
}

constexpr int LDS_BYTES = 131072 + 4096;
constexpr size_t OFF_BAR = 640 * MiB;
__global__ void __launch_bounds__(512) k_all(P p) {
    cooperative_groups::grid_group grid = cooperative_groups::this_grid();
    extern __shared__ __attribute__((aligned(16))) unsigned char lds[];
    float* sm = (float*)lds;
    volatile LAS unsigned* st = (volatile LAS unsigned*)((LAS unsigned char*)lds + 131072 + 64);
    if (threadIdx.x < 4) st[threadIdx.x] = 0u;
    __syncthreads();
    XcdBarrier bar = xcd_barrier_post((unsigned*)(p.ws + OFF_BAR), st);
#define GSYNC() xcd_barrier(bar)
    ph_mod(p, sm); __syncthreads(); ph_convert_other(p, sm); ph_convert_gates(p, sm); ph_convert_moe(p, 0, sm); GSYNC();
    if (gridDim.x == 0x7fffffffu) grid.sync();
    ph_router_tables(p); ph_norm0(p); GSYNC();
    fg_inproj_even(p, lds); GSYNC();
    ph_prep_attn(p, sm); ph_conv3v(p); GSYNC();
    ph_attn_mfma(p, lds); GSYNC();
    fg_outproj(p, 0, true, OFF_WT_EVOUT, NT, lds); GSYNC();
    ph_normF(p, 0, true, sm); ph_normF_ctx(p, 0); GSYNC();
    ph_topk(p, true, sm); GSYNC();
    fg_moe_up(p, 0, ME, lds); GSYNC();
    fg_moe_down(p, 0, ME, lds); GSYNC();
    ph_combine(p, 0, false, NT); GSYNC();
    fg_inproj_odd(p, lds); GSYNC();
    ph_lru(p, sm); GSYNC();
    ph_lru_out(p); GSYNC();
    fg_outproj(p, 1, false, OFF_WT_ODOUT, NL, lds); GSYNC();
    ph_normF(p, 1, false, sm); GSYNC();
    ph_topk(p, false, sm); __syncthreads(); ph_convert_moe(p, 1, sm, CVT_Q5); GSYNC();
    fg_moe_up(p, 1, NB * CAPL, lds); GSYNC();
    fg_moe_down(p, 1, NB * CAPL, lds); GSYNC();
    ph_combine(p, 1, true, NL);
}
}

extern "C" void kernel_launch(void* const* d_in, const int* in_sizes, int n_in, void* d_out, int out_size, void* d_ws, size_t ws_size, hipStream_t stream) {
    if (n_in != N_IN || ws_size < 644 * MiB) { fprintf(stderr, "kernel_launch: unexpected n_in %d or ws_size %zu\n", n_in, ws_size); return; }
    static int grid_blocks = 0;
    if (!grid_blocks) {
        int dev = 0, cus = 0, per_cu = 0;
        (void)hipGetDevice(&dev);
        (void)hipDeviceGetAttribute(&cus, hipDeviceAttributeMultiprocessorCount, dev);
        (void)hipFuncSetAttribute((const void*)k_all, hipFuncAttributeMaxDynamicSharedMemorySize, LDS_BYTES);
        (void)hipOccupancyMaxActiveBlocksPerMultiprocessor(&per_cu, k_all, 512, LDS_BYTES);
        if (per_cu < 1) per_cu = 1;
        grid_blocks = cus * per_cu;
        fprintf(stderr, "kernel_launch: cus %d per_cu %d grid %d ws %zu\n", cus, per_cu, grid_blocks, ws_size);
    }
    P p{};
    for (int i = 0; i < N_IN; ++i) p.in[i] = (const float*)d_in[i];
    p.out = (float*)d_out; p.ws = (char*)d_ws;
    (void)hipMemsetAsync((char*)d_ws + OFF_BAR, 0, 16384, stream);
    void* args[] = {&p};
    hipError_t e = hipLaunchCooperativeKernel((void*)k_all, dim3(grid_blocks), dim3(512), args, LDS_BYTES, stream);
    if (e != hipSuccess) fprintf(stderr, "cooperative launch failed: %s (grid %d)\n", hipGetErrorString(e), grid_blocks);
}
```
